# Optimizing an MI355X kernel written in HIP

```python
import math
import jax, jax.numpy as jnp
from jax import lax
import numpy as np

D_MODEL = 1024
BATCH = 8
SEQ = 4096
DEPTH = 2

DN_HEADS = 8
DN_HEAD_DIM = 128
DN_WIDTH = DN_HEADS * DN_HEAD_DIM
DN_CONV = 4
DN_CHUNK = 64
DA_HEADS = 12
DA_HEAD_DIM = 64
DA_WIDTH = DA_HEADS * DA_HEAD_DIM
DA_PATTERNS = ((128, 1), (512, 4), (2048, 16))
DA_BLOCK = 128
ALIBI_MAX_EXP = 8.0
D_FF = 2816
MACARON_WEIGHT = 0.5
NORM_EPS = 1e-6
N_ADA = 9
IN_SPLITS = (3 * DN_WIDTH, DN_WIDTH, DN_HEADS, DN_HEADS,
             DA_WIDTH, DA_WIDTH, DA_WIDTH, D_MODEL, D_MODEL)
IN_COLS = 3 * DN_WIDTH + DN_WIDTH + 2 * DN_HEADS + 3 * DA_WIDTH + 2 * D_MODEL

kernel_name = "hybrid_deltanet_dilated_attn_macaron_adaln"


def rmsnorm(x, g):
    xf = x.astype(jnp.float32)
    y = xf * lax.rsqrt(jnp.mean(xf * xf, axis=-1, keepdims=True) + NORM_EPS)
    return (y * g.astype(jnp.float32)).astype(x.dtype)


def l2norm(x):
    xf = x.astype(jnp.float32)
    return xf * lax.rsqrt(jnp.sum(xf * xf, axis=-1, keepdims=True) + NORM_EPS)


def modulate(x, shift, scale):
    return x * (1.0 + scale[:, None, :]) + shift[:, None, :]


def swiglu(x, w_gate, w_up, w_down):
    return (jax.nn.silu(x @ w_gate) * (x @ w_up)) @ w_down


def causal_depthwise_conv(x, w):
    K = w.shape[0]
    S = x.shape[1]
    xp = jnp.pad(x, ((0, 0), (K - 1, 0), (0, 0)))
    y = xp[:, 0:S] * w[0]
    for j in range(1, K):
        y = y + xp[:, j:j + S] * w[j]
    return y


def gated_delta_rule(q, k, v, g, beta):
    B, S, H, dk = q.shape
    dv = v.shape[-1]
    C = DN_CHUNK
    N = S // C
    f32 = jnp.float32

    def chunks(t):
        t = t.astype(f32).reshape((B, N, C, H) + t.shape[3:])
        return t.transpose((1, 0, 3, 2) + tuple(range(4, t.ndim)))

    qc, kc, vc = chunks(q), chunks(k), chunks(v)
    gc = jnp.cumsum(chunks(g), axis=-1)
    bc = chunks(beta)
    kb = kc * bc[..., None]
    vb = vc * bc[..., None]
    incl = jnp.tril(jnp.ones((C, C), dtype=bool))
    strict = jnp.tril(jnp.ones((C, C), dtype=bool), -1)
    decay = jnp.exp(jnp.where(incl, gc[..., :, None] - gc[..., None, :], -jnp.inf))
    m = jnp.where(strict, jnp.einsum('nbhid,nbhjd->nbhij', kb, kc) * decay, 0.0)
    a = m + jnp.eye(C, dtype=f32)
    u_c = lax.linalg.triangular_solve(a, vb, left_side=True, lower=True, unit_diagonal=True)
    w_c = lax.linalg.triangular_solve(a, kb * jnp.exp(gc)[..., None], left_side=True,
                                      lower=True, unit_diagonal=True)
    qk = jnp.einsum('nbhid,nbhjd->nbhij', qc, kc) * decay

    def step(state, xs):
        q_i, k_i, u_i, w_i, g_i, qk_i = xs
        v_new = u_i - jnp.einsum('bhcd,bhde->bhce', w_i, state)
        o_i = (jnp.einsum('bhcd,bhde->bhce', q_i * jnp.exp(g_i)[..., None], state)
               + jnp.einsum('bhij,bhje->bhie', qk_i, v_new))
        g_last = g_i[..., -1]
        state = (state * jnp.exp(g_last)[..., None, None]
                 + jnp.einsum('bhcd,bhce->bhde',
                              k_i * jnp.exp(g_last[..., None] - g_i)[..., None], v_new))
        return state, o_i

    state0 = jnp.zeros((B, H, dk, dv), f32)
    _, o = lax.scan(step, state0, (qc, kc, u_c, w_c, gc, qk))
    return o.transpose(1, 0, 3, 2, 4).reshape(B, S, H, dv)


def dilated_window_branch(q, k, v, slopes, window, dilation):
    B, S, H, dh = q.shape
    r = dilation
    n = S // r
    span = window // r
    nb = -(-n // DA_BLOCK)
    n_pad = nb * DA_BLOCK
    z = B * r

    def to_sub(t):
        t = t.reshape(B, n, r, H, dh).transpose(0, 2, 1, 3, 4).reshape(z, n, H, dh)
        return jnp.pad(t, ((0, 0), (0, n_pad - n), (0, 0), (0, 0)))

    def band(t):
        tp = jnp.pad(t, ((0, 0), (DA_BLOCK, 0), (0, 0), (0, 0)))
        prev = tp[:, :n_pad].reshape(z, nb, DA_BLOCK, H, dh)
        cur = t.reshape(z, nb, DA_BLOCK, H, dh)
        return jnp.concatenate([prev, cur], axis=2)

    qs, ks, vs = to_sub(q), to_sub(k), to_sub(v)
    qb = qs.reshape(z, nb, DA_BLOCK, H, dh)
    kb, vb = band(ks), band(vs)
    s = jnp.einsum('znqhd,znkhd->znhqk', qb, kb).astype(jnp.float32) * (dh ** -0.5)
    qi = jnp.arange(DA_BLOCK)[:, None]
    ki = jnp.arange(2 * DA_BLOCK)[None, :]
    dist = qi + DA_BLOCK - ki
    key_pos = jnp.arange(nb)[:, None, None] * DA_BLOCK + ki[None] - DA_BLOCK
    valid = (dist[None] >= 0) & (dist[None] <= span) & (key_pos >= 0)
    bias = -slopes[:, None, None] * (dist * r).astype(jnp.float32)[None]
    s = jnp.where(valid[None, :, None], s + bias[None, None], -jnp.inf)
    mx = jnp.max(s, axis=-1, keepdims=True)
    p = jnp.exp(s - mx)
    l = jnp.sum(p, axis=-1, keepdims=True)
    o = jnp.einsum('znhqk,znkhd->znqhd', (p / l).astype(v.dtype), vb).astype(jnp.float32)
    lse = (mx + jnp.log(l))[..., 0]
    o = o.reshape(z, n_pad, H, dh)[:, :n].reshape(B, r, n, H, dh)
    o = o.transpose(0, 2, 1, 3, 4).reshape(B, S, H, dh)
    lse = lse.transpose(0, 1, 3, 2).reshape(z, n_pad, H)[:, :n].reshape(B, r, n, H)
    lse = lse.transpose(0, 2, 1, 3).reshape(B, S, H)
    return o, lse


def hybrid_mixer(u, w_in, conv_w, a_log, dt_bias, dn_norm, w_a, w_b, w_o):
    B, S, _ = u.shape
    proj = u @ w_in
    idx = np.cumsum(IN_SPLITS)[:-1].tolist()
    dn_qkv, dn_z, dn_b, dn_a, da_q, da_k, da_v, gate_a, gate_b = jnp.split(proj, idx, axis=-1)

    qkv = jax.nn.silu(causal_depthwise_conv(dn_qkv, conv_w))
    q, k, v = jnp.split(qkv, 3, axis=-1)
    q = l2norm(q.reshape(B, S, DN_HEADS, DN_HEAD_DIM)) * (DN_HEAD_DIM ** -0.5)
    k = l2norm(k.reshape(B, S, DN_HEADS, DN_HEAD_DIM))
    v = v.reshape(B, S, DN_HEADS, DN_HEAD_DIM)
    beta = jax.nn.sigmoid(dn_b.astype(jnp.float32))
    g = -jnp.exp(a_log.astype(jnp.float32)) * jax.nn.softplus(
        dn_a.astype(jnp.float32) + dt_bias.astype(jnp.float32))
    o_a = gated_delta_rule(q, k, v, g, beta).astype(u.dtype)
    o_a = rmsnorm(o_a, dn_norm) * jax.nn.silu(dn_z.reshape(B, S, DN_HEADS, DN_HEAD_DIM))
    y_a = o_a.reshape(B, S, DN_WIDTH) @ w_a

    qd = da_q.reshape(B, S, DA_HEADS, DA_HEAD_DIM)
    kd = da_k.reshape(B, S, DA_HEADS, DA_HEAD_DIM)
    vd = da_v.reshape(B, S, DA_HEADS, DA_HEAD_DIM)
    slopes = 2.0 ** (-ALIBI_MAX_EXP * jnp.arange(1, DA_HEADS + 1, dtype=jnp.float32) / DA_HEADS)
    outs, lses = [], []
    for window, dilation in DA_PATTERNS:
        o_p, lse_p = dilated_window_branch(qd, kd, vd, slopes, window, dilation)
        outs.append(o_p)
        lses.append(lse_p)
    wts = jax.nn.softmax(jnp.stack(lses, axis=0), axis=0)
    o_b = jnp.sum(wts[..., None] * jnp.stack(outs, axis=0), axis=0).astype(u.dtype)
    y_b = o_b.reshape(B, S, DA_WIDTH) @ w_b

    merged = jax.nn.sigmoid(gate_a) * y_a + jax.nn.sigmoid(gate_b) * y_b
    return merged @ w_o


def setup_inputs(seed: int = 0) -> dict:
    key = jax.random.key(seed)
    ks = jax.random.split(key, 24)
    f32 = jnp.float32
    D = D_MODEL

    def nrm(k, shape, scale):
        return jax.random.normal(k, shape, f32) * scale

    x = nrm(ks[0], (BATCH, SEQ, D), 1.0)
    c = nrm(ks[1], (BATCH, D), 1.0)
    ada_w = nrm(ks[2], (DEPTH, D, N_ADA * D), 0.5 * D ** -0.5)
    ada_b = nrm(ks[3], (DEPTH, N_ADA * D), 0.02)
    ln_ffn1 = 1.0 + nrm(ks[4], (DEPTH, D), 0.02)
    ln_mix = 1.0 + nrm(ks[5], (DEPTH, D), 0.02)
    ln_ffn2 = 1.0 + nrm(ks[6], (DEPTH, D), 0.02)
    ffn1_wg = nrm(ks[7], (DEPTH, D, D_FF), D ** -0.5)
    ffn1_wu = nrm(ks[8], (DEPTH, D, D_FF), D ** -0.5)
    ffn1_wd = nrm(ks[9], (DEPTH, D_FF, D), D_FF ** -0.5)
    w_in = nrm(ks[10], (DEPTH, D, IN_COLS), D ** -0.5)
    conv_w = nrm(ks[11], (DEPTH, DN_CONV, 3 * DN_WIDTH), DN_CONV ** -0.5)
    a_log = jnp.log(jax.random.uniform(ks[12], (DEPTH, DN_HEADS), f32, 1.0, 16.0))
    dt = jnp.exp(jax.random.uniform(ks[13], (DEPTH, DN_HEADS), f32,
                                    math.log(1e-3), math.log(1e-1)))
    dt_bias = dt + jnp.log(-jnp.expm1(-dt))
    dn_norm = 1.0 + nrm(ks[14], (DEPTH, DN_HEAD_DIM), 0.02)
    w_a = nrm(ks[15], (DEPTH, DN_WIDTH, D), DN_WIDTH ** -0.5)
    w_b = nrm(ks[16], (DEPTH, DA_WIDTH, D), DA_WIDTH ** -0.5)
    w_o = nrm(ks[17], (DEPTH, D, D), D ** -0.5)
    ffn2_wg = nrm(ks[18], (DEPTH, D, D_FF), D ** -0.5)
    ffn2_wu = nrm(ks[19], (DEPTH, D, D_FF), D ** -0.5)
    ffn2_wd = nrm(ks[20], (DEPTH, D_FF, D), D_FF ** -0.5)
    final_norm = 1.0 + nrm(ks[21], (D,), 0.02)
    return {"x": x, "c": c, "ada_w": ada_w, "ada_b": ada_b,
            "ln_ffn1": ln_ffn1, "ln_mix": ln_mix, "ln_ffn2": ln_ffn2,
            "ffn1_wg": ffn1_wg, "ffn1_wu": ffn1_wu, "ffn1_wd": ffn1_wd,
            "w_in": w_in, "conv_w": conv_w, "a_log": a_log, "dt_bias": dt_bias,
            "dn_norm": dn_norm, "w_a": w_a, "w_b": w_b, "w_o": w_o,
            "ffn2_wg": ffn2_wg, "ffn2_wu": ffn2_wu, "ffn2_wd": ffn2_wd,
            "final_norm": final_norm}


def reference(x, c, ada_w, ada_b, ln_ffn1, ln_mix, ln_ffn2, ffn1_wg, ffn1_wu, ffn1_wd,
              w_in, conv_w, a_log, dt_bias, dn_norm, w_a, w_b, w_o,
              ffn2_wg, ffn2_wu, ffn2_wd, final_norm):
    h = x
    c_act = jax.nn.silu(c)
    for l in range(DEPTH):
        mod = c_act @ ada_w[l] + ada_b[l]
        (sh1, sc1, gt1, sh2, sc2, gt2, sh3, sc3, gt3) = jnp.split(mod, N_ADA, axis=-1)
        f = swiglu(modulate(rmsnorm(h, ln_ffn1[l]), sh1, sc1), ffn1_wg[l], ffn1_wu[l], ffn1_wd[l])
        h = h + MACARON_WEIGHT * gt1[:, None, :] * f
        u = modulate(rmsnorm(h, ln_mix[l]), sh2, sc2)
        m = hybrid_mixer(u, w_in[l], conv_w[l], a_log[l], dt_bias[l], dn_norm[l],
                         w_a[l], w_b[l], w_o[l])
        h = h + gt2[:, None, :] * m
        f = swiglu(modulate(rmsnorm(h, ln_ffn2[l]), sh3, sc3), ffn2_wg[l], ffn2_wu[l], ffn2_wd[l])
        h = h + MACARON_WEIGHT * gt3[:, None, :] * f
    return rmsnorm(h, final_norm)
```

```cpp
#include <hip/hip_runtime.h>
#include <hip/hip_cooperative_groups.h>
#include <cstdio>
namespace cg = cooperative_groups;

typedef _Float16 h16;
typedef _Float16 h16x2 __attribute__((ext_vector_type(2)));
typedef _Float16 h16x4 __attribute__((ext_vector_type(4)));
typedef _Float16 h16x8 __attribute__((ext_vector_type(8)));
typedef float f32x4 __attribute__((ext_vector_type(4)));
#define LAS __attribute__((address_space(3)))
#define GAS __attribute__((address_space(1)))
template <class T> __device__ __forceinline__ T gld(const T* p) { return *(const GAS T*)p; }
template <class T> __device__ __forceinline__ void gst(T* p, T v) { *(GAS T*)p = v; }

constexpr int M_TOK = 32768, DM = 1024, FF = 2816, SEQ = 4096;
constexpr size_t MiB = 1024ull * 1024ull;
constexpr size_t R0 = 0;
constexpr size_t R1 = 256 * MiB;
constexpr size_t R2 = 320 * MiB;
constexpr size_t R3 = 368 * MiB;
constexpr size_t R4 = 496 * MiB;
constexpr size_t R3_T = R3, R3_QK = R3 + 32 * MiB, R3_HALO = R3 + 64 * MiB, R3_WDN = R3 + 74 * MiB, R3_WDA = R3 + 83 * MiB;
constexpr size_t R3_W1 = R3, R3_W2 = R3 + 12 * MiB;
constexpr size_t KiB = 1024ull;
constexpr size_t R4_WG = R4, R4_WA = R4 + 4096 * KiB, R4_WB = R4 + 6144 * KiB, R4_WO = R4 + 7680 * KiB, R4_MOD = R4 + 9728 * KiB,
                 R4_BD = R4 + 10496 * KiB, R4_LSE = R4 + 12544 * KiB, R4_GC = R4 + 14080 * KiB, R4_BETA = R4 + 15104 * KiB, R4_BAR = R4 + 16256 * KiB;
constexpr size_t WS_NEED = 512 * MiB;
constexpr int LDS_BYTES = 161792 + 64;

__device__ __forceinline__ float shx(float v, int m, int lane) { return __int_as_float(__builtin_amdgcn_ds_bpermute((lane ^ m) << 2, __float_as_int(v))); }
__device__ __forceinline__ float wave_sum(float v, int lane) {
#pragma unroll
    for (int o = 32; o > 0; o >>= 1) v += shx(v, o, lane);
    return v;
}
__device__ __forceinline__ float fexp(float x) { return __builtin_amdgcn_exp2f(x * 1.4426950408889634f); }
__device__ __forceinline__ float flog(float x) { return __builtin_amdgcn_logf(x) * 0.6931471805599453f; }
__device__ __forceinline__ float silu_f(float x) { return x * __builtin_amdgcn_rcpf(1.0f + fexp(-x)); }
__device__ __forceinline__ float sigm_f(float x) { return __builtin_amdgcn_rcpf(1.0f + fexp(-x)); }
__device__ __forceinline__ h16x8 cat8(h16x4 a, h16x4 b) { return __builtin_shufflevector(a, b, 0, 1, 2, 3, 4, 5, 6, 7); }
typedef short s16x4v __attribute__((__vector_size__(8)));
__device__ __forceinline__ h16x4 tr_read4(const h16* p) { return __builtin_bit_cast(h16x4, __builtin_amdgcn_ds_read_tr16_b64_v4i16((LAS s16x4v*)p)); }
#define LDS_BARRIER() do { asm volatile("s_waitcnt lgkmcnt(0)" ::: "memory"); __builtin_amdgcn_s_barrier(); asm volatile("" ::: "memory"); } while (0)
#define LAUNDER_V(x) asm volatile("" : "+v"(x))
#define LAUNDER_S(x) asm volatile("" : "+s"(x))
#define MFMA16(a, b, c) __builtin_amdgcn_mfma_f32_16x16x32_f16((a), (b), (c), 0, 0, 0)

namespace pg8 {
constexpr int BM = 256, BK = 64, HALF = 128, HTB = HALF * BK * 2, NXCD = 8, WGM = 8;
__device__ __forceinline__ int lds_byte(int r, int c) { const int st = (r >> 4) * 2 + (c >> 5), rr = r & 15, cc = c & 31, ob = rr * 64 + cc * 2; return st * 1024 + (ob ^ (((ob >> 9) & 1) << 5)); }
__device__ __forceinline__ void stage_rc(int b, int& R, int& C) { const int st = b / 1024, sb = b % 1024, swz = sb ^ (((sb >> 9) & 1) << 5); R = (st >> 1) * 16 + swz / 64; C = (st & 1) * 32 + (swz % 64) / 2; }
__device__ __forceinline__ int perm32(int rho) { const int n = rho >> 4, i = rho & 15; return 8 * (i >> 2) + 4 * n + (i & 3); }
struct Unit { int pm, pn; };
struct Gemm { const h16* A; const h16* Bt; int M, N, K, lda; };
struct StaticOrder {
    int nM, nN, nwg, G, c;
    __device__ void init(int M, int N, int G_, int c_) { nM = M / BM; nN = N / BM; nwg = nM * nN; G = G_; c = c_; }
    __device__ bool next(int i, Unit& u) const {
        const long L = (long)i * G + c; if (L >= nwg) return false;
        int wgid = (int)L; { const int q = nwg / NXCD, r = nwg % NXCD, xcd = wgid % NXCD, off = wgid / NXCD; wgid = (xcd < r ? xcd * (q + 1) : r * (q + 1) + (xcd - r) * q) + off; }
        const int nig = WGM * nN, gid = wgid / nig, fm = gid * WGM, gsz = (nM - fm) < WGM ? (nM - fm) : WGM;
        u.pm = fm + ((wgid % nig) % gsz); u.pn = (wgid % nig) / gsz; return true;
    }
};

struct EpiSwiglu {
    static constexpr bool PERM = true;
    h16* O;
    __device__ __forceinline__ void operator()(const f32x4 (&acc)[2][2][4][2], const Unit& u, int wr, int wc, int fr, int fq) const {
        const int row0 = u.pm * BM + wr * 64 + fr, col0 = u.pn * 128 + wc * 32 + 8 * fq;
#pragma unroll
        for (int ai = 0; ai < 2; ++ai)
#pragma unroll
            for (int m = 0; m < 4; ++m) {
                h16x8 o;
#pragma unroll
                for (int n = 0; n < 2; ++n)
#pragma unroll
                    for (int j = 0; j < 4; ++j) o[4 * n + j] = (h16)(silu_f(acc[ai][0][m][n][j]) * acc[ai][1][m][n][j]);
                *(h16x8*)(O + (unsigned)(row0 + ai * HALF + m * 16) * FF + col0) = o;
            }
    }
};
struct EpiStore {
    static constexpr bool PERM = true;
    h16* O; int ldc; float* bd; int nmain; int act; h16* halo;
    __device__ __forceinline__ void operator()(const f32x4 (&acc)[2][2][4][2], const Unit& u, int wr, int wc, int fr, int fq) const {
        const int row0 = u.pm * BM + wr * 64 + fr;
        if (u.pn < nmain) {
            const int col0 = u.pn * BM + wc * 32 + 8 * fq;
#pragma unroll
            for (int ai = 0; ai < 2; ++ai)
#pragma unroll
                for (int m = 0; m < 4; ++m)
#pragma unroll
                    for (int bj = 0; bj < 2; ++bj) {
                        h16x8 o;
#pragma unroll
                        for (int n = 0; n < 2; ++n)
#pragma unroll
                            for (int j = 0; j < 4; ++j) { float v = acc[ai][bj][m][n][j]; if (act) v = sigm_f(v); o[4 * n + j] = (h16)v; }
                        *(h16x8*)(O + (unsigned)(row0 + ai * HALF + m * 16) * ldc + col0 + bj * HALF) = o;
                        if (halo && m == 3 && fr >= 13 && u.pn < 12) {
                            const int row = row0 + ai * HALF + 48, nc = ((row & 4095) >> 6) + 1;
                            if (nc < 64) *(h16x8*)(halo + ((unsigned)((row >> 12) * 64 + nc) * 3 + (fr - 13)) * 3072 + col0 + bj * HALF) = o;
                        }
                    }
        } else if (wc == 0 && fq < 2) {
#pragma unroll
            for (int ai = 0; ai < 2; ++ai)
#pragma unroll
                for (int m = 0; m < 4; ++m)
#pragma unroll
                    for (int n = 0; n < 2; ++n) *(f32x4*)(bd + (unsigned)(row0 + ai * HALF + m * 16) * 16 + 8 * fq + 4 * n) = acc[ai][0][m][n];
        }
    }
};
struct EpiResid {
    static constexpr bool PERM = true;
    const float* in32; const h16* in16; h16* out; const float* gate; float coef;
    __device__ __forceinline__ void operator()(const f32x4 (&acc)[2][2][4][2], const Unit& u, int wr, int wc, int fr, int fq) const {
        const int row0 = u.pm * BM + wr * 64 + fr, col0 = u.pn * BM + wc * 32 + 8 * fq;
        const int b = (u.pm * BM) >> 12;
        f32x4 gv[2][2];
#pragma unroll
        for (int bj = 0; bj < 2; ++bj)
#pragma unroll
            for (int n = 0; n < 2; ++n) gv[bj][n] = *(const f32x4*)(gate + b * 9216 + col0 + bj * HALF + 4 * n) * coef;
        if (in32) {
#pragma unroll
            for (int ai = 0; ai < 2; ++ai)
#pragma unroll
                for (int m = 0; m < 4; ++m)
#pragma unroll
                    for (int bj = 0; bj < 2; ++bj) {
                        const unsigned off = (unsigned)(row0 + ai * HALF + m * 16) * DM + col0 + bj * HALF;
                        const f32x4 x0 = *(const f32x4*)(in32 + off), x1 = *(const f32x4*)(in32 + off + 4);
                        h16x8 o;
#pragma unroll
                        for (int j = 0; j < 4; ++j) { o[j] = (h16)(x0[j] + gv[bj][0][j] * acc[ai][bj][m][0][j]); o[4 + j] = (h16)(x1[j] + gv[bj][1][j] * acc[ai][bj][m][1][j]); }
                        *(h16x8*)(out + off) = o;
                    }
        } else {
#pragma unroll
            for (int ai = 0; ai < 2; ++ai)
#pragma unroll
                for (int m = 0; m < 4; ++m)
#pragma unroll
                    for (int bj = 0; bj < 2; ++bj) {
                        const unsigned off = (unsigned)(row0 + ai * HALF + m * 16) * DM + col0 + bj * HALF;
                        const h16x8 xv = *(const h16x8*)(in16 + off);
                        h16x8 o;
#pragma unroll
                        for (int j = 0; j < 4; ++j) { o[j] = (h16)((float)xv[j] + gv[bj][0][j] * acc[ai][bj][m][0][j]); o[4 + j] = (h16)((float)xv[4 + j] + gv[bj][1][j] * acc[ai][bj][m][1][j]); }
                        *(h16x8*)(out + off) = o;
                    }
        }
    }
};
template <bool F32IN, bool FINAL = false> struct EpiResidNorm {
    static constexpr bool PERM = true;
    const float* in32; const h16* in16; h16* out; const float* gate; float coef;
    h16* xn; const float* ln; const float* shp; const float* scp;
    float* ss; unsigned* cnt; unsigned target;
    float* fout;
    LAS unsigned char* sm;
    __device__ __forceinline__ void operator()(const f32x4 (&acc)[2][2][4][2], const Unit& u, int wr, int wc, int fr, int fq) const {
        const int lane = fq * 16 + fr, wid = wr * 4 + wc, tid = wid * 64 + lane;
        const int row0 = u.pm * BM + wr * 64 + fr, col0 = u.pn * BM + wc * 32 + 8 * fq;
        const int b = (u.pm * BM) >> 12;
        LAS float* red = (LAS float*)sm; LAS float* rs = red + 1024;
        f32x4 gv[2][2];
#pragma unroll
        for (int bj = 0; bj < 2; ++bj)
#pragma unroll
            for (int n = 0; n < 2; ++n) gv[bj][n] = *(const f32x4*)(gate + b * 9216 + col0 + bj * HALF + 4 * n) * coef;
        h16x8 ov[2][4][2];
#pragma unroll
        for (int ai = 0; ai < 2; ++ai)
#pragma unroll
            for (int m = 0; m < 4; ++m) {
                float sq = 0.f;
#pragma unroll
                for (int bj = 0; bj < 2; ++bj) {
                    const unsigned off = (unsigned)(row0 + ai * HALF + m * 16) * DM + col0 + bj * HALF;
                    f32x4 xa, xb;
                    if (F32IN) { xa = *(const f32x4*)(in32 + off); xb = *(const f32x4*)(in32 + off + 4); }
                    else { const h16x8 xv = *(const h16x8*)(in16 + off); xa = (f32x4){(float)xv[0], (float)xv[1], (float)xv[2], (float)xv[3]}; xb = (f32x4){(float)xv[4], (float)xv[5], (float)xv[6], (float)xv[7]}; }
                    h16x8 o;
#pragma unroll
                    for (int j = 0; j < 4; ++j) { o[j] = (h16)(xa[j] + gv[bj][0][j] * acc[ai][bj][m][0][j]); o[4 + j] = (h16)(xb[j] + gv[bj][1][j] * acc[ai][bj][m][1][j]); }
                    if (!FINAL) *(h16x8*)(out + off) = o;
                    ov[ai][m][bj] = o;
#pragma unroll
                    for (int j = 0; j < 8; ++j) sq += (float)o[j] * (float)o[j];
                }
                sq += shx(sq, 16, lane); sq += shx(sq, 32, lane);
                if (fq == 0) red[(ai * HALF + wr * 64 + m * 16 + fr) * 4 + wc] = sq;
            }
        asm volatile("s_waitcnt lgkmcnt(0)" ::: "memory"); __builtin_amdgcn_s_barrier(); asm volatile("" ::: "memory");
        if (tid < 256) {
            const float part = (red[tid * 4 + 0] + red[tid * 4 + 1]) + (red[tid * 4 + 2] + red[tid * 4 + 3]);
            __hip_atomic_store(ss + (unsigned)(u.pm * 4 + u.pn) * 256 + tid, part, __ATOMIC_RELAXED, __HIP_MEMORY_SCOPE_AGENT);
        }
        asm volatile("s_waitcnt vmcnt(0)" ::: "memory");
        __builtin_amdgcn_s_barrier(); asm volatile("" ::: "memory");
        if (tid == 0) {
            (void)__hip_atomic_fetch_add(cnt + 16 * u.pm, 1u, __ATOMIC_RELAXED, __HIP_MEMORY_SCOPE_AGENT);
            unsigned spins = 0;
            while (__hip_atomic_load(cnt + 16 * u.pm, __ATOMIC_RELAXED, __HIP_MEMORY_SCOPE_AGENT) < target) { __builtin_amdgcn_s_sleep(1); if (++spins > (1u << 20)) break; }
        }
        __builtin_amdgcn_s_barrier(); asm volatile("" ::: "memory");
        if (tid < 256) {
            float tot = 0.f;
#pragma unroll
            for (int q = 0; q < 4; ++q) tot += __hip_atomic_load(ss + (unsigned)(u.pm * 4 + q) * 256 + tid, __ATOMIC_RELAXED, __HIP_MEMORY_SCOPE_AGENT);
            rs[tid] = rsqrtf(tot * (1.0f / 1024.0f) + 1e-6f);
        }
        asm volatile("s_waitcnt lgkmcnt(0)" ::: "memory"); __builtin_amdgcn_s_barrier(); asm volatile("" ::: "memory");
        const float* sh = FINAL ? ln : shp + b * 9216; const float* sc = FINAL ? ln : scp + b * 9216;
#pragma unroll
        for (int bj = 0; bj < 2; ++bj) {
            const int col = col0 + bj * HALF;
            const f32x4 l0 = *(const f32x4*)(ln + col), l1 = *(const f32x4*)(ln + col + 4), s0 = *(const f32x4*)(sh + col), s1 = *(const f32x4*)(sh + col + 4),
                        c0 = *(const f32x4*)(sc + col), c1 = *(const f32x4*)(sc + col + 4);
#pragma unroll
            for (int ai = 0; ai < 2; ++ai)
#pragma unroll
                for (int m = 0; m < 4; ++m) {
                    const float rstd = rs[ai * HALF + wr * 64 + m * 16 + fr];
                    const h16x8 o = ov[ai][m][bj];
                    if (FINAL) {
                        f32x4 y0, y1;
#pragma unroll
                        for (int j = 0; j < 4; ++j) { y0[j] = (float)o[j] * rstd * l0[j]; y1[j] = (float)o[4 + j] * rstd * l1[j]; }
                        float* yp = fout + (unsigned)(row0 + ai * HALF + m * 16) * DM + col;
                        *(f32x4*)yp = y0; *(f32x4*)(yp + 4) = y1;
                    } else {
                        h16x8 y;
#pragma unroll
                        for (int j = 0; j < 4; ++j) { y[j] = (h16)((float)o[j] * rstd * l0[j] * (1.0f + c0[j]) + s0[j]); y[4 + j] = (h16)((float)o[4 + j] * rstd * l1[j] * (1.0f + c1[j]) + s1[j]); }
                        *(h16x8*)(xn + (unsigned)(row0 + ai * HALF + m * 16) * DM + col) = y;
                    }
                }
        }
    }
};
struct EpiMerge {
    static constexpr bool PERM = true;
    h16* Mg; const h16* gates; int goff; int add;
    __device__ __forceinline__ void operator()(const f32x4 (&acc)[2][2][4][2], const Unit& u, int wr, int wc, int fr, int fq) const {
        const int row0 = u.pm * BM + wr * 64 + fr, col0 = u.pn * BM + wc * 32 + 8 * fq;
#pragma unroll
        for (int ai = 0; ai < 2; ++ai)
#pragma unroll
            for (int m = 0; m < 4; ++m)
#pragma unroll
                for (int bj = 0; bj < 2; ++bj) {
                    const unsigned row = (unsigned)(row0 + ai * HALF + m * 16);
                    const int col = col0 + bj * HALF;
                    const h16x8 gv = *(const h16x8*)(gates + row * 2048 + goff + col);
                    h16x8 pv = {0, 0, 0, 0, 0, 0, 0, 0};
                    if (add) pv = *(const h16x8*)(Mg + row * DM + col);
                    h16x8 o;
#pragma unroll
                    for (int n = 0; n < 2; ++n)
#pragma unroll
                        for (int j = 0; j < 4; ++j) o[4 * n + j] = (h16)((float)pv[4 * n + j] + (float)gv[4 * n + j] * acc[ai][bj][m][n][j]);
                    *(h16x8*)(Mg + row * DM + col) = o;
                }
    }
};

template <class Epi>
__device__ __forceinline__ void gemm_phase(LAS unsigned char* lds, const Gemm g, const StaticOrder& S, const Epi& E) {
    int tid = threadIdx.x; LAUNDER_V(tid);
    const int wid = __builtin_amdgcn_readfirstlane(tid >> 6), lane = tid & 63, wr = wid >> 2, wc = wid & 3, fr = lane & 15, fq = lane >> 4;
    const int K = g.K, nt = K / BK;
    unsigned voffA[2], voffB[2];
#pragma unroll
    for (int i = 0; i < 2; ++i) { int R, C; stage_rc(tid * 16 + i * 8192, R, C); const int Rb = Epi::PERM ? ((R & ~31) + perm32(R & 31)) : R;
        voffA[i] = (unsigned)(R * g.lda + C) * 2u; voffB[i] = (unsigned)(Rb * K + C) * 2u; }
    const size_t kstep = (size_t)(BK * 2);
    const size_t hstepA = (size_t)HALF * g.lda * 2, hstepB = (size_t)HALF * K * 2;
    const size_t tstepA = 2 * hstepA, tstepB = 2 * hstepB;
    const unsigned ldsw = (unsigned)wid * 1024u;
    const int aoff = lds_byte(wr * 64 + fr, fq * 8), boff = lds_byte(wc * 32 + fr, fq * 8);
#define PG8_SA(b, h) (((b) * 2 + (h)) * HTB)
#define PG8_SB(b, h) ((4 + (b) * 2 + (h)) * HTB)
#define PG8_STAGE(bufoff, gbase, voff) do { _Pragma("unroll") for (int _i = 0; _i < 2; ++_i) \
        __builtin_amdgcn_global_load_lds((const unsigned*)((const char*)(gbase) + (voff)[_i]), (LAS unsigned*)(lds + (bufoff) + ldsw + _i * 8192), 16, 0, 0); } while (0)
#define PG8_LDA(dst, b, h) do { _Pragma("unroll") for (int m = 0; m < 4; ++m) _Pragma("unroll") for (int k = 0; k < 2; ++k) dst[m][k] = *(const LAS h16x8*)(lds + PG8_SA(b, h) + aoff + m * 2048 + k * 1024); } while (0)
#define PG8_LDB(dst, b, h) do { _Pragma("unroll") for (int n = 0; n < 2; ++n) _Pragma("unroll") for (int k = 0; k < 2; ++k) dst[n][k] = *(const LAS h16x8*)(lds + PG8_SB(b, h) + boff + n * 2048 + k * 1024); } while (0)
#define PG8_MMA(ai, bj, At, Bt) do { __builtin_amdgcn_s_setprio(1); _Pragma("unroll") for (int m = 0; m < 4; ++m) _Pragma("unroll") for (int n = 0; n < 2; ++n) _Pragma("unroll") for (int k = 0; k < 2; ++k) \
        acc[ai][bj][m][n] = __builtin_amdgcn_mfma_f32_16x16x32_f16(Bt[n][k], At[m][k], acc[ai][bj][m][n], 0, 0, 0); __builtin_amdgcn_s_setprio(0); } while (0)
#define PG8_WAIT_V(n) asm volatile("s_waitcnt vmcnt(" #n ")" ::: "memory")
#define PG8_WAIT_L(n) asm volatile("s_waitcnt lgkmcnt(" #n ")" ::: "memory")
#define PG8_BAR __builtin_amdgcn_s_barrier()
#define PG8_SCHED __builtin_amdgcn_sched_barrier(0)
    Unit cur, nxt; int ui = 0;
    if (!S.next(0, cur)) return;
    f32x4 acc[2][2][4][2];
#pragma unroll
    for (int a = 0; a < 2; ++a)
#pragma unroll
        for (int b = 0; b < 2; ++b)
#pragma unroll
            for (int m = 0; m < 4; ++m)
#pragma unroll
                for (int n = 0; n < 2; ++n) acc[a][b][m][n] = (f32x4){0.f, 0.f, 0.f, 0.f};
    h16x8 At[4][2], B0[2][2], B1[2][2];
    const char* cA = (const char*)g.A + (size_t)cur.pm * tstepA; const char* cB = (const char*)g.Bt + (size_t)cur.pn * tstepB;
    PG8_STAGE(PG8_SB(0, 0), cB, voffB); PG8_STAGE(PG8_SB(0, 1), cB + hstepB, voffB); PG8_STAGE(PG8_SA(0, 0), cA, voffA); PG8_STAGE(PG8_SA(0, 1), cA + hstepA, voffA);
    if (wr == 1) PG8_BAR;
    PG8_WAIT_V(2); PG8_BAR;
    PG8_STAGE(PG8_SB(1, 0), cB + kstep, voffB); PG8_STAGE(PG8_SA(1, 0), cA + kstep, voffA); PG8_STAGE(PG8_SB(1, 1), cB + hstepB + kstep, voffB);
    PG8_WAIT_V(6); PG8_BAR;
    for (;;) {
        const bool has_next = S.next(ui + 1, nxt);
        const char* nA = has_next ? (const char*)g.A + (size_t)nxt.pm * tstepA : cA; const char* nB = has_next ? (const char*)g.Bt + (size_t)nxt.pn * tstepB : cB;
        for (int t = 0; t < nt; t += 2) {
            const bool last = (t == nt - 2);
            const char* a1 = cA + (size_t)(t + 1) * kstep;
            const char* a2 = last ? nA : cA + (size_t)(t + 2) * kstep; const char* b2 = last ? nB : cB + (size_t)(t + 2) * kstep;
            const char* a3 = a2 + kstep; const char* b3 = b2 + kstep;
            PG8_LDB(B0, 0, 0); PG8_LDB(B1, 0, 1); PG8_SCHED; PG8_LDA(At, 0, 0); PG8_STAGE(PG8_SA(1, 1), a1 + hstepA, voffA);
            PG8_WAIT_V(8); PG8_WAIT_L(0); PG8_BAR; PG8_MMA(0, 0, At, B0); PG8_MMA(0, 1, At, B1); PG8_BAR; PG8_SCHED;
            PG8_LDA(At, 0, 1); PG8_STAGE(PG8_SB(0, 0), b2, voffB); PG8_STAGE(PG8_SB(0, 1), b2 + hstepB, voffB); PG8_STAGE(PG8_SA(0, 0), a2, voffA);
            PG8_WAIT_V(8); PG8_WAIT_L(0); PG8_BAR; PG8_MMA(1, 0, At, B0); PG8_MMA(1, 1, At, B1); PG8_BAR; PG8_SCHED;
            PG8_LDB(B0, 1, 0); PG8_LDB(B1, 1, 1); PG8_SCHED; PG8_LDA(At, 1, 0); PG8_STAGE(PG8_SA(0, 1), a2 + hstepA, voffA);
            PG8_WAIT_V(8); PG8_WAIT_L(0); PG8_BAR; PG8_MMA(0, 0, At, B0); PG8_MMA(0, 1, At, B1); PG8_BAR; PG8_SCHED;
            PG8_LDA(At, 1, 1); PG8_STAGE(PG8_SB(1, 0), b3, voffB); PG8_STAGE(PG8_SB(1, 1), b3 + hstepB, voffB); PG8_STAGE(PG8_SA(1, 0), a3, voffA);
            PG8_WAIT_V(8); PG8_WAIT_L(0); PG8_BAR; PG8_MMA(1, 0, At, B0); PG8_MMA(1, 1, At, B1); PG8_BAR; PG8_SCHED;
        }
        if (wr == 0) PG8_BAR;
        E(acc, cur, wr, wc, fr, fq);
        if (!has_next) break;
#pragma unroll
        for (int a = 0; a < 2; ++a)
#pragma unroll
            for (int b = 0; b < 2; ++b)
#pragma unroll
                for (int m = 0; m < 4; ++m)
#pragma unroll
                    for (int n = 0; n < 2; ++n) acc[a][b][m][n] = (f32x4){0.f, 0.f, 0.f, 0.f};
        cur = nxt; cA = nA; cB = nB; ++ui;
        if (wr == 1) PG8_BAR;
    }
    PG8_WAIT_V(0);
    PG8_BAR;
#undef PG8_SA
#undef PG8_SB
#undef PG8_STAGE
#undef PG8_LDA
#undef PG8_LDB
#undef PG8_MMA
#undef PG8_WAIT_V
#undef PG8_WAIT_L
#undef PG8_BAR
#undef PG8_SCHED
}
}

struct Params {
    const float* in[22];
    float* out;
    unsigned char* ws;
};

__device__ __forceinline__ void phase_mod(const float* c, const float* ada_w, const float* ada_b, float* mod, unsigned char* ldsb) {
    float* cact = (float*)ldsb;
    float* red = cact + 8192;
    int tid = threadIdx.x; LAUNDER_V(tid); int bid = blockIdx.x; LAUNDER_S(bid);
    const int lane = tid & 63, w = __builtin_amdgcn_readfirstlane(tid >> 6);
    for (int i = tid; i < 8192; i += 512) cact[i] = silu_f(c[i]);
    LDS_BARRIER();
    for (int item = bid; item < 288; item += gridDim.x) {
        const int l = item / 144, n0 = (item % 144) * 64;
        const float* W = ada_w + (unsigned)l * 1024 * 9216 + n0 + lane;
        float acc[8];
#pragma unroll
        for (int b = 0; b < 8; ++b) acc[b] = 0.f;
        const int k0 = w * 128;
#pragma unroll 16
        for (int k = k0; k < k0 + 128; ++k) {
            const float wv = W[(unsigned)k * 9216];
#pragma unroll
            for (int b = 0; b < 8; ++b) acc[b] += cact[b * 1024 + k] * wv;
        }
#pragma unroll
        for (int b = 0; b < 8; ++b) red[(w * 8 + b) * 64 + lane] = acc[b];
        LDS_BARRIER();
        {
            const int b = w;
            float s = ada_b[l * 9216 + n0 + lane];
#pragma unroll
            for (int ww = 0; ww < 8; ++ww) s += red[(ww * 8 + b) * 64 + lane];
            mod[(unsigned)(l * 8 + b) * 9216 + n0 + lane] = s;
        }
        LDS_BARRIER();
    }
}

__device__ __forceinline__ void conv_w(const float* src, int ldsrc, int coloff, int nvalid, int Ntot, int K, h16* dst, int inter, unsigned char* ldsb) {
    float* tile = (float*)ldsb;
    int tid = threadIdx.x; LAUNDER_V(tid); int bid = blockIdx.x; LAUNDER_S(bid);
    const int nkt = K / 64, ntiles = (Ntot / 128) * nkt;
    float v[16];
#define CONVW_LOAD(t_) do { const int n0_ = ((t_) / nkt) * 128, k0_ = ((t_) % nkt) * 64; \
        _Pragma("unroll") for (int it = 0; it < 16; ++it) { const int e = tid + 512 * it, kk = e >> 7, nn = e & 127, n = n0_ + nn; \
            const int nc_ = (n < nvalid) ? n : (nvalid - 1); const float x_ = gld(src + (unsigned)(k0_ + kk) * ldsrc + nc_ + coloff); v[it] = (n < nvalid) ? x_ : 0.f; } } while (0)
    if (bid < ntiles) CONVW_LOAD(bid);
    for (int t = bid; t < ntiles; t += gridDim.x) {
        const int n0 = (t / nkt) * 128, k0 = (t % nkt) * 64;
#pragma unroll
        for (int it = 0; it < 16; ++it) { const int e = tid + 512 * it, kk = e >> 7, nn = e & 127; tile[kk * 129 + nn] = v[it]; }
        LDS_BARRIER();
        if (t + (int)gridDim.x < ntiles) CONVW_LOAD(t + (int)gridDim.x);
#pragma unroll
        for (int it = 0; it < 8; ++it) {
            const int e = tid + 512 * it, nn = e >> 5, kp = e & 31, n = n0 + nn;
            const int dr = (inter >= 0) ? ((n >> 7) * 256 + inter * 128 + (n & 127)) : n;
            h16x2 o; o[0] = (h16)tile[(2 * kp) * 129 + nn]; o[1] = (h16)tile[(2 * kp + 1) * 129 + nn];
            gst((h16x2*)(dst + (unsigned)dr * K + k0 + 2 * kp), o);
        }
        LDS_BARRIER();
    }
#undef CONVW_LOAD
}

__device__ __forceinline__ void phase_norm(const float* src32, const h16* src16, const float* ln, const float* modl, int shi, int sci, h16* dst) {
    int tid = threadIdx.x; LAUNDER_V(tid); int bid = blockIdx.x; LAUNDER_S(bid);
    const int lane = tid & 63, w = __builtin_amdgcn_readfirstlane(tid >> 6);
    const int stride = gridDim.x * 16, half = gridDim.x * 8;
    f32x4 vc[2][4], vn[2][4];
#define NORM_LOAD(V, r0_) do { _Pragma("unroll") for (int u = 0; u < 2; ++u) { const int row = (r0_) + u * half; if (row < M_TOK) { \
        if (src32) { _Pragma("unroll") for (int i = 0; i < 4; ++i) V[u][i] = gld((const f32x4*)(src32 + (unsigned)row * DM + 4 * lane + 256 * i)); } \
        else { const h16x8 a_ = gld((const h16x8*)(src16 + (unsigned)row * DM + 16 * lane)), b_ = gld((const h16x8*)(src16 + (unsigned)row * DM + 16 * lane + 8)); \
               _Pragma("unroll") for (int j = 0; j < 4; ++j) { V[u][0][j] = (float)a_[j]; V[u][1][j] = (float)a_[4 + j]; V[u][2][j] = (float)b_[j]; V[u][3][j] = (float)b_[4 + j]; } } } } } while (0)
    int row0 = bid * 8 + w;
    if (row0 < M_TOK) NORM_LOAD(vc, row0);
    for (; row0 < M_TOK; row0 += stride) {
        if (row0 + stride < M_TOK) NORM_LOAD(vn, row0 + stride);
#pragma unroll
        for (int u = 0; u < 2; ++u) {
            const int row = row0 + u * half;
            if (row < M_TOK) {
                float ss = 0.f;
#pragma unroll
                for (int i = 0; i < 4; ++i) ss += vc[u][i][0] * vc[u][i][0] + vc[u][i][1] * vc[u][i][1] + vc[u][i][2] * vc[u][i][2] + vc[u][i][3] * vc[u][i][3];
                ss = wave_sum(ss, lane);
                const float rstd = rsqrtf(ss * (1.0f / 1024.0f) + 1e-6f);
                const int b = row >> 12;
                const float* sh = modl + b * 9216 + shi * 1024; const float* sc = modl + b * 9216 + sci * 1024;
#pragma unroll
                for (int i = 0; i < 4; ++i) {
                    const int col = src32 ? (4 * lane + 256 * i) : (16 * lane + 4 * i);
                    const f32x4 gv = *(const f32x4*)(ln + col), sv = *(const f32x4*)(sh + col), cv = *(const f32x4*)(sc + col);
                    h16x4 o;
#pragma unroll
                    for (int j = 0; j < 4; ++j) o[j] = (h16)(vc[u][i][j] * rstd * gv[j] * (1.0f + cv[j]) + sv[j]);
                    gst((h16x4*)(dst + (unsigned)row * DM + col), o);
                }
            }
        }
#pragma unroll
        for (int u = 0; u < 2; ++u)
#pragma unroll
            for (int i = 0; i < 4; ++i) vc[u][i] = vn[u][i];
    }
#undef NORM_LOAD
}
__device__ __forceinline__ void phase_final(const h16* src, float* outp, const float* ln) {
    int tid = threadIdx.x; LAUNDER_V(tid); int bid = blockIdx.x; LAUNDER_S(bid);
    const int lane = tid & 63, w = __builtin_amdgcn_readfirstlane(tid >> 6);
    const int stride = gridDim.x * 16, half = gridDim.x * 8;
    h16x8 vc[2][2], vn[2][2];
#define FIN_LOAD(V, r0_) do { _Pragma("unroll") for (int u = 0; u < 2; ++u) { const int row = (r0_) + u * half; if (row < M_TOK) { \
        V[u][0] = gld((const h16x8*)(src + (unsigned)row * DM + 16 * lane)); V[u][1] = gld((const h16x8*)(src + (unsigned)row * DM + 16 * lane + 8)); } } } while (0)
    f32x4 gv[4];
#pragma unroll
    for (int i = 0; i < 4; ++i) gv[i] = *(const f32x4*)(ln + 16 * lane + 4 * i);
    int row0 = bid * 8 + w;
    if (row0 < M_TOK) FIN_LOAD(vc, row0);
    for (; row0 < M_TOK; row0 += stride) {
        if (row0 + stride < M_TOK) FIN_LOAD(vn, row0 + stride);
#pragma unroll
        for (int u = 0; u < 2; ++u) {
            const int row = row0 + u * half;
            if (row < M_TOK) {
                float x[16]; float ss = 0.f;
#pragma unroll
                for (int e = 0; e < 8; ++e) { x[e] = (float)vc[u][0][e]; x[8 + e] = (float)vc[u][1][e]; }
#pragma unroll
                for (int e = 0; e < 16; ++e) ss += x[e] * x[e];
                ss = wave_sum(ss, lane);
                const float rstd = rsqrtf(ss * (1.0f / 1024.0f) + 1e-6f);
#pragma unroll
                for (int i = 0; i < 4; ++i) {
                    f32x4 o;
#pragma unroll
                    for (int j = 0; j < 4; ++j) o[j] = x[4 * i + j] * rstd * gv[i][j];
                    gst((f32x4*)(outp + (unsigned)row * DM + 16 * lane + 4 * i), o);
                }
            }
        }
#pragma unroll
        for (int u = 0; u < 2; ++u) { vc[u][0] = vn[u][0]; vc[u][1] = vn[u][1]; }
    }
#undef FIN_LOAD
}

__device__ __forceinline__ void phase_attn(const h16* Pda, h16* ob, float* lse, int pat, unsigned char* ldsb) {
    int tid = threadIdx.x; LAUNDER_V(tid); int bid = blockIdx.x; LAUNDER_S(bid);
    const int lane = tid & 63, w = __builtin_amdgcn_readfirstlane(tid >> 6), fr = lane & 15, g = lane >> 4;
    const int r = (pat == 0) ? 1 : (pat == 1 ? 4 : 16);
    const int nbk2 = 16 / r;
    h16* Ks = (h16*)ldsb;
    h16* Vs = Ks + 384 * 72;
    h16* Qs = Vs + 384 * 72;
    h16x8 pk[6], pv[6], pq[4];
#define ATT_MAP(v_) ((((v_) & 7) * 192) + ((v_) >> 3))
#define ATT_LOAD(vitem_) do { const int item_ = ATT_MAP(vitem_); const int b_ = (item_) / 192, rem_ = (item_) % 192, h_ = rem_ / 16, rest_ = rem_ % 16, p_ = rest_ / nbk2, nbA_ = 2 * (rest_ % nbk2); \
        int tl_ = tid; LAUNDER_V(tl_); const h16* base_ = Pda + (unsigned)b_ * SEQ * 2304 + h_ * 64; \
        _Pragma("unroll") for (int it = 0; it < 6; ++it) { const int c = tl_ + 512 * it, j = c >> 3, part = c & 7, s = 128 * (nbA_ - 1) + j; \
            pk[it] = (h16x8){0, 0, 0, 0, 0, 0, 0, 0}; pv[it] = pk[it]; \
            if (s >= 0) { const h16* rowp = base_ + (unsigned)(p_ + r * s) * 2304 + part * 8; pk[it] = gld((const h16x8*)(rowp + 768)); pv[it] = gld((const h16x8*)(rowp + 1536)); } } \
        _Pragma("unroll") for (int it = 0; it < 4; ++it) { const int c = tl_ + 512 * it, i = c >> 3, part = c & 7, s = 128 * nbA_ + i; \
            pq[it] = gld((const h16x8*)(base_ + (unsigned)(p_ + r * s) * 2304 + part * 8)); } } while (0)
    const int G_ = (int)gridDim.x;
    if (bid < 1536) ATT_LOAD(bid);
    for (int item = bid; item < 1536; item += G_) {
        {
        {
        const int mitem = ATT_MAP(item);
        const int b = mitem / 192, rem = mitem % 192, h = rem / 16, rest = rem % 16;
        const int p = rest / nbk2, nbA = 2 * (rest % nbk2);
#pragma unroll
        for (int it = 0; it < 6; ++it) {
            const int c = tid + 512 * it, j = c >> 3, part = c & 7;
            *(h16x8*)(Ks + j * 72 + part * 8) = pk[it];
            *(h16x8*)(Vs + j * 72 + part * 8) = pv[it];
        }
#pragma unroll
        for (int it = 0; it < 4; ++it) {
            const int c = tid + 512 * it, i = c >> 3, part = c & 7;
            *(h16x8*)(Qs + i * 72 + part * 8) = pq[it] * (h16)0.18033688f;
        }
        LDS_BARRIER();
        if (item + G_ < 1536) ATT_LOAD(item + G_);
#pragma unroll
        for (int qb = 0; qb < 2; ++qb) {
        const int nb = nbA + qb;
        const h16* Kb = Ks + 128 * qb * 72; const h16* Vb = Vs + 128 * qb * 72; const h16* Qb = Qs + 128 * qb * 72;
        float lp_pre = 0.f; h16x4 prev_pre[4];
#pragma unroll
        for (int dt = 0; dt < 4; ++dt) prev_pre[dt] = (h16x4){0, 0, 0, 0};
        if (pat > 0) {
            const unsigned tok_ = (unsigned)b * SEQ + p + r * (128 * nb + 16 * w + fr);
            lp_pre = gld(lse + tok_ * 12 + h);
#pragma unroll
            for (int dt = 0; dt < 4; ++dt) prev_pre[dt] = gld((const h16x4*)(ob + tok_ * 768 + h * 64 + 4 * g + 16 * dt));
        }
        const float slope = __builtin_amdgcn_exp2f(-8.0f * (float)(h + 1) / 12.0f);
        const float sr = slope * (float)r * 1.4426950408889634f;
        h16x8 qf[2];
#pragma unroll
        for (int kk = 0; kk < 2; ++kk) qf[kk] = *(const h16x8*)(Qb + (16 * w + fr) * 72 + 32 * kk + 8 * g);
        float sc[9][4];
        float mx = -1e30f;
        const int iq = 16 * w + fr;
        float brg[4];
#pragma unroll
        for (int rg = 0; rg < 4; ++rg) brg[rg] = -sr * (float)(fr + 128 - 4 * g - rg);
#pragma unroll
        for (int tt = 0; tt < 9; ++tt) {
            const int jt = w + tt;
            const bool tile_ok = (jt <= 15) && (nb > 0 || jt >= 8);
            if (tile_ok) {
                f32x4 acc = {0.f, 0.f, 0.f, 0.f};
#pragma unroll
                for (int kk = 0; kk < 2; ++kk) { const h16x8 kf = *(const h16x8*)(Kb + (16 * jt + fr) * 72 + 32 * kk + 8 * g); acc = MFMA16(kf, qf[kk], acc); }
                const float bt = sr * (float)(16 * tt);
#pragma unroll
                for (int rg = 0; rg < 4; ++rg) {
                    float sv = acc[rg] + (brg[rg] + bt);
                    if (tt == 0) sv = (4 * g + rg >= fr) ? sv : -1e30f;
                    if (tt == 8) sv = (4 * g + rg <= fr) ? sv : -1e30f;
                    sc[tt][rg] = sv; mx = fmaxf(mx, sv);
                }
            } else {
#pragma unroll
                for (int rg = 0; rg < 4; ++rg) sc[tt][rg] = -1e30f;
            }
        }
        mx = fmaxf(mx, shx(mx, 16, lane)); mx = fmaxf(mx, shx(mx, 32, lane));
        float lsum = 0.f;
#pragma unroll
        for (int tt = 0; tt < 9; ++tt)
#pragma unroll
            for (int rg = 0; rg < 4; ++rg) { const float pv = __builtin_amdgcn_exp2f(sc[tt][rg] - mx); sc[tt][rg] = pv; lsum += pv; }
        lsum += shx(lsum, 16, lane); lsum += shx(lsum, 32, lane);
        f32x4 o[4];
#pragma unroll
        for (int dt = 0; dt < 4; ++dt) o[dt] = (f32x4){0.f, 0.f, 0.f, 0.f};
#pragma unroll
        for (int kk2 = 0; kk2 < 5; ++kk2) {
            const int ta = 2 * kk2, tb = 2 * kk2 + 1;
            h16x8 pf;
#pragma unroll
            for (int rg = 0; rg < 4; ++rg) { pf[rg] = (h16)sc[ta][rg]; pf[4 + rg] = (tb <= 8) ? (h16)sc[tb < 9 ? tb : 8][rg] : (h16)0.f; }
            const int ja = (w + ta) < 15 ? (w + ta) : 15, jb = (w + tb) < 15 ? (w + tb) : 15;
#pragma unroll
            for (int dt = 0; dt < 4; ++dt) {
                const h16x4 va = tr_read4(Vb + (16 * ja + 4 * g + (fr >> 2)) * 72 + 16 * dt + 4 * (fr & 3));
                const h16x4 vb = tr_read4(Vb + (16 * jb + 4 * g + (fr >> 2)) * 72 + 16 * dt + 4 * (fr & 3));
                o[dt] = MFMA16(cat8(va, vb), pf, o[dt]);
            }
        }
        {
            const int t = p + r * (128 * nb + iq);
            const unsigned tok = (unsigned)b * SEQ + t;
            const float inv = 1.0f / lsum, lse_p = (mx + __builtin_amdgcn_logf(lsum)) * 0.6931471805599453f;
            float w1 = 0.f, w2 = inv, lse_new = lse_p;
            if (pat > 0) {
                const float lp = lp_pre, m2 = fmaxf(lp, lse_p), e1 = fexp(lp - m2), e2 = fexp(lse_p - m2), den = e1 + e2;
                w1 = e1 / den; w2 = e2 * inv / den; lse_new = m2 + flog(den);
            }
            h16* op = ob + tok * 768 + h * 64 + 4 * g;
#pragma unroll
            for (int dt = 0; dt < 4; ++dt) {
                h16x4 prev = {0, 0, 0, 0};
                if (pat > 0) prev = prev_pre[dt];
                h16x4 res;
#pragma unroll
                for (int rg = 0; rg < 4; ++rg) res[rg] = (h16)(w1 * (float)prev[rg] + w2 * o[dt][rg]);
                gst((h16x4*)(op + 16 * dt), res);
            }
            if (pat < 2 && g == 0) gst(lse + tok * 12 + h, lse_new);
        }
        }
        LDS_BARRIER();
        }
    }
    }
#undef ATT_LOAD
#undef ATT_MAP
}

__device__ __forceinline__ void phase_halo(const h16* Pdn, h16* halo) {
    const int total = 8 * 64 * 3 * 384;
    int tid = threadIdx.x; LAUNDER_V(tid); int bid = blockIdx.x; LAUNDER_S(bid);
    for (int c = bid * 512 + tid; c < total; c += gridDim.x * 512) {
        const int part = c % 384, e = (c / 384) % 3, bn = c / (384 * 3), n = bn & 63, b = bn >> 6;
        if (n == 0) continue;
        *(h16x8*)(halo + ((unsigned)bn * 3 + e) * 3072 + part * 8) = *(const h16x8*)(Pdn + ((unsigned)b * SEQ + 64 * n - 3 + e) * 4096 + part * 8);
    }
}

__device__ __forceinline__ void phase_dnprep(h16* Pdn, const h16* halo, const float* bd, const float* convw, const float* a_log, const float* dt_bias,
                             h16* Tg, h16* qkg, float* gcg, float* betag, LAS unsigned char* ldsl, unsigned char* ldsb) {
    int bid = blockIdx.x; LAUNDER_S(bid);
    const int w = __builtin_amdgcn_readfirstlane((int)threadIdx.x >> 6);
    constexpr int RP = 384;
    constexpr int RAWB = 67 * RP * 2;
    h16* qn = (h16*)(ldsb + 2 * RAWB);
    h16* kn = qn + 64 * 136;
    float* Mm = (float*)(kn + 64 * 136);
    float* cw = Mm + 64 * 68;
    float* gcs = cw + 4 * 384;
    float* bts = gcs + 64;
    float cv[4] = {0.f, 0.f, 0.f, 0.f}, pbr = 0.f, par_ = 0.f;
#define PREP_FETCH(item_, buf_) do { const int b_ = (item_) >> 9, h_ = ((item_) >> 6) & 7, n_ = (item_) & 63; int t_ = threadIdx.x; LAUNDER_V(t_); const int ln_ = t_ & 63; const unsigned tok0_ = (unsigned)b_ * SEQ + 64 * n_; \
        _Pragma("unroll") for (int it = 0; it < 7; ++it) { const int blk = w + 8 * it; if (blk < 51) { const int L = blk * 1024 + ln_ * 16, row = L / 768, q = (L - row * 768) >> 4; \
            const int coff_ = (q >> 4) * 1024 + h_ * 128 + (q & 15) * 8; \
            const h16* src = (row >= 3) ? Pdn + (tok0_ + row - 3) * 4096 + coff_ : halo + ((unsigned)(b_ * 64 + n_) * 3 + row) * 3072 + coff_; \
            if (L < RAWB && (row >= 3 || n_ > 0)) __builtin_amdgcn_global_load_lds((const unsigned*)src, (LAS unsigned*)(ldsl + (buf_) * RAWB + blk * 1024), 16, 0, 0); } } \
        _Pragma("unroll") for (int j = 0; j < 4; ++j) { if (t_ < 384) cv[j] = gld(convw + j * 3072 + (t_ >> 7) * 1024 + h_ * 128 + (t_ & 127)); } \
        if (w == 0) { pbr = gld(bd + (tok0_ + ln_) * 16 + h_); par_ = gld(bd + (tok0_ + ln_) * 16 + 8 + h_); } } while (0)
    if (bid < 4096) PREP_FETCH(bid, 0);
    int cur = 0;
    for (int item = bid; item < 4096; item += gridDim.x, cur ^= 1) {
        const int b = item >> 9, h = (item >> 6) & 7, n = item & 63;
        int tl = threadIdx.x; LAUNDER_V(tl);
        const int lane = tl & 63, fr = lane & 15, g = lane >> 4;
        const unsigned tok0 = (unsigned)b * SEQ + 64 * n;
        const unsigned bh0 = (unsigned)(b * 8 + h) * SEQ + 64 * n;
        h16* raw = (h16*)(ldsb + cur * RAWB);
        float* X = (float*)raw;
        float* Zs = X + 64 * 68;
        asm volatile("s_waitcnt vmcnt(0)" ::: "memory");
        if (n == 0 && tl < 144) { int z0 = 0; LAUNDER_V(z0); const float zf = __int_as_float(z0); *(f32x4*)(raw + tl * 8) = (f32x4){zf, zf, zf, zf}; }
#pragma unroll
        for (int j = 0; j < 4; ++j) if (tl < 384) cw[j * 384 + tl] = cv[j];
        if (w == 0) {
            const float br = pbr, ar = par_;
            const float beta = 1.0f / (1.0f + fexp(-br));
            const float xs = ar + dt_bias[h];
            const float sp = (xs > 20.f) ? xs : flog(1.0f + fexp(xs));
            float gg = -fexp(a_log[h]) * sp;
#pragma unroll
            for (int o = 1; o < 64; o <<= 1) { const float t = __int_as_float(__builtin_amdgcn_ds_bpermute(((lane >= o) ? (lane - o) : lane) << 2, __float_as_int(gg))); if (lane >= o) gg += t; }
            gcs[lane] = gg; bts[lane] = beta; gst(gcg + bh0 + lane, gg); gst(betag + bh0 + lane, beta);
        }
        LDS_BARRIER();
        if (item + (int)gridDim.x < 4096) PREP_FETCH(item + (int)gridDim.x, cur ^ 1);
        {
            const int rr = lane >> 3, cp = lane & 7, i = 8 * w + rr;
            h16* gp = Pdn + (tok0 + i) * 4096 + h * 128 + 16 * cp;
            const float bt_i = bts[i];
#pragma unroll
            for (int seg = 0; seg < 3; ++seg) {
                float y[16];
#pragma unroll
                for (int e = 0; e < 16; ++e) y[e] = 0.f;
#pragma unroll
                for (int j = 0; j < 4; ++j) {
                    const h16x8 x0 = *(const h16x8*)(raw + (i + j) * RP + seg * 128 + 16 * cp), x1 = *(const h16x8*)(raw + (i + j) * RP + seg * 128 + 16 * cp + 8);
                    const f32x4* cwp = (const f32x4*)(cw + j * 384 + seg * 128 + 16 * cp);
                    const f32x4 c0 = cwp[0], c1 = cwp[1], c2 = cwp[2], c3 = cwp[3];
#pragma unroll
                    for (int e = 0; e < 4; ++e) {
                        y[e] += c0[e] * (float)x0[e]; y[4 + e] += c1[e] * (float)x0[4 + e];
                        y[8 + e] += c2[e] * (float)x1[e]; y[12 + e] += c3[e] * (float)x1[4 + e];
                    }
                }
#pragma unroll
                for (int e = 0; e < 16; ++e) y[e] = silu_f(y[e]);
                float scl = bt_i;
                if (seg < 2) {
                    float ss = 0.f;
#pragma unroll
                    for (int e = 0; e < 16; ++e) ss += y[e] * y[e];
                    ss += shx(ss, 1, lane); ss += shx(ss, 2, lane); ss += shx(ss, 4, lane);
                    scl = rsqrtf(ss + 1e-6f) * (seg == 0 ? 0.08838834764831845f : 1.0f);
                }
                h16x8 o0, o1;
#pragma unroll
                for (int e = 0; e < 8; ++e) { o0[e] = (h16)(y[e] * scl); o1[e] = (h16)(y[8 + e] * scl); }
                if (seg == 0) { *(h16x8*)(qn + i * 136 + 16 * cp) = o0; *(h16x8*)(qn + i * 136 + 16 * cp + 8) = o1; }
                if (seg == 1) { *(h16x8*)(kn + i * 136 + 16 * cp) = o0; *(h16x8*)(kn + i * 136 + 16 * cp + 8) = o1; }
                gst((h16x8*)(gp + seg * 1024), o0); gst((h16x8*)(gp + seg * 1024 + 8), o1);
            }
        }
        LDS_BARRIER();
#pragma unroll
        for (int idx0 = 0; idx0 < 4; ++idx0) {
            const int idx = w + 8 * idx0;
            const int isqk = idx >> 4, ti = (idx >> 2) & 3, tj = idx & 3;
            f32x4 acc = {0.f, 0.f, 0.f, 0.f};
            if (tj <= ti) {
                const h16* As = isqk ? qn : kn;
#pragma unroll
                for (int kk = 0; kk < 4; ++kk) {
                    const h16x8 a = *(const h16x8*)(As + (16 * ti + fr) * 136 + 32 * kk + 8 * g);
                    const h16x8 bb = *(const h16x8*)(kn + (16 * tj + fr) * 136 + 32 * kk + 8 * g);
                    acc = MFMA16(a, bb, acc);
                }
            }
#pragma unroll
            for (int rg = 0; rg < 4; ++rg) {
                const int i = 16 * ti + 4 * g + rg, j = 16 * tj + fr;
                const float dec = fexp(fminf(gcs[i] - gcs[j], 0.f));
                if (!isqk) Mm[i * 68 + j] = (j < i) ? acc[rg] * bts[i] * dec : 0.f;
                else gst(qkg + (bh0 + i) * 64 + j, (h16)((j <= i) ? acc[rg] * dec : 0.f));
            }
        }
        for (int e = tl; e < 4096; e += 512) { const int r = e >> 6, c = e & 63; if ((c >> 4) > (r >> 4)) X[r * 68 + c] = 0.f; }
        LDS_BARRIER();
        if (w < 4 && lane < 16) {
            const int q = w, c = lane;
            float x[16];
#pragma unroll
            for (int i = 0; i < 16; ++i) {
                float mrow[16];
#pragma unroll
                for (int q4 = 0; q4 < 4; ++q4) { const f32x4 t4 = *(const f32x4*)(Mm + (16 * q + i) * 68 + 16 * q + 4 * q4); mrow[4 * q4] = t4[0]; mrow[4 * q4 + 1] = t4[1]; mrow[4 * q4 + 2] = t4[2]; mrow[4 * q4 + 3] = t4[3]; }
                float sacc = (i == c) ? 1.f : 0.f;
#pragma unroll
                for (int j = 0; j < 16; ++j) if (j < i) sacc -= mrow[j] * x[j];
                x[i] = sacc;
            }
#pragma unroll
            for (int i = 0; i < 16; ++i) X[(16 * q + i) * 68 + 16 * q + c] = x[i];
        }
        LDS_BARRIER();
#pragma unroll 1
        for (int ib = 1; ib < 4; ++ib) {
            const int ncol = 16 * ib;
            for (int e = tl; e < 16 * ncol; e += 512) {
                const int r = e & 15, c = e >> 4;
                float sacc = 0.f;
#pragma unroll 1
                for (int kb = 0; kb < ib; ++kb) {
                    float mv[16], xv[16];
#pragma unroll
                    for (int q4 = 0; q4 < 4; ++q4) { const f32x4 t4 = *(const f32x4*)(Mm + (ncol + r) * 68 + 16 * kb + 4 * q4); mv[4 * q4] = t4[0]; mv[4 * q4 + 1] = t4[1]; mv[4 * q4 + 2] = t4[2]; mv[4 * q4 + 3] = t4[3]; }
#pragma unroll
                    for (int kk = 0; kk < 16; ++kk) xv[kk] = X[(16 * kb + kk) * 68 + c];
#pragma unroll
                    for (int kk = 0; kk < 16; ++kk) sacc += mv[kk] * xv[kk];
                }
                Zs[r * 52 + c] = sacc;
            }
            LDS_BARRIER();
            for (int e = tl; e < 16 * ncol; e += 512) {
                const int r = e & 15, c = e >> 4;
                float tv[16], zv[16];
#pragma unroll
                for (int q4 = 0; q4 < 4; ++q4) { const f32x4 t4 = *(const f32x4*)(X + (ncol + r) * 68 + ncol + 4 * q4); tv[4 * q4] = t4[0]; tv[4 * q4 + 1] = t4[1]; tv[4 * q4 + 2] = t4[2]; tv[4 * q4 + 3] = t4[3]; }
#pragma unroll
                for (int m = 0; m < 16; ++m) zv[m] = Zs[m * 52 + c];
                float sacc = 0.f;
#pragma unroll
                for (int m = 0; m < 16; ++m) sacc += tv[m] * zv[m];
                X[(ncol + r) * 68 + c] = -sacc;
            }
            LDS_BARRIER();
        }
        {
            const int i = tl >> 3, part = tl & 7;
            h16x8 o;
#pragma unroll
            for (int e = 0; e < 8; ++e) o[e] = (h16)X[i * 68 + 8 * part + e];
            gst((h16x8*)(Tg + (bh0 + i) * 64 + 8 * part), o);
        }
        LDS_BARRIER();
    }
#undef PREP_FETCH
}

__device__ __forceinline__ void phase_scan(h16* Pdn, const h16* Tg, const h16* qkg, const float* gcg, const float* betag, unsigned char* ldsb) {
    int tid = threadIdx.x; LAUNDER_V(tid); int bid = blockIdx.x; LAUNDER_S(bid);
    const int lane = tid & 63, w = __builtin_amdgcn_readfirstlane(tid >> 6), fr = lane & 15, g = lane >> 4;
    constexpr int OQ = 0, OK_ = 64 * 136, OT = 2 * 64 * 136, OQK = OT + 64 * 72, OV = OQK + 64 * 72, OSC = OV + 64 * 64, BUFH = OSC + 256;
    if (bid < 128) {
        const int item = bid;
        const int bh = (item & 7) * 8 + (item >> 4), s = (item >> 3) & 1, b = bh >> 3, h = bh & 7;
        f32x4 S[8];
#pragma unroll
        for (int tk = 0; tk < 8; ++tk) S[tk] = (f32x4){0.f, 0.f, 0.f, 0.f};
#define SCAN_LD(n_, R_) do { const unsigned tok0_ = (unsigned)b * SEQ + 64 * (n_), bh0_ = (unsigned)bh * SEQ + 64 * (n_); int lt = tid - 256; LAUNDER_V(lt); \
            _Pragma("unroll") for (int it = 0; it < 4; ++it) { const int c = lt + 256 * it, i = c >> 4, part = c & 15; const h16* rp = Pdn + (tok0_ + i) * 4096 + h * 128 + part * 8; \
                R_[it] = gld((const h16x8*)rp); R_[4 + it] = gld((const h16x8*)(rp + 1024)); } \
            _Pragma("unroll") for (int it = 0; it < 2; ++it) { const int c = lt + 256 * it, i = c >> 3, part = c & 7; \
                R_[8 + it] = gld((const h16x8*)(Tg + (bh0_ + i) * 64 + part * 8)); R_[10 + it] = gld((const h16x8*)(qkg + (bh0_ + i) * 64 + part * 8)); \
                R_[12 + it] = gld((const h16x8*)(Pdn + (tok0_ + i) * 4096 + 2048 + h * 128 + 64 * s + part * 8)); } \
            if (lt < 32) R_[14] = gld((const h16x8*)(((lt < 16) ? gcg : betag) + bh0_ + 4 * (lt & 15))); } while (0)
#define SCAN_ST(buf_, R_) do { h16* B_ = (h16*)ldsb + (buf_) * BUFH; int lt = tid - 256; LAUNDER_V(lt); \
            _Pragma("unroll") for (int it = 0; it < 4; ++it) { const int c = lt + 256 * it, i = c >> 4, part = c & 15; \
                *(h16x8*)(B_ + OQ + i * 136 + part * 8) = R_[it]; *(h16x8*)(B_ + OK_ + i * 136 + part * 8) = R_[4 + it]; } \
            _Pragma("unroll") for (int it = 0; it < 2; ++it) { const int c = lt + 256 * it, i = c >> 3, part = c & 7; \
                *(h16x8*)(B_ + OT + i * 72 + part * 8) = R_[8 + it]; *(h16x8*)(B_ + OQK + i * 72 + part * 8) = R_[10 + it]; *(h16x8*)(B_ + OV + i * 64 + part * 8) = R_[12 + it]; } \
            if (lt < 32) *(h16x8*)(B_ + OSC + 8 * lt) = R_[14]; } while (0)
        if (w >= 4) {
            h16x8 R0[15], R1[15], R2[15];
            SCAN_LD(0, R0); SCAN_ST(0, R0);
            SCAN_LD(1, R1); SCAN_LD(2, R2); SCAN_LD(3, R0);
            LDS_BARRIER();
#pragma unroll 1
            for (int n = 0; n < 63; n += 3) {
                SCAN_ST((n + 1) & 1, R1); if (n + 4 < 64) SCAN_LD(n + 4, R1);
                LDS_BARRIER();
                SCAN_ST((n + 2) & 1, R2); if (n + 5 < 64) SCAN_LD(n + 5, R2);
                LDS_BARRIER();
                SCAN_ST((n + 3) & 1, R0); if (n + 6 < 64) SCAN_LD(n + 6, R0);
                LDS_BARRIER();
            }
            LDS_BARRIER();
        } else {
        int tc = tid; LAUNDER_V(tc);
        __builtin_amdgcn_s_setprio(3);
        const int lane = tc & 63, fr = lane & 15, g = lane >> 4; (void)lane;
        LDS_BARRIER();
#pragma unroll 1
        for (int n = 0; n < 64; ++n) {
            const unsigned tok0 = (unsigned)b * SEQ + 64 * n;
            const h16* B = (const h16*)ldsb + (n & 1) * BUFH;
            const h16* qn = B + OQ; const h16* kn = B + OK_; const h16* Tm = B + OT; const h16* qkm = B + OQK; const h16* vbs = B + OV;
            const float* gcs = (const float*)(B + OSC); const float* bts = gcs + 64;
            {
                GAS h16* ob = (GAS h16*)(Pdn + (tok0 * 4096 + 2048 + h * 128 + 64 * s));
                const float g_last = gcs[63], e_last = fexp(g_last);
                h16x8 Sf[4];
#pragma unroll
                for (int kk = 0; kk < 4; ++kk)
#pragma unroll
                    for (int rg = 0; rg < 4; ++rg) { Sf[kk][rg] = (h16)S[2 * kk][rg]; Sf[kk][4 + rg] = (h16)S[2 * kk + 1][rg]; }
#define LD_A(F, ti_) do { _Pragma("unroll") for (int kk = 0; kk < 4; ++kk) { const h16* kp = kn + (16 * (ti_) + fr) * 136 + 32 * kk + 4 * g; const h16* qp = qn + (16 * (ti_) + fr) * 136 + 32 * kk + 4 * g; \
                    F[2 * kk] = cat8(*(const h16x4*)kp, *(const h16x4*)(kp + 16)); F[2 * kk + 1] = cat8(*(const h16x4*)qp, *(const h16x4*)(qp + 16)); } } while (0)
#define LD_T(F, base_) do { _Pragma("unroll") for (int ti = 0; ti < 4; ++ti) _Pragma("unroll") for (int k2 = 0; k2 < 2; ++k2) { const h16* tp = (base_) + (16 * ti + fr) * 72 + 32 * k2 + 4 * g; \
                    F[2 * ti + k2] = cat8(*(const h16x4*)tp, *(const h16x4*)(tp + 16)); } } while (0)
#define LD_K(F, tk0_) do { _Pragma("unroll") for (int t = 0; t < 4; ++t) _Pragma("unroll") for (int k2 = 0; k2 < 2; ++k2) { const h16* kp = kn + (32 * k2 + 4 * g + (fr >> 2)) * 136 + 16 * ((tk0_) + t) + 4 * (fr & 3); \
                    F[2 * t + k2] = cat8(tr_read4(kp), tr_read4(kp + 16 * 136)); } } while (0)
#define CP_F(D, S_) do { _Pragma("unroll") for (int q = 0; q < 8; ++q) D[q] = S_[q]; } while (0)
#define LD_S(G_, B_, V_, ti_) do { G_ = *(const f32x4*)(gcs + 16 * (ti_) + 4 * g); B_ = *(const f32x4*)(bts + 16 * (ti_) + 4 * g); V_ = tr_read4(vbs + (16 * (ti_) + 4 * g + (fr >> 2)) * 64 + 16 * w + 4 * (fr & 3)); } while (0)
                h16x8 F0[8], F1[8];
                f32x4 gc0, bt0, gc1 = {0.f, 0.f, 0.f, 0.f}, bt1 = {0.f, 0.f, 0.f, 0.f}; h16x4 vb0, vb1 = {0, 0, 0, 0};
                LD_A(F0, 0); LD_S(gc0, bt0, vb0, 0);
                f32x4 R[4], O[4];
#pragma unroll
                for (int ti = 0; ti < 4; ++ti) {
                    if (ti < 3) { LD_A(F1, ti + 1); LD_S(gc1, bt1, vb1, ti + 1); } else LD_T(F1, Tm);
                    __builtin_amdgcn_sched_barrier(0);
                    f32x4 ka = {0.f, 0.f, 0.f, 0.f}, qa = {0.f, 0.f, 0.f, 0.f};
#pragma unroll
                    for (int kk = 0; kk < 4; ++kk) { ka = MFMA16(F0[2 * kk], Sf[kk], ka); qa = MFMA16(F0[2 * kk + 1], Sf[kk], qa); }
#pragma unroll
                    for (int rg = 0; rg < 4; ++rg) { const float eg = fexp(gc0[rg]); R[ti][rg] = (float)vb0[rg] - bt0[rg] * eg * ka[rg]; O[ti][rg] = eg * qa[rg]; }
                    CP_F(F0, F1); gc0 = gc1; bt0 = bt1; vb0 = vb1;
                }
                h16x8 Rf[2];
#pragma unroll
                for (int k2 = 0; k2 < 2; ++k2)
#pragma unroll
                    for (int rg = 0; rg < 4; ++rg) { Rf[k2][rg] = (h16)R[2 * k2][rg]; Rf[k2][4 + rg] = (h16)R[2 * k2 + 1][rg]; }
                LD_T(F1, qkm);
                __builtin_amdgcn_sched_barrier(0);
                f32x4 Vn[4];
#pragma unroll
                for (int ti = 0; ti < 4; ++ti) {
                    f32x4 acc = {0.f, 0.f, 0.f, 0.f};
#pragma unroll
                    for (int k2 = 0; k2 < 2; ++k2) acc = MFMA16(F0[2 * ti + k2], Rf[k2], acc);
                    Vn[ti] = acc;
                }
                CP_F(F0, F1);
                h16x8 Vf[2], V2f[2];
#pragma unroll
                for (int k2 = 0; k2 < 2; ++k2) {
                    const f32x4 gca = *(const f32x4*)(gcs + 32 * k2 + 4 * g), gcb = *(const f32x4*)(gcs + 32 * k2 + 16 + 4 * g);
#pragma unroll
                    for (int rg = 0; rg < 4; ++rg) {
                        Vf[k2][rg] = (h16)Vn[2 * k2][rg]; Vf[k2][4 + rg] = (h16)Vn[2 * k2 + 1][rg];
                        V2f[k2][rg] = (h16)(Vn[2 * k2][rg] * fexp(g_last - gca[rg])); V2f[k2][4 + rg] = (h16)(Vn[2 * k2 + 1][rg] * fexp(g_last - gcb[rg]));
                    }
                }
                LD_K(F1, 0);
                __builtin_amdgcn_sched_barrier(0);
#pragma unroll
                for (int ti = 0; ti < 4; ++ti) {
#pragma unroll
                    for (int k2 = 0; k2 < 2; ++k2) O[ti] = MFMA16(F0[2 * ti + k2], Vf[k2], O[ti]);
#pragma unroll
                    for (int rg = 0; rg < 4; ++rg) {
                        const int i = 16 * ti + 4 * g + rg;
                        ob[i * 4096 + 16 * w + fr] = (h16)O[ti][rg];
                    }
                }
                CP_F(F0, F1);
                LD_K(F1, 4);
                __builtin_amdgcn_sched_barrier(0);
#pragma unroll
                for (int t = 0; t < 4; ++t) {
                    f32x4 acc = S[t] * e_last;
#pragma unroll
                    for (int k2 = 0; k2 < 2; ++k2) acc = MFMA16(F0[2 * t + k2], V2f[k2], acc);
                    S[t] = acc;
                }
                __builtin_amdgcn_sched_barrier(0);
#pragma unroll
                for (int t = 0; t < 4; ++t) {
                    f32x4 acc = S[4 + t] * e_last;
#pragma unroll
                    for (int k2 = 0; k2 < 2; ++k2) acc = MFMA16(F1[2 * t + k2], V2f[k2], acc);
                    S[4 + t] = acc;
                }
#undef LD_A
#undef LD_S
#undef LD_T
#undef LD_K
#undef CP_F
            }
            LDS_BARRIER();
        }
        __builtin_amdgcn_s_setprio(0);
        }
#undef SCAN_LD
#undef SCAN_ST
    }
}

__device__ __forceinline__ void phase_gnorm(h16* Pdn, const float* dn_norm) {
    int tid = threadIdx.x; LAUNDER_V(tid); int bid = blockIdx.x; LAUNDER_S(bid);
    const int lane = tid & 63, w = __builtin_amdgcn_readfirstlane(tid >> 6);
    const int hh = lane >> 3, cp = lane & 7;
    const int stride = gridDim.x * 16, half = gridDim.x * 8;
    float gn[16];
#pragma unroll
    for (int q4 = 0; q4 < 4; ++q4) { const f32x4 t4 = *(const f32x4*)(dn_norm + 16 * cp + 4 * q4); gn[4 * q4] = t4[0]; gn[4 * q4 + 1] = t4[1]; gn[4 * q4 + 2] = t4[2]; gn[4 * q4 + 3] = t4[3]; }
    h16x8 oc[2][2], zc[2][2], on[2][2], zn[2][2];
#define GN_LOAD(O_, Z_, r0_) do { _Pragma("unroll") for (int u = 0; u < 2; ++u) { const int row = (r0_) + u * half; if (row < M_TOK) { const h16* rp = Pdn + (unsigned)row * 4096 + 2048 + hh * 128 + 16 * cp; \
        O_[u][0] = gld((const h16x8*)rp); O_[u][1] = gld((const h16x8*)(rp + 8)); Z_[u][0] = gld((const h16x8*)(rp + 1024)); Z_[u][1] = gld((const h16x8*)(rp + 1032)); } } } while (0)
    int row0 = bid * 8 + w;
    if (row0 < M_TOK) GN_LOAD(oc, zc, row0);
    for (; row0 < M_TOK; row0 += stride) {
        if (row0 + stride < M_TOK) GN_LOAD(on, zn, row0 + stride);
#pragma unroll
        for (int u = 0; u < 2; ++u) {
            const int row = row0 + u * half;
            if (row < M_TOK) {
                float ss = 0.f;
#pragma unroll
                for (int e = 0; e < 8; ++e) { const float a0 = (float)oc[u][0][e], a1 = (float)oc[u][1][e]; ss += a0 * a0 + a1 * a1; }
                ss += shx(ss, 1, lane); ss += shx(ss, 2, lane); ss += shx(ss, 4, lane);
                const float rstd = rsqrtf(ss * (1.0f / 128.0f) + 1e-6f);
                h16x8 r0, r1;
#pragma unroll
                for (int e = 0; e < 8; ++e) {
                    r0[e] = (h16)((float)oc[u][0][e] * rstd * gn[e] * silu_f((float)zc[u][0][e]));
                    r1[e] = (h16)((float)oc[u][1][e] * rstd * gn[8 + e] * silu_f((float)zc[u][1][e]));
                }
                h16* wp = Pdn + (unsigned)row * 4096 + 2048 + hh * 128 + 16 * cp;
                gst((h16x8*)wp, r0); gst((h16x8*)(wp + 8), r1);
            }
        }
#pragma unroll
        for (int u = 0; u < 2; ++u) { oc[u][0] = on[u][0]; oc[u][1] = on[u][1]; zc[u][0] = zn[u][0]; zc[u][1] = zn[u][1]; }
    }
#undef GN_LOAD
}

#define XB_TMO      128
#define XB_XCNT(j)  (256  + 64 * (j))
#define XB_XSUB(j)  (1280 + 64 * (j))
#define XB_XGEN(j)  (2304 + 64 * (j))
#define XB_TOP      3328
#define XB_TOPGEN   3392
#define XCD_BAR_WORDS 3456
#define XB_SPIN_CAP (1u << 18)
__device__ __forceinline__ unsigned xb_ld(unsigned* p)              { return __hip_atomic_load(p, __ATOMIC_RELAXED, __HIP_MEMORY_SCOPE_AGENT); }
__device__ __forceinline__ unsigned xb_add(unsigned* p, unsigned v) { return __hip_atomic_fetch_add(p, v, __ATOMIC_RELAXED, __HIP_MEMORY_SCOPE_AGENT); }
__device__ __forceinline__ unsigned xb_xcc_id() { return (unsigned)__builtin_amdgcn_s_getreg((3 << 11) | 20) & 0xFu; }
#define XB_SPIN(cond, bar) do { unsigned _sp = 0; while (cond) { __builtin_amdgcn_s_sleep(1); \
    if ((++_sp & 255u) == 0u) { if (xb_ld(&(bar)[XB_TMO])) break; if (_sp > XB_SPIN_CAP) { atomicAdd(&(bar)[XB_TMO], 1u); break; } } } } while (0)
__device__ __forceinline__ void xcd_barrier_complete(unsigned* bar, unsigned x, unsigned& nloc, unsigned& nx) {
    const unsigned G = gridDim.x * gridDim.y * gridDim.z;
    unsigned sum, cnt, mine, sp = 0u;
    for (;;) {
        sum = 0u; cnt = 0u; mine = 0u;
#pragma unroll
        for (unsigned j = 0; j < 16; ++j) { const unsigned c = xb_ld(&bar[XB_XCNT(j)]); sum += c; cnt += (c > 0u) ? 1u : 0u; mine = (j == x) ? c : mine; }
        if (sum == G) break;
        __builtin_amdgcn_s_sleep(1);
        if ((++sp & 255u) == 0u) { if (xb_ld(&bar[XB_TMO])) break; if (sp > XB_SPIN_CAP) { atomicAdd(&bar[XB_TMO], 1u); break; } }
    }
    nloc = mine > 0u ? mine : 1u; nx = cnt > 0u ? cnt : 1u;
}
__device__ __forceinline__ void xcd_barrier(unsigned* bar, unsigned x, volatile LAS unsigned* st) {
    asm volatile("s_waitcnt vmcnt(0)" ::: "memory");
    __syncthreads();
    if (threadIdx.x == 0) {
        __builtin_amdgcn_s_waitcnt(0);
        unsigned nloc = st[0], nx = st[1];
        if (nloc == 0u) { xcd_barrier_complete(bar, x, nloc, nx); st[0] = nloc; st[1] = nx; }
        const unsigned old = xb_add(&bar[XB_XSUB(x)], 1u);
        const unsigned gen = old / nloc;
        if (old + 1u == (gen + 1u) * nloc) {
            __builtin_amdgcn_fence(__ATOMIC_RELEASE, "agent");
            asm volatile("s_waitcnt vmcnt(0)" ::: "memory");
            const unsigned og = xb_add(&bar[XB_TOP], 1u);
            const unsigned tg = og / nx;
            if (og + 1u == (tg + 1u) * nx) xb_add(&bar[XB_TOPGEN], 1u);
            else XB_SPIN(xb_ld(&bar[XB_TOPGEN]) == tg, bar);
            __builtin_amdgcn_fence(__ATOMIC_ACQUIRE, "agent");
            xb_add(&bar[XB_XGEN(x)], 1u);
            asm volatile("s_waitcnt vmcnt(0)" ::: "memory");
        } else {
            XB_SPIN(xb_ld(&bar[XB_XGEN(x)]) == gen, bar);
            __builtin_amdgcn_fence(__ATOMIC_ACQUIRE, "agent");
            asm volatile("s_waitcnt vmcnt(0)" ::: "memory");
        }
    }
    __syncthreads();
}

#ifndef PROBE_GEMM2
constexpr int NPROG = 15;
__constant__ unsigned char PROG[NPROG] = {0, 1, 2, 4, 5, 6, 7, 8, 10, 11, 13, 14, 15, 17, 18};
#else
constexpr int NPROG = 24;
__constant__ unsigned char PROG[NPROG] = {0, 1, 1, 2, 3, 4, 4, 5, 6, 7, 8, 8, 9, 10, 11, 12, 13, 13, 14, 15, 16, 17, 17, 18};
#endif
__global__ void __launch_bounds__(512, 2) fwd_mega(Params p) {
    extern __shared__ __attribute__((aligned(16))) unsigned char lds[];
    cg::grid_group grid = cg::this_grid();
    LAS unsigned char* ldsl = (LAS unsigned char*)lds;
    volatile LAS unsigned* bst = (volatile LAS unsigned*)(ldsl + 161792);
    if (threadIdx.x == 0) { bst[0] = 0u; bst[1] = 0u; (void)xb_add((unsigned*)(p.ws + R4_BAR) + XB_XCNT(xb_xcc_id()), 1u); }
    __syncthreads();
    { unsigned char* ws0 = p.ws; LAUNDER_S(ws0); phase_mod(p.in[1], p.in[2], p.in[3], (float*)(ws0 + R4_MOD), lds); }
    if (p.ws == nullptr) grid.sync();
    xcd_barrier((unsigned*)(p.ws + R4_BAR), xb_xcc_id(), bst);
#pragma unroll 1
    for (int pc = 0; pc < NPROG * 2; ++pc) {
        const int l = (pc >= NPROG) ? 1 : 0;
        const int sl = PROG[pc - NPROG * l];
        const int step = 19 * l + sl;
        if (l == 1 && sl == 0) continue;
        unsigned char* ws = p.ws; LAUNDER_S(ws);
            const int G = gridDim.x; int bid = blockIdx.x; LAUNDER_S(bid);
        const float* x = p.in[0];
        h16* hbuf = (h16*)p.out;
        h16* XN = (h16*)(ws + R1);
        h16* HID = (h16*)(ws + R0);
        h16* Pda = (h16*)(ws + R0);
        h16* Pdn = (h16*)(ws + R0);
        h16* OB = (h16*)(ws + R2);
        h16* GATES = (h16*)(ws + R3);
        h16* Tg = (h16*)(ws + R3_T); h16* QKg = (h16*)(ws + R3_QK); h16* HALO = (h16*)(ws + R3_HALO);
        h16* Wdn = (h16*)(ws + R3_WDN); h16* Wda = (h16*)(ws + R3_WDA);
        const size_t ffoff = (l == 1 && (sl == 1 || sl == 2)) ? 32 * MiB : 0;
        h16* W1t = (h16*)(ws + R3_W1 + ffoff); h16* W2t = (h16*)(ws + R3_W2 + ffoff);
        h16* Wg = (h16*)(ws + R4_WG); h16* Wa = (h16*)(ws + R4_WA); h16* Wb = (h16*)(ws + R4_WB); h16* Wo = (h16*)(ws + R4_WO);
        float* MOD = (float*)(ws + R4_MOD); float* BD = (float*)(ws + R4_BD); float* LSE = (float*)(ws + R4_LSE);
        float* GC = (float*)(ws + R4_GC); float* BETA = (float*)(ws + R4_BETA);


        const float* modl = MOD + (unsigned)l * 8 * 9216;
        const bool first = (step == 0) || (step == 2);
        const float* hin32 = first ? x : (const float*)nullptr;
        if (sl == 0) {
            if (step == 0) phase_norm(hin32, hbuf, p.in[4], modl, 0, 1, XN);
        } else if (sl == 1 || sl == 17) {
            pg8::Gemm gm{XN, W1t, M_TOK, 2 * FF, 1024, 1024}; pg8::StaticOrder S; S.init(M_TOK, 2 * FF, G, bid);
            pg8::EpiSwiglu E{HID}; pg8::gemm_phase(ldsl, gm, S, E);
        } else if (sl == 2 || sl == 18 || sl == 15) {
            const bool wo = (sl == 15);
            pg8::Gemm gm{wo ? XN : HID, wo ? Wo : W2t, M_TOK, 1024, wo ? 1024 : FF, wo ? 1024 : FF}; pg8::StaticOrder S; S.init(M_TOK, 1024, G, bid);
            const bool lastffn = (l == 1 && sl == 18);
            h16* HB2 = (h16*)(ws + R3 + 32 * MiB);
            if (!lastffn) {
                const int nl = (sl == 18) ? 1 : l;
                const float* modn = MOD + (unsigned)nl * 8 * 9216;
                const int nsh = (sl == 2) ? 3 : (sl == 15 ? 6 : 0);
                const float* lnn = ((sl == 2) ? p.in[5] : (sl == 15 ? p.in[6] : p.in[4])) + nl * 1024;
                const unsigned use = (l == 0) ? (sl == 2 ? 1u : (sl == 15 ? 2u : 3u)) : (sl == 2 ? 4u : 5u);
                if (first) {
                    pg8::EpiResidNorm<true> E{x, hbuf, hbuf, modl + 2 * 1024, 0.5f, XN, lnn, modn + nsh * 1024, modn + (nsh + 1) * 1024,
                                              (float*)(ws + R2), (unsigned*)(p.ws + R4_BAR + 16384), 4u * use, (float*)nullptr, ldsl + 131072};
                    pg8::gemm_phase(ldsl, gm, S, E);
                } else {
                    pg8::EpiResidNorm<false> E{nullptr, hbuf, (wo && l == 1) ? HB2 : hbuf, modl + (wo ? 5 : (sl == 2 ? 2 : 8)) * 1024, wo ? 1.0f : 0.5f, XN, lnn, modn + nsh * 1024, modn + (nsh + 1) * 1024,
                                               (float*)(ws + R2), (unsigned*)(p.ws + R4_BAR + 16384), 4u * use, (float*)nullptr, ldsl + 131072};
                    pg8::gemm_phase(ldsl, gm, S, E);
                }
            } else {
                pg8::EpiResidNorm<false, true> E{nullptr, HB2, HB2, modl + 8 * 1024, 0.5f, XN, p.in[21], p.in[21], p.in[21],
                                                 (float*)(ws + R2), (unsigned*)(p.ws + R4_BAR + 16384), 4u * 6u, p.out, ldsl + 131072};
                pg8::gemm_phase(ldsl, gm, S, E);
            }
        } else if (sl == 4 || sl == 8 || sl == 13) {
            if (sl == 13) phase_gnorm(Pdn, p.in[14] + l * 128);
            const int N = (sl == 4) ? 2560 : (sl == 8 ? 4096 : 2048);
            pg8::Gemm gm{XN, sl == 4 ? Wda : (sl == 8 ? Wdn : Wg), M_TOK, N, 1024, 1024}; pg8::StaticOrder S; S.init(M_TOK, N, G, bid);
            pg8::EpiStore E{sl == 4 ? Pda : (sl == 8 ? Pdn : GATES), sl == 4 ? 2304 : (sl == 8 ? 4096 : 2048), BD, sl == 4 ? 9 : (sl == 8 ? 16 : 8), sl == 13 ? 1 : 0, sl == 8 ? HALO : (h16*)nullptr};
            pg8::gemm_phase(ldsl, gm, S, E);
        } else if (sl >= 5 && sl <= 7) {
            phase_attn(Pda, OB, LSE, sl - 5, lds);
        } else if (sl == 10) {
            phase_dnprep(Pdn, HALO, BD, p.in[11] + (unsigned)l * 4 * 3072, p.in[12] + l * 8, p.in[13] + l * 8, Tg, QKg, GC, BETA, ldsl, lds);
        } else if (sl == 11) {
            phase_scan(Pdn, Tg, QKg, GC, BETA, lds);
        } else if (sl == 14) {
#pragma unroll 1
            for (int q = 0; q < 2; ++q) {
                pg8::Gemm gm{q ? OB : Pdn + 2048, q ? Wb : Wa, M_TOK, 1024, q ? 768 : 1024, q ? 768 : 4096}; pg8::StaticOrder S; S.init(M_TOK, 1024, G, bid);
                pg8::EpiMerge E{XN, GATES, q ? 1024 : 0, q}; pg8::gemm_phase(ldsl, gm, S, E);
                __syncthreads();
            }
        }
        {
            const int ck = (sl == 0) ? 0 : (sl == 2 ? 3 : (sl == 15 ? 16 : ((sl == 18 && l == 0) ? 0 : -1)));
            const int cl = (sl == 18) ? 1 : l;
            h16* cW1 = (h16*)(ws + R3_W1 + ((sl == 18) ? 32 * MiB : 0)); h16* cW2 = (h16*)(ws + R3_W2 + ((sl == 18) ? 32 * MiB : 0));
            if (ck >= 0) {
            const int nconv = (ck == 3) ? 7 : 3;
    #pragma unroll 1
                for (int ci = 0; ci < nconv; ++ci) {
                    const float* src; int ldsrc, coloff = 0, nvalid, Ntot, K = 1024, inter = -1; h16* dst;
                    if (ck == 3) {
                        const float* win = p.in[10] + (unsigned)l * 1024 * 8464;
                        if (ci == 0)      { src = win; ldsrc = 8464; coloff = 4112; nvalid = 2304; Ntot = 2304; dst = Wda; }
                        else if (ci == 1) { src = win; ldsrc = 8464; coloff = 0;    nvalid = 4096; Ntot = 4096; dst = Wdn; }
                        else if (ci == 6) { src = win; ldsrc = 8464; coloff = 4096; nvalid = 16;   Ntot = 256;  dst = Wda + 2304 * 1024; }
                        else if (ci == 2) { src = win; ldsrc = 8464; coloff = 6416; nvalid = 2048; Ntot = 2048; dst = Wg; }
                        else if (ci == 3) { src = p.in[15] + (unsigned)l * 1024 * 1024; ldsrc = 1024; nvalid = 1024; Ntot = 1024; dst = Wa; }
                        else if (ci == 4) { src = p.in[16] + (unsigned)l * 768 * 1024;  ldsrc = 1024; nvalid = 1024; Ntot = 1024; K = 768; dst = Wb; }
                        else              { src = p.in[17] + (unsigned)l * 1024 * 1024; ldsrc = 1024; nvalid = 1024; Ntot = 1024; dst = Wo; }
                    } else {
                        const bool f2 = (ck == 16);
                        if (ci == 0)      { src = (f2 ? p.in[18] : p.in[7]) + (unsigned)cl * 1024 * FF; ldsrc = FF; nvalid = FF; Ntot = FF; dst = cW1; inter = 0; }
                        else if (ci == 1) { src = (f2 ? p.in[19] : p.in[8]) + (unsigned)cl * 1024 * FF; ldsrc = FF; nvalid = FF; Ntot = FF; dst = cW1; inter = 1; }
                        else              { src = (f2 ? p.in[20] : p.in[9]) + (unsigned)cl * FF * 1024; ldsrc = 1024; nvalid = 1024; Ntot = 1024; K = FF; dst = cW2; }
                    }
                    conv_w(src, ldsrc, coloff, nvalid, Ntot, K, dst, inter, lds);
                }

            }
        }
        xcd_barrier((unsigned*)(p.ws + R4_BAR), xb_xcc_id(), bst);
    }
}

extern "C" void kernel_launch(void* const* d_in, const int* in_sizes, int n_in, void* d_out, int out_size, void* d_ws, size_t ws_size, hipStream_t stream) {
    static int grid = 0;
    if (grid == 0) {
        if (n_in != 22 || ws_size < WS_NEED) { fprintf(stderr, "kernel_launch: unexpected n_in %d or ws_size %zu (< %zu)\n", n_in, ws_size, (size_t)WS_NEED); grid = -1; return; }
        int dev = 0, cus = 0, per_cu = 0;
        hipGetDevice(&dev);
        hipDeviceGetAttribute(&cus, hipDeviceAttributeMultiprocessorCount, dev);
        hipFuncSetAttribute((const void*)fwd_mega, hipFuncAttributeMaxDynamicSharedMemorySize, LDS_BYTES);
        hipOccupancyMaxActiveBlocksPerMultiprocessor(&per_cu, (const void*)fwd_mega, 512, LDS_BYTES);
        if (per_cu < 1) per_cu = 1;
        if (per_cu > 1) per_cu = 1;
        grid = cus * per_cu;
        (void)hipGetLastError();
    }
    if (grid < 0) return;
    Params p{};
    for (int i = 0; i < 22; ++i) p.in[i] = (const float*)d_in[i];
    p.out = (float*)d_out; p.ws = (unsigned char*)d_ws;
    (void)hipMemsetAsync((unsigned char*)d_ws + R4_BAR, 0, 32768, stream);
    void* args[] = {&p};
    hipError_t e = hipLaunchCooperativeKernel((const void*)fwd_mega, dim3(grid), dim3(512), args, LDS_BYTES, stream);
    if (e != hipSuccess) fprintf(stderr, "cooperative launch failed: %s (grid %d)\n", hipGetErrorString(e), grid);
}
```

```cpp
#include <hip/hip_runtime.h>
#include <hip/hip_cooperative_groups.h>
#include <cstdio>
namespace cg = cooperative_groups;

typedef _Float16 h16;
typedef _Float16 h16x2 __attribute__((ext_vector_type(2)));
typedef _Float16 h16x4 __attribute__((ext_vector_type(4)));
typedef _Float16 h16x8 __attribute__((ext_vector_type(8)));
typedef float f32x4 __attribute__((ext_vector_type(4)));
#define LAS __attribute__((address_space(3)))
#define GAS __attribute__((address_space(1)))
template <class T> __device__ __forceinline__ T gld(const T* p) { return *(const GAS T*)p; }
template <class T> __device__ __forceinline__ void gst(T* p, T v) { *(GAS T*)p = v; }

constexpr int M_TOK = 32768, DM = 1024, FF = 2816, SEQ = 4096;
constexpr size_t MiB = 1024ull * 1024ull;
constexpr size_t R0 = 0;
constexpr size_t R1 = 256 * MiB;
constexpr size_t R2 = 320 * MiB;
constexpr size_t R3 = 368 * MiB;
constexpr size_t R4 = 496 * MiB;
constexpr size_t R3_T = R3, R3_QK = R3 + 32 * MiB, R3_HALO = R3 + 64 * MiB, R3_WDN = R3 + 74 * MiB, R3_WDA = R3 + 83 * MiB;
constexpr size_t R3_W1 = R3, R3_W2 = R3 + 12 * MiB;
constexpr size_t KiB = 1024ull;
constexpr size_t R4_WG = R4, R4_WA = R4 + 4096 * KiB, R4_WB = R4 + 6144 * KiB, R4_WO = R4 + 7680 * KiB, R4_MOD = R4 + 9728 * KiB,
                 R4_BD = R4 + 10496 * KiB, R4_LSE = R4 + 12544 * KiB, R4_GC = R4 + 14080 * KiB, R4_BETA = R4 + 15104 * KiB, R4_BAR = R4 + 16256 * KiB;
constexpr size_t WS_NEED = 512 * MiB;
constexpr int LDS_BYTES = 161792 + 64;

__device__ __forceinline__ float shx(float v, int m, int lane) { return __int_as_float(__builtin_amdgcn_ds_bpermute((lane ^ m) << 2, __float_as_int(v))); }
__device__ __forceinline__ float wave_sum(float v, int lane) {
#pragma unroll
    for (int o = 32; o > 0; o >>= 1) v += shx(v, o, lane);
    return v;
}
__device__ __forceinline__ float fexp(float x) { return __builtin_amdgcn_exp2f(x * 1.4426950408889634f); }
__device__ __forceinline__ float flog(float x) { return __builtin_amdgcn_logf(x) * 0.6931471805599453f; }
__device__ __forceinline__ float silu_f(float x) { return x * __builtin_amdgcn_rcpf(1.0f + fexp(-x)); }
__device__ __forceinline__ float sigm_f(float x) { return __builtin_amdgcn_rcpf(1.0f + fexp(-x)); }
__device__ __forceinline__ h16x8 cat8(h16x4 a, h16x4 b) { return __builtin_shufflevector(a, b, 0, 1, 2, 3, 4, 5, 6, 7); }
typedef short s16x4v __attribute__((__vector_size__(8)));
__device__ __forceinline__ h16x4 tr_read4(const h16* p) { return __builtin_bit_cast(h16x4, __builtin_amdgcn_ds_read_tr16_b64_v4i16((LAS s16x4v*)p)); }
#define LDS_BARRIER() do { asm volatile("s_waitcnt lgkmcnt(0)" ::: "memory"); __builtin_amdgcn_s_barrier(); asm volatile("" ::: "memory"); } while (0)
#define LAUNDER_V(x) asm volatile("" : "+v"(x))
#define LAUNDER_S(x) asm volatile("" : "+s"(x))
#define MFMA16(a, b, c) __builtin_amdgcn_mfma_f32_16x16x32_f16((a), (b), (c), 0, 0, 0)

namespace pg8 {
constexpr int BM = 256, BK = 64, HALF = 128, HTB = HALF * BK * 2, NXCD = 8, WGM = 8;
__device__ __forceinline__ int lds_byte(int r, int c) { const int st = (r >> 4) * 2 + (c >> 5), rr = r & 15, cc = c & 31, ob = rr * 64 + cc * 2; return st * 1024 + (ob ^ (((ob >> 9) & 1) << 5)); }
__device__ __forceinline__ void stage_rc(int b, int& R, int& C) { const int st = b / 1024, sb = b % 1024, swz = sb ^ (((sb >> 9) & 1) << 5); R = (st >> 1) * 16 + swz / 64; C = (st & 1) * 32 + (swz % 64) / 2; }
__device__ __forceinline__ int perm32(int rho) { const int n = rho >> 4, i = rho & 15; return 8 * (i >> 2) + 4 * n + (i & 3); }
struct Unit { int pm, pn; };
struct Gemm { const h16* A; const h16* Bt; int M, N, K, lda; };
struct StaticOrder {
    int nM, nN, nwg, G, c;
    __device__ void init(int M, int N, int G_, int c_) { nM = M / BM; nN = N / BM; nwg = nM * nN; G = G_; c = c_; }
    __device__ bool next(int i, Unit& u) const {
        const long L = (long)i * G + c; if (L >= nwg) return false;
        int wgid = (int)L; { const int q = nwg / NXCD, r = nwg % NXCD, xcd = wgid % NXCD, off = wgid / NXCD; wgid = (xcd < r ? xcd * (q + 1) : r * (q + 1) + (xcd - r) * q) + off; }
        const int nig = WGM * nN, gid = wgid / nig, fm = gid * WGM, gsz = (nM - fm) < WGM ? (nM - fm) : WGM;
        u.pm = fm + ((wgid % nig) % gsz); u.pn = (wgid % nig) / gsz; return true;
    }
};

struct EpiSwiglu {
    static constexpr bool PERM = true;
    h16* O;
    __device__ __forceinline__ void operator()(const f32x4 (&acc)[2][2][4][2], const Unit& u, int wr, int wc, int fr, int fq) const {
        const int row0 = u.pm * BM + wr * 64 + fr, col0 = u.pn * 128 + wc * 32 + 8 * fq;
#pragma unroll
        for (int ai = 0; ai < 2; ++ai)
#pragma unroll
            for (int m = 0; m < 4; ++m) {
                h16x8 o;
#pragma unroll
                for (int n = 0; n < 2; ++n)
#pragma unroll
                    for (int j = 0; j < 4; ++j) o[4 * n + j] = (h16)(silu_f(acc[ai][0][m][n][j]) * acc[ai][1][m][n][j]);
                *(h16x8*)(O + (unsigned)(row0 + ai * HALF + m * 16) * FF + col0) = o;
            }
    }
};
struct EpiStore {
    static constexpr bool PERM = true;
    h16* O; int ldc; float* bd; int nmain; int act; h16* halo;
    __device__ __forceinline__ void operator()(const f32x4 (&acc)[2][2][4][2], const Unit& u, int wr, int wc, int fr, int fq) const {
        const int row0 = u.pm * BM + wr * 64 + fr;
        if (u.pn < nmain) {
            const int col0 = u.pn * BM + wc * 32 + 8 * fq;
#pragma unroll
            for (int ai = 0; ai < 2; ++ai)
#pragma unroll
                for (int m = 0; m < 4; ++m)
#pragma unroll
                    for (int bj = 0; bj < 2; ++bj) {
                        h16x8 o;
#pragma unroll
                        for (int n = 0; n < 2; ++n)
#pragma unroll
                            for (int j = 0; j < 4; ++j) { float v = acc[ai][bj][m][n][j]; if (act) v = sigm_f(v); o[4 * n + j] = (h16)v; }
                        *(h16x8*)(O + (unsigned)(row0 + ai * HALF + m * 16) * ldc + col0 + bj * HALF) = o;
                        if (halo && m == 3 && fr >= 13 && u.pn < 12) {
                            const int row = row0 + ai * HALF + 48, nc = ((row & 4095) >> 6) + 1;
                            if (nc < 64) *(h16x8*)(halo + ((unsigned)((row >> 12) * 64 + nc) * 3 + (fr - 13)) * 3072 + col0 + bj * HALF) = o;
                        }
                    }
        } else if (wc == 0 && fq < 2) {
#pragma unroll
            for (int ai = 0; ai < 2; ++ai)
#pragma unroll
                for (int m = 0; m < 4; ++m)
#pragma unroll
                    for (int n = 0; n < 2; ++n) *(f32x4*)(bd + (unsigned)(row0 + ai * HALF + m * 16) * 16 + 8 * fq + 4 * n) = acc[ai][0][m][n];
        }
    }
};
struct EpiResid {
    static constexpr bool PERM = true;
    const float* in32; const h16* in16; h16* out; const float* gate; float coef;
    __device__ __forceinline__ void operator()(const f32x4 (&acc)[2][2][4][2], const Unit& u, int wr, int wc, int fr, int fq) const {
        const int row0 = u.pm * BM + wr * 64 + fr, col0 = u.pn * BM + wc * 32 + 8 * fq;
        const int b = (u.pm * BM) >> 12;
        f32x4 gv[2][2];
#pragma unroll
        for (int bj = 0; bj < 2; ++bj)
#pragma unroll
            for (int n = 0; n < 2; ++n) gv[bj][n] = *(const f32x4*)(gate + b * 9216 + col0 + bj * HALF + 4 * n) * coef;
        if (in32) {
#pragma unroll
            for (int ai = 0; ai < 2; ++ai)
#pragma unroll
                for (int m = 0; m < 4; ++m)
#pragma unroll
                    for (int bj = 0; bj < 2; ++bj) {
                        const unsigned off = (unsigned)(row0 + ai * HALF + m * 16) * DM + col0 + bj * HALF;
                        const f32x4 x0 = *(const f32x4*)(in32 + off), x1 = *(const f32x4*)(in32 + off + 4);
                        h16x8 o;
#pragma unroll
                        for (int j = 0; j < 4; ++j) { o[j] = (h16)(x0[j] + gv[bj][0][j] * acc[ai][bj][m][0][j]); o[4 + j] = (h16)(x1[j] + gv[bj][1][j] * acc[ai][bj][m][1][j]); }
                        *(h16x8*)(out + off) = o;
                    }
        } else {
#pragma unroll
            for (int ai = 0; ai < 2; ++ai)
#pragma unroll
                for (int m = 0; m < 4; ++m)
#pragma unroll
                    for (int bj = 0; bj < 2; ++bj) {
                        const unsigned off = (unsigned)(row0 + ai * HALF + m * 16) * DM + col0 + bj * HALF;
                        const h16x8 xv = *(const h16x8*)(in16 + off);
                        h16x8 o;
#pragma unroll
                        for (int j = 0; j < 4; ++j) { o[j] = (h16)((float)xv[j] + gv[bj][0][j] * acc[ai][bj][m][0][j]); o[4 + j] = (h16)((float)xv[4 + j] + gv[bj][1][j] * acc[ai][bj][m][1][j]); }
                        *(h16x8*)(out + off) = o;
                    }
        }
    }
};
template <bool F32IN, bool FINAL = false> struct EpiResidNorm {
    static constexpr bool PERM = true;
    const float* in32; const h16* in16; h16* out; const float* gate; float coef;
    h16* xn; const float* ln; const float* shp; const float* scp;
    float* ss; unsigned* cnt; unsigned target;
    float* fout;
    LAS unsigned char* sm;
    __device__ __forceinline__ void operator()(const f32x4 (&acc)[2][2][4][2], const Unit& u, int wr, int wc, int fr, int fq) const {
        const int lane = fq * 16 + fr, wid = wr * 4 + wc, tid = wid * 64 + lane;
        const int row0 = u.pm * BM + wr * 64 + fr, col0 = u.pn * BM + wc * 32 + 8 * fq;
        const int b = (u.pm * BM) >> 12;
        LAS float* red = (LAS float*)sm; LAS float* rs = red + 1024;
        f32x4 gv[2][2];
#pragma unroll
        for (int bj = 0; bj < 2; ++bj)
#pragma unroll
            for (int n = 0; n < 2; ++n) gv[bj][n] = *(const f32x4*)(gate + b * 9216 + col0 + bj * HALF + 4 * n) * coef;
        h16x8 ov[2][4][2];
#pragma unroll
        for (int ai = 0; ai < 2; ++ai)
#pragma unroll
            for (int m = 0; m < 4; ++m) {
                float sq = 0.f;
#pragma unroll
                for (int bj = 0; bj < 2; ++bj) {
                    const unsigned off = (unsigned)(row0 + ai * HALF + m * 16) * DM + col0 + bj * HALF;
                    f32x4 xa, xb;
                    if (F32IN) { xa = *(const f32x4*)(in32 + off); xb = *(const f32x4*)(in32 + off + 4); }
                    else { const h16x8 xv = *(const h16x8*)(in16 + off); xa = (f32x4){(float)xv[0], (float)xv[1], (float)xv[2], (float)xv[3]}; xb = (f32x4){(float)xv[4], (float)xv[5], (float)xv[6], (float)xv[7]}; }
                    h16x8 o;
#pragma unroll
                    for (int j = 0; j < 4; ++j) { o[j] = (h16)(xa[j] + gv[bj][0][j] * acc[ai][bj][m][0][j]); o[4 + j] = (h16)(xb[j] + gv[bj][1][j] * acc[ai][bj][m][1][j]); }
                    if (!FINAL) *(h16x8*)(out + off) = o;
                    ov[ai][m][bj] = o;
#pragma unroll
                    for (int j = 0; j < 8; ++j) sq += (float)o[j] * (float)o[j];
                }
                sq += shx(sq, 16, lane); sq += shx(sq, 32, lane);
                if (fq == 0) red[(ai * HALF + wr * 64 + m * 16 + fr) * 4 + wc] = sq;
            }
        asm volatile("s_waitcnt lgkmcnt(0)" ::: "memory"); __builtin_amdgcn_s_barrier(); asm volatile("" ::: "memory");
        if (tid < 256) {
            const float part = (red[tid * 4 + 0] + red[tid * 4 + 1]) + (red[tid * 4 + 2] + red[tid * 4 + 3]);
            __hip_atomic_store(ss + (unsigned)(u.pm * 4 + u.pn) * 256 + tid, part, __ATOMIC_RELAXED, __HIP_MEMORY_SCOPE_AGENT);
        }
        asm volatile("s_waitcnt vmcnt(0)" ::: "memory");
        __builtin_amdgcn_s_barrier(); asm volatile("" ::: "memory");
        if (tid == 0) {
            (void)__hip_atomic_fetch_add(cnt + 16 * u.pm, 1u, __ATOMIC_RELAXED, __HIP_MEMORY_SCOPE_AGENT);
            unsigned spins = 0;
            while (__hip_atomic_load(cnt + 16 * u.pm, __ATOMIC_RELAXED, __HIP_MEMORY_SCOPE_AGENT) < target) { __builtin_amdgcn_s_sleep(1); if (++spins > (1u << 20)) break; }
        }
        __builtin_amdgcn_s_barrier(); asm volatile("" ::: "memory");
        if (tid < 256) {
            float tot = 0.f;
#pragma unroll
            for (int q = 0; q < 4; ++q) tot += __hip_atomic_load(ss + (unsigned)(u.pm * 4 + q) * 256 + tid, __ATOMIC_RELAXED, __HIP_MEMORY_SCOPE_AGENT);
            rs[tid] = rsqrtf(tot * (1.0f / 1024.0f) + 1e-6f);
        }
        asm volatile("s_waitcnt lgkmcnt(0)" ::: "memory"); __builtin_amdgcn_s_barrier(); asm volatile("" ::: "memory");
        const float* sh = FINAL ? ln : shp + b * 9216; const float* sc = FINAL ? ln : scp + b * 9216;
#pragma unroll
        for (int bj = 0; bj < 2; ++bj) {
            const int col = col0 + bj * HALF;
            const f32x4 l0 = *(const f32x4*)(ln + col), l1 = *(const f32x4*)(ln + col + 4), s0 = *(const f32x4*)(sh + col), s1 = *(const f32x4*)(sh + col + 4),
                        c0 = *(const f32x4*)(sc + col), c1 = *(const f32x4*)(sc + col + 4);
#pragma unroll
            for (int ai = 0; ai < 2; ++ai)
#pragma unroll
                for (int m = 0; m < 4; ++m) {
                    const float rstd = rs[ai * HALF + wr * 64 + m * 16 + fr];
                    const h16x8 o = ov[ai][m][bj];
                    if (FINAL) {
                        f32x4 y0, y1;
#pragma unroll
                        for (int j = 0; j < 4; ++j) { y0[j] = (float)o[j] * rstd * l0[j]; y1[j] = (float)o[4 + j] * rstd * l1[j]; }
                        float* yp = fout + (unsigned)(row0 + ai * HALF + m * 16) * DM + col;
                        *(f32x4*)yp = y0; *(f32x4*)(yp + 4) = y1;
                    } else {
                        h16x8 y;
#pragma unroll
                        for (int j = 0; j < 4; ++j) { y[j] = (h16)((float)o[j] * rstd * l0[j] * (1.0f + c0[j]) + s0[j]); y[4 + j] = (h16)((float)o[4 + j] * rstd * l1[j] * (1.0f + c1[j]) + s1[j]); }
                        *(h16x8*)(xn + (unsigned)(row0 + ai * HALF + m * 16) * DM + col) = y;
                    }
                }
        }
    }
};
struct EpiMerge {
    static constexpr bool PERM = true;
    h16* Mg; const h16* gates; int goff; int add;
    __device__ __forceinline__ void operator()(const f32x4 (&acc)[2][2][4][2], const Unit& u, int wr, int wc, int fr, int fq) const {
        const int row0 = u.pm * BM + wr * 64 + fr, col0 = u.pn * BM + wc * 32 + 8 * fq;
#pragma unroll
        for (int ai = 0; ai < 2; ++ai)
#pragma unroll
            for (int m = 0; m < 4; ++m)
#pragma unroll
                for (int bj = 0; bj < 2; ++bj) {
                    const unsigned row = (unsigned)(row0 + ai * HALF + m * 16);
                    const int col = col0 + bj * HALF;
                    const h16x8 gv = *(const h16x8*)(gates + row * 2048 + goff + col);
                    h16x8 pv = {0, 0, 0, 0, 0, 0, 0, 0};
                    if (add) pv = *(const h16x8*)(Mg + row * DM + col);
                    h16x8 o;
#pragma unroll
                    for (int n = 0; n < 2; ++n)
#pragma unroll
                        for (int j = 0; j < 4; ++j) o[4 * n + j] = (h16)((float)pv[4 * n + j] + (float)gv[4 * n + j] * acc[ai][bj][m][n][j]);
                    *(h16x8*)(Mg + row * DM + col) = o;
                }
    }
};

template <class Epi>
__device__ __forceinline__ void gemm_phase(LAS unsigned char* lds, const Gemm g, const StaticOrder& S, const Epi& E) {
    int tid = threadIdx.x; LAUNDER_V(tid);
    const int wid = __builtin_amdgcn_readfirstlane(tid >> 6), lane = tid & 63, wr = wid >> 2, wc = wid & 3, fr = lane & 15, fq = lane >> 4;
    const int K = g.K, nt = K / BK;
    unsigned voffA[2], voffB[2];
#pragma unroll
    for (int i = 0; i < 2; ++i) { int R, C; stage_rc(tid * 16 + i * 8192, R, C); const int Rb = Epi::PERM ? ((R & ~31) + perm32(R & 31)) : R;
        voffA[i] = (unsigned)(R * g.lda + C) * 2u; voffB[i] = (unsigned)(Rb * K + C) * 2u; }
    const size_t kstep = (size_t)(BK * 2);
    const size_t hstepA = (size_t)HALF * g.lda * 2, hstepB = (size_t)HALF * K * 2;
    const size_t tstepA = 2 * hstepA, tstepB = 2 * hstepB;
    const unsigned ldsw = (unsigned)wid * 1024u;
    const int aoff = lds_byte(wr * 64 + fr, fq * 8), boff = lds_byte(wc * 32 + fr, fq * 8);
#define PG8_SA(b, h) (((b) * 2 + (h)) * HTB)
#define PG8_SB(b, h) ((4 + (b) * 2 + (h)) * HTB)
#define PG8_STAGE(bufoff, gbase, voff) do { _Pragma("unroll") for (int _i = 0; _i < 2; ++_i) \
        __builtin_amdgcn_global_load_lds((const unsigned*)((const char*)(gbase) + (voff)[_i]), (LAS unsigned*)(lds + (bufoff) + ldsw + _i * 8192), 16, 0, 0); } while (0)
#define PG8_LDA(dst, b, h) do { _Pragma("unroll") for (int m = 0; m < 4; ++m) _Pragma("unroll") for (int k = 0; k < 2; ++k) dst[m][k] = *(const LAS h16x8*)(lds + PG8_SA(b, h) + aoff + m * 2048 + k * 1024); } while (0)
#define PG8_LDB(dst, b, h) do { _Pragma("unroll") for (int n = 0; n < 2; ++n) _Pragma("unroll") for (int k = 0; k < 2; ++k) dst[n][k] = *(const LAS h16x8*)(lds + PG8_SB(b, h) + boff + n * 2048 + k * 1024); } while (0)
#define PG8_MMA(ai, bj, At, Bt) do { __builtin_amdgcn_s_setprio(1); _Pragma("unroll") for (int m = 0; m < 4; ++m) _Pragma("unroll") for (int n = 0; n < 2; ++n) _Pragma("unroll") for (int k = 0; k < 2; ++k) \
        acc[ai][bj][m][n] = __builtin_amdgcn_mfma_f32_16x16x32_f16(Bt[n][k], At[m][k], acc[ai][bj][m][n], 0, 0, 0); __builtin_amdgcn_s_setprio(0); } while (0)
#define PG8_WAIT_V(n) asm volatile("s_waitcnt vmcnt(" #n ")" ::: "memory")
#define PG8_WAIT_L(n) asm volatile("s_waitcnt lgkmcnt(" #n ")" ::: "memory")
#define PG8_BAR __builtin_amdgcn_s_barrier()
#define PG8_SCHED __builtin_amdgcn_sched_barrier(0)
    Unit cur, nxt; int ui = 0;
    if (!S.next(0, cur)) return;
    f32x4 acc[2][2][4][2];
#pragma unroll
    for (int a = 0; a < 2; ++a)
#pragma unroll
        for (int b = 0; b < 2; ++b)
#pragma unroll
            for (int m = 0; m < 4; ++m)
#pragma unroll
                for (int n = 0; n < 2; ++n) acc[a][b][m][n] = (f32x4){0.f, 0.f, 0.f, 0.f};
    h16x8 At[4][2], B0[2][2], B1[2][2];
    const char* cA = (const char*)g.A + (size_t)cur.pm * tstepA; const char* cB = (const char*)g.Bt + (size_t)cur.pn * tstepB;
    PG8_STAGE(PG8_SB(0, 0), cB, voffB); PG8_STAGE(PG8_SB(0, 1), cB + hstepB, voffB); PG8_STAGE(PG8_SA(0, 0), cA, voffA); PG8_STAGE(PG8_SA(0, 1), cA + hstepA, voffA);
    if (wr == 1) PG8_BAR;
    PG8_WAIT_V(2); PG8_BAR;
    PG8_STAGE(PG8_SB(1, 0), cB + kstep, voffB); PG8_STAGE(PG8_SA(1, 0), cA + kstep, voffA); PG8_STAGE(PG8_SB(1, 1), cB + hstepB + kstep, voffB);
    PG8_WAIT_V(6); PG8_BAR;
    for (;;) {
        const bool has_next = S.next(ui + 1, nxt);
        const char* nA = has_next ? (const char*)g.A + (size_t)nxt.pm * tstepA : cA; const char* nB = has_next ? (const char*)g.Bt + (size_t)nxt.pn * tstepB : cB;
        for (int t = 0; t < nt; t += 2) {
            const bool last = (t == nt - 2);
            const char* a1 = cA + (size_t)(t + 1) * kstep;
            const char* a2 = last ? nA : cA + (size_t)(t + 2) * kstep; const char* b2 = last ? nB : cB + (size_t)(t + 2) * kstep;
            const char* a3 = a2 + kstep; const char* b3 = b2 + kstep;
            PG8_LDB(B0, 0, 0); PG8_LDB(B1, 0, 1); PG8_SCHED; PG8_LDA(At, 0, 0); PG8_STAGE(PG8_SA(1, 1), a1 + hstepA, voffA);
            PG8_WAIT_V(8); PG8_WAIT_L(0); PG8_BAR; PG8_MMA(0, 0, At, B0); PG8_MMA(0, 1, At, B1); PG8_BAR; PG8_SCHED;
            PG8_LDA(At, 0, 1); PG8_STAGE(PG8_SB(0, 0), b2, voffB); PG8_STAGE(PG8_SB(0, 1), b2 + hstepB, voffB); PG8_STAGE(PG8_SA(0, 0), a2, voffA);
            PG8_WAIT_V(8); PG8_WAIT_L(0); PG8_BAR; PG8_MMA(1, 0, At, B0); PG8_MMA(1, 1, At, B1); PG8_BAR; PG8_SCHED;
            PG8_LDB(B0, 1, 0); PG8_LDB(B1, 1, 1); PG8_SCHED; PG8_LDA(At, 1, 0); PG8_STAGE(PG8_SA(0, 1), a2 + hstepA, voffA);
            PG8_WAIT_V(8); PG8_WAIT_L(0); PG8_BAR; PG8_MMA(0, 0, At, B0); PG8_MMA(0, 1, At, B1); PG8_BAR; PG8_SCHED;
            PG8_LDA(At, 1, 1); PG8_STAGE(PG8_SB(1, 0), b3, voffB); PG8_STAGE(PG8_SB(1, 1), b3 + hstepB, voffB); PG8_STAGE(PG8_SA(1, 0), a3, voffA);
            PG8_WAIT_V(8); PG8_WAIT_L(0); PG8_BAR; PG8_MMA(1, 0, At, B0); PG8_MMA(1, 1, At, B1); PG8_BAR; PG8_SCHED;
        }
        if (wr == 0) PG8_BAR;
        E(acc, cur, wr, wc, fr, fq);
        if (!has_next) break;
#pragma unroll
        for (int a = 0; a < 2; ++a)
#pragma unroll
            for (int b = 0; b < 2; ++b)
#pragma unroll
                for (int m = 0; m < 4; ++m)
#pragma unroll
                    for (int n = 0; n < 2; ++n) acc[a][b][m][n] = (f32x4){0.f, 0.f, 0.f, 0.f};
        cur = nxt; cA = nA; cB = nB; ++ui;
        if (wr == 1) PG8_BAR;
    }
    PG8_WAIT_V(0);
    PG8_BAR;
#undef PG8_SA
#undef PG8_SB
#undef PG8_STAGE
#undef PG8_LDA
#undef PG8_LDB
#undef PG8_MMA
#undef PG8_WAIT_V
#undef PG8_WAIT_L
#undef PG8_BAR
#undef PG8_SCHED
}
}

struct Params {
    const float* in[22];
    float* out;
    unsigned char* ws;
};

__device__ __forceinline__ void phase_mod(const float* c, const float* ada_w, const float* ada_b, float* mod, unsigned char* ldsb) {
    float* cact = (float*)ldsb;
    float* red = cact + 8192;
    int tid = threadIdx.x; LAUNDER_V(tid); int bid = blockIdx.x; LAUNDER_S(bid);
    const int lane = tid & 63, w = __builtin_amdgcn_readfirstlane(tid >> 6);
    for (int i = tid; i < 8192; i += 512) cact[i] = silu_f(c[i]);
    LDS_BARRIER();
    for (int item = bid; item < 288; item += gridDim.x) {
        const int l = item / 144, n0 = (item % 144) * 64;
        const float* W = ada_w + (unsigned)l * 1024 * 9216 + n0 + lane;
        float acc[8];
#pragma unroll
        for (int b = 0; b < 8; ++b) acc[b] = 0.f;
        const int k0 = w * 128;
#pragma unroll 16
        for (int k = k0; k < k0 + 128; ++k) {
            const float wv = W[(unsigned)k * 9216];
#pragma unroll
            for (int b = 0; b < 8; ++b) acc[b] += cact[b * 1024 + k] * wv;
        }
#pragma unroll
        for (int b = 0; b < 8; ++b) red[(w * 8 + b) * 64 + lane] = acc[b];
        LDS_BARRIER();
        {
            const int b = w;
            float s = ada_b[l * 9216 + n0 + lane];
#pragma unroll
            for (int ww = 0; ww < 8; ++ww) s += red[(ww * 8 + b) * 64 + lane];
            mod[(unsigned)(l * 8 + b) * 9216 + n0 + lane] = s;
        }
        LDS_BARRIER();
    }
}

__device__ __forceinline__ void conv_w(const float* src, int ldsrc, int coloff, int nvalid, int Ntot, int K, h16* dst, int inter, unsigned char* ldsb) {
    float* tile = (float*)ldsb;
    int tid = threadIdx.x; LAUNDER_V(tid); int bid = blockIdx.x; LAUNDER_S(bid);
    const int nkt = K / 64, ntiles = (Ntot / 128) * nkt;
    float v[16];
#define CONVW_LOAD(t_) do { const int n0_ = ((t_) / nkt) * 128, k0_ = ((t_) % nkt) * 64; \
        _Pragma("unroll") for (int it = 0; it < 16; ++it) { const int e = tid + 512 * it, kk = e >> 7, nn = e & 127, n = n0_ + nn; \
            const int nc_ = (n < nvalid) ? n : (nvalid - 1); const float x_ = gld(src + (unsigned)(k0_ + kk) * ldsrc + nc_ + coloff); v[it] = (n < nvalid) ? x_ : 0.f; } } while (0)
    if (bid < ntiles) CONVW_LOAD(bid);
    for (int t = bid; t < ntiles; t += gridDim.x) {
        const int n0 = (t / nkt) * 128, k0 = (t % nkt) * 64;
#pragma unroll
        for (int it = 0; it < 16; ++it) { const int e = tid + 512 * it, kk = e >> 7, nn = e & 127; tile[kk * 129 + nn] = v[it]; }
        LDS_BARRIER();
        if (t + (int)gridDim.x < ntiles) CONVW_LOAD(t + (int)gridDim.x);
#pragma unroll
        for (int it = 0; it < 8; ++it) {
            const int e = tid + 512 * it, nn = e >> 5, kp = e & 31, n = n0 + nn;
            const int dr = (inter >= 0) ? ((n >> 7) * 256 + inter * 128 + (n & 127)) : n;
            h16x2 o; o[0] = (h16)tile[(2 * kp) * 129 + nn]; o[1] = (h16)tile[(2 * kp + 1) * 129 + nn];
            gst((h16x2*)(dst + (unsigned)dr * K + k0 + 2 * kp), o);
        }
        LDS_BARRIER();
    }
#undef CONVW_LOAD
}

__device__ __forceinline__ void phase_norm(const float* src32, const h16* src16, const float* ln, const float* modl, int shi, int sci, h16* dst) {
    int tid = threadIdx.x; LAUNDER_V(tid); int bid = blockIdx.x; LAUNDER_S(bid);
    const int lane = tid & 63, w = __builtin_amdgcn_readfirstlane(tid >> 6);
    const int stride = gridDim.x * 16, half = gridDim.x * 8;
    f32x4 vc[2][4], vn[2][4];
#define NORM_LOAD(V, r0_) do { _Pragma("unroll") for (int u = 0; u < 2; ++u) { const int row = (r0_) + u * half; if (row < M_TOK) { \
        if (src32) { _Pragma("unroll") for (int i = 0; i < 4; ++i) V[u][i] = gld((const f32x4*)(src32 + (unsigned)row * DM + 4 * lane + 256 * i)); } \
        else { const h16x8 a_ = gld((const h16x8*)(src16 + (unsigned)row * DM + 16 * lane)), b_ = gld((const h16x8*)(src16 + (unsigned)row * DM + 16 * lane + 8)); \
               _Pragma("unroll") for (int j = 0; j < 4; ++j) { V[u][0][j] = (float)a_[j]; V[u][1][j] = (float)a_[4 + j]; V[u][2][j] = (float)b_[j]; V[u][3][j] = (float)b_[4 + j]; } } } } } while (0)
    int row0 = bid * 8 + w;
    if (row0 < M_TOK) NORM_LOAD(vc, row0);
    for (; row0 < M_TOK; row0 += stride) {
        if (row0 + stride < M_TOK) NORM_LOAD(vn, row0 + stride);
#pragma unroll
        for (int u = 0; u < 2; ++u) {
            const int row = row0 + u * half;
            if (row < M_TOK) {
                float ss = 0.f;
#pragma unroll
                for (int i = 0; i < 4; ++i) ss += vc[u][i][0] * vc[u][i][0] + vc[u][i][1] * vc[u][i][1] + vc[u][i][2] * vc[u][i][2] + vc[u][i][3] * vc[u][i][3];
                ss = wave_sum(ss, lane);
                const float rstd = rsqrtf(ss * (1.0f / 1024.0f) + 1e-6f);
                const int b = row >> 12;
                const float* sh = modl + b * 9216 + shi * 1024; const float* sc = modl + b * 9216 + sci * 1024;
#pragma unroll
                for (int i = 0; i < 4; ++i) {
                    const int col = src32 ? (4 * lane + 256 * i) : (16 * lane + 4 * i);
                    const f32x4 gv = *(const f32x4*)(ln + col), sv = *(const f32x4*)(sh + col), cv = *(const f32x4*)(sc + col);
                    h16x4 o;
#pragma unroll
                    for (int j = 0; j < 4; ++j) o[j] = (h16)(vc[u][i][j] * rstd * gv[j] * (1.0f + cv[j]) + sv[j]);
                    gst((h16x4*)(dst + (unsigned)row * DM + col), o);
                }
            }
        }
#pragma unroll
        for (int u = 0; u < 2; ++u)
#pragma unroll
            for (int i = 0; i < 4; ++i) vc[u][i] = vn[u][i];
    }
#undef NORM_LOAD
}
__device__ __forceinline__ void phase_final(const h16* src, float* outp, const float* ln) {
    int tid = threadIdx.x; LAUNDER_V(tid); int bid = blockIdx.x; LAUNDER_S(bid);
    const int lane = tid & 63, w = __builtin_amdgcn_readfirstlane(tid >> 6);
    const int stride = gridDim.x * 16, half = gridDim.x * 8;
    h16x8 vc[2][2], vn[2][2];
#define FIN_LOAD(V, r0_) do { _Pragma("unroll") for (int u = 0; u < 2; ++u) { const int row = (r0_) + u * half; if (row < M_TOK) { \
        V[u][0] = gld((const h16x8*)(src + (unsigned)row * DM + 16 * lane)); V[u][1] = gld((const h16x8*)(src + (unsigned)row * DM + 16 * lane + 8)); } } } while (0)
    f32x4 gv[4];
#pragma unroll
    for (int i = 0; i < 4; ++i) gv[i] = *(const f32x4*)(ln + 16 * lane + 4 * i);
    int row0 = bid * 8 + w;
    if (row0 < M_TOK) FIN_LOAD(vc, row0);
    for (; row0 < M_TOK; row0 += stride) {
        if (row0 + stride < M_TOK) FIN_LOAD(vn, row0 + stride);
#pragma unroll
        for (int u = 0; u < 2; ++u) {
            const int row = row0 + u * half;
            if (row < M_TOK) {
                float x[16]; float ss = 0.f;
#pragma unroll
                for (int e = 0; e < 8; ++e) { x[e] = (float)vc[u][0][e]; x[8 + e] = (float)vc[u][1][e]; }
#pragma unroll
                for (int e = 0; e < 16; ++e) ss += x[e] * x[e];
                ss = wave_sum(ss, lane);
                const float rstd = rsqrtf(ss * (1.0f / 1024.0f) + 1e-6f);
#pragma unroll
                for (int i = 0; i < 4; ++i) {
                    f32x4 o;
#pragma unroll
                    for (int j = 0; j < 4; ++j) o[j] = x[4 * i + j] * rstd * gv[i][j];
                    gst((f32x4*)(outp + (unsigned)row * DM + 16 * lane + 4 * i), o);
                }
            }
        }
#pragma unroll
        for (int u = 0; u < 2; ++u) { vc[u][0] = vn[u][0]; vc[u][1] = vn[u][1]; }
    }
#undef FIN_LOAD
}

__device__ __forceinline__ void phase_attn(const h16* Pda, h16* ob, float* lse, int pat, unsigned char* ldsb) {
    int tid = threadIdx.x; LAUNDER_V(tid); int bid = blockIdx.x; LAUNDER_S(bid);
    const int lane = tid & 63, w = __builtin_amdgcn_readfirstlane(tid >> 6), fr = lane & 15, g = lane >> 4;
    const int r = (pat == 0) ? 1 : (pat == 1 ? 4 : 16);
    const int nbk2 = 16 / r;
    h16* Ks = (h16*)ldsb;
    h16* Vs = Ks + 384 * 72;
    h16* Qs = Vs + 384 * 72;
    h16x8 pk[6], pv[6], pq[4];
#define ATT_MAP(v_) ((((v_) & 7) * 192) + ((v_) >> 3))
#define ATT_LOAD(vitem_) do { const int item_ = ATT_MAP(vitem_); const int b_ = (item_) / 192, rem_ = (item_) % 192, h_ = rem_ / 16, rest_ = rem_ % 16, p_ = rest_ / nbk2, nbA_ = 2 * (rest_ % nbk2); \
        int tl_ = tid; LAUNDER_V(tl_); const h16* base_ = Pda + (unsigned)b_ * SEQ * 2304 + h_ * 64; \
        _Pragma("unroll") for (int it = 0; it < 6; ++it) { const int c = tl_ + 512 * it, j = c >> 3, part = c & 7, s = 128 * (nbA_ - 1) + j; \
            pk[it] = (h16x8){0, 0, 0, 0, 0, 0, 0, 0}; pv[it] = pk[it]; \
            if (s >= 0) { const h16* rowp = base_ + (unsigned)(p_ + r * s) * 2304 + part * 8; pk[it] = gld((const h16x8*)(rowp + 768)); pv[it] = gld((const h16x8*)(rowp + 1536)); } } \
        _Pragma("unroll") for (int it = 0; it < 4; ++it) { const int c = tl_ + 512 * it, i = c >> 3, part = c & 7, s = 128 * nbA_ + i; \
            pq[it] = gld((const h16x8*)(base_ + (unsigned)(p_ + r * s) * 2304 + part * 8)); } } while (0)
    const int G_ = (int)gridDim.x;
    if (bid < 1536) ATT_LOAD(bid);
    for (int item = bid; item < 1536; item += G_) {
        {
        {
        const int mitem = ATT_MAP(item);
        const int b = mitem / 192, rem = mitem % 192, h = rem / 16, rest = rem % 16;
        const int p = rest / nbk2, nbA = 2 * (rest % nbk2);
#pragma unroll
        for (int it = 0; it < 6; ++it) {
            const int c = tid + 512 * it, j = c >> 3, part = c & 7;
            *(h16x8*)(Ks + j * 72 + part * 8) = pk[it];
            *(h16x8*)(Vs + j * 72 + part * 8) = pv[it];
        }
#pragma unroll
        for (int it = 0; it < 4; ++it) {
            const int c = tid + 512 * it, i = c >> 3, part = c & 7;
            *(h16x8*)(Qs + i * 72 + part * 8) = pq[it] * (h16)0.18033688f;
        }
        LDS_BARRIER();
        if (item + G_ < 1536) ATT_LOAD(item + G_);
#pragma unroll
        for (int qb = 0; qb < 2; ++qb) {
        const int nb = nbA + qb;
        const h16* Kb = Ks + 128 * qb * 72; const h16* Vb = Vs + 128 * qb * 72; const h16* Qb = Qs + 128 * qb * 72;
        float lp_pre = 0.f; h16x4 prev_pre[4];
#pragma unroll
        for (int dt = 0; dt < 4; ++dt) prev_pre[dt] = (h16x4){0, 0, 0, 0};
        if (pat > 0) {
            const unsigned tok_ = (unsigned)b * SEQ + p + r * (128 * nb + 16 * w + fr);
            lp_pre = gld(lse + tok_ * 12 + h);
#pragma unroll
            for (int dt = 0; dt < 4; ++dt) prev_pre[dt] = gld((const h16x4*)(ob + tok_ * 768 + h * 64 + 4 * g + 16 * dt));
        }
        const float slope = __builtin_amdgcn_exp2f(-8.0f * (float)(h + 1) / 12.0f);
        const float sr = slope * (float)r * 1.4426950408889634f;
        h16x8 qf[2];
#pragma unroll
        for (int kk = 0; kk < 2; ++kk) qf[kk] = *(const h16x8*)(Qb + (16 * w + fr) * 72 + 32 * kk + 8 * g);
        float sc[9][4];
        float mx = -1e30f;
        const int iq = 16 * w + fr;
        float brg[4];
#pragma unroll
        for (int rg = 0; rg < 4; ++rg) brg[rg] = -sr * (float)(fr + 128 - 4 * g - rg);
#pragma unroll
        for (int tt = 0; tt < 9; ++tt) {
            const int jt = w + tt;
            const bool tile_ok = (jt <= 15) && (nb > 0 || jt >= 8);
            if (tile_ok) {
                f32x4 acc = {0.f, 0.f, 0.f, 0.f};
#pragma unroll
                for (int kk = 0; kk < 2; ++kk) { const h16x8 kf = *(const h16x8*)(Kb + (16 * jt + fr) * 72 + 32 * kk + 8 * g); acc = MFMA16(kf, qf[kk], acc); }
                const float bt = sr * (float)(16 * tt);
#pragma unroll
                for (int rg = 0; rg < 4; ++rg) {
                    float sv = acc[rg] + (brg[rg] + bt);
                    if (tt == 0) sv = (4 * g + rg >= fr) ? sv : -1e30f;
                    if (tt == 8) sv = (4 * g + rg <= fr) ? sv : -1e30f;
                    sc[tt][rg] = sv; mx = fmaxf(mx, sv);
                }
            } else {
#pragma unroll
                for (int rg = 0; rg < 4; ++rg) sc[tt][rg] = -1e30f;
            }
        }
        mx = fmaxf(mx, shx(mx, 16, lane)); mx = fmaxf(mx, shx(mx, 32, lane));
        float lsum = 0.f;
#pragma unroll
        for (int tt = 0; tt < 9; ++tt)
#pragma unroll
            for (int rg = 0; rg < 4; ++rg) { const float pv = __builtin_amdgcn_exp2f(sc[tt][rg] - mx); sc[tt][rg] = pv; lsum += pv; }
        lsum += shx(lsum, 16, lane); lsum += shx(lsum, 32, lane);
        f32x4 o[4];
#pragma unroll
        for (int dt = 0; dt < 4; ++dt) o[dt] = (f32x4){0.f, 0.f, 0.f, 0.f};
#pragma unroll
        for (int kk2 = 0; kk2 < 5; ++kk2) {
            const int ta = 2 * kk2, tb = 2 * kk2 + 1;
            h16x8 pf;
#pragma unroll
            for (int rg = 0; rg < 4; ++rg) { pf[rg] = (h16)sc[ta][rg]; pf[4 + rg] = (tb <= 8) ? (h16)sc[tb < 9 ? tb : 8][rg] : (h16)0.f; }
            const int ja = (w + ta) < 15 ? (w + ta) : 15, jb = (w + tb) < 15 ? (w + tb) : 15;
#pragma unroll
            for (int dt = 0; dt < 4; ++dt) {
                const h16x4 va = tr_read4(Vb + (16 * ja + 4 * g + (fr >> 2)) * 72 + 16 * dt + 4 * (fr & 3));
                const h16x4 vb = tr_read4(Vb + (16 * jb + 4 * g + (fr >> 2)) * 72 + 16 * dt + 4 * (fr & 3));
                o[dt] = MFMA16(cat8(va, vb), pf, o[dt]);
            }
        }
        {
            const int t = p + r * (128 * nb + iq);
            const unsigned tok = (unsigned)b * SEQ + t;
            const float inv = 1.0f / lsum, lse_p = (mx + __builtin_amdgcn_logf(lsum)) * 0.6931471805599453f;
            float w1 = 0.f, w2 = inv, lse_new = lse_p;
            if (pat > 0) {
                const float lp = lp_pre, m2 = fmaxf(lp, lse_p), e1 = fexp(lp - m2), e2 = fexp(lse_p - m2), den = e1 + e2;
                w1 = e1 / den; w2 = e2 * inv / den; lse_new = m2 + flog(den);
            }
            h16* op = ob + tok * 768 + h * 64 + 4 * g;
#pragma unroll
            for (int dt = 0; dt < 4; ++dt) {
                h16x4 prev = {0, 0, 0, 0};
                if (pat > 0) prev = prev_pre[dt];
                h16x4 res;
#pragma unroll
                for (int rg = 0; rg < 4; ++rg) res[rg] = (h16)(w1 * (float)prev[rg] + w2 * o[dt][rg]);
                gst((h16x4*)(op + 16 * dt), res);
            }
            if (pat < 2 && g == 0) gst(lse + tok * 12 + h, lse_new);
        }
        }
        LDS_BARRIER();
        }
    }
    }
#undef ATT_LOAD
#undef ATT_MAP
}

__device__ __forceinline__ void phase_halo(const h16* Pdn, h16* halo) {
    const int total = 8 * 64 * 3 * 384;
    int tid = threadIdx.x; LAUNDER_V(tid); int bid = blockIdx.x; LAUNDER_S(bid);
    for (int c = bid * 512 + tid; c < total; c += gridDim.x * 512) {
        const int part = c % 384, e = (c / 384) % 3, bn = c / (384 * 3), n = bn & 63, b = bn >> 6;
        if (n == 0) continue;
        *(h16x8*)(halo + ((unsigned)bn * 3 + e) * 3072 + part * 8) = *(const h16x8*)(Pdn + ((unsigned)b * SEQ + 64 * n - 3 + e) * 4096 + part * 8);
    }
}

__device__ __forceinline__ void phase_dnprep(h16* Pdn, const h16* halo, const float* bd, const float* convw, const float* a_log, const float* dt_bias,
                             h16* Tg, h16* qkg, float* gcg, float* betag, LAS unsigned char* ldsl, unsigned char* ldsb) {
    int bid = blockIdx.x; LAUNDER_S(bid);
    const int w = __builtin_amdgcn_readfirstlane((int)threadIdx.x >> 6);
    constexpr int RP = 384;
    constexpr int RAWB = 67 * RP * 2;
    h16* qn = (h16*)(ldsb + 2 * RAWB);
    h16* kn = qn + 64 * 136;
    float* Mm = (float*)(kn + 64 * 136);
    float* cw = Mm + 64 * 68;
    float* gcs = cw + 4 * 384;
    float* bts = gcs + 64;
    float cv[4] = {0.f, 0.f, 0.f, 0.f}, pbr = 0.f, par_ = 0.f;
#define PREP_FETCH(item_, buf_) do { const int b_ = (item_) >> 9, h_ = ((item_) >> 6) & 7, n_ = (item_) & 63; int t_ = threadIdx.x; LAUNDER_V(t_); const int ln_ = t_ & 63; const unsigned tok0_ = (unsigned)b_ * SEQ + 64 * n_; \
        _Pragma("unroll") for (int it = 0; it < 7; ++it) { const int blk = w + 8 * it; if (blk < 51) { const int L = blk * 1024 + ln_ * 16, row = L / 768, q = (L - row * 768) >> 4; \
            const int coff_ = (q >> 4) * 1024 + h_ * 128 + (q & 15) * 8; \
            const h16* src = (row >= 3) ? Pdn + (tok0_ + row - 3) * 4096 + coff_ : halo + ((unsigned)(b_ * 64 + n_) * 3 + row) * 3072 + coff_; \
            if (L < RAWB && (row >= 3 || n_ > 0)) __builtin_amdgcn_global_load_lds((const unsigned*)src, (LAS unsigned*)(ldsl + (buf_) * RAWB + blk * 1024), 16, 0, 0); } } \
        _Pragma("unroll") for (int j = 0; j < 4; ++j) { if (t_ < 384) cv[j] = gld(convw + j * 3072 + (t_ >> 7) * 1024 + h_ * 128 + (t_ & 127)); } \
        if (w == 0) { pbr = gld(bd + (tok0_ + ln_) * 16 + h_); par_ = gld(bd + (tok0_ + ln_) * 16 + 8 + h_); } } while (0)
    if (bid < 4096) PREP_FETCH(bid, 0);
    int cur = 0;
    for (int item = bid; item < 4096; item += gridDim.x, cur ^= 1) {
        const int b = item >> 9, h = (item >> 6) & 7, n = item & 63;
        int tl = threadIdx.x; LAUNDER_V(tl);
        const int lane = tl & 63, fr = lane & 15, g = lane >> 4;
        const unsigned tok0 = (unsigned)b * SEQ + 64 * n;
        const unsigned bh0 = (unsigned)(b * 8 + h) * SEQ + 64 * n;
        h16* raw = (h16*)(ldsb + cur * RAWB);
        float* X = (float*)raw;
        float* Zs = X + 64 * 68;
        asm volatile("s_waitcnt vmcnt(0)" ::: "memory");
        if (n == 0 && tl < 144) { int z0 = 0; LAUNDER_V(z0); const float zf = __int_as_float(z0); *(f32x4*)(raw + tl * 8) = (f32x4){zf, zf, zf, zf}; }
#pragma unroll
        for (int j = 0; j < 4; ++j) if (tl < 384) cw[j * 384 + tl] = cv[j];
        if (w == 0) {
            const float br = pbr, ar = par_;
            const float beta = 1.0f / (1.0f + fexp(-br));
            const float xs = ar + dt_bias[h];
            const float sp = (xs > 20.f) ? xs : flog(1.0f + fexp(xs));
            float gg = -fexp(a_log[h]) * sp;
#pragma unroll
            for (int o = 1; o < 64; o <<= 1) { const float t = __int_as_float(__builtin_amdgcn_ds_bpermute(((lane >= o) ? (lane - o) : lane) << 2, __float_as_int(gg))); if (lane >= o) gg += t; }
            gcs[lane] = gg; bts[lane] = beta; gst(gcg + bh0 + lane, gg); gst(betag + bh0 + lane, beta);
        }
        LDS_BARRIER();
        if (item + (int)gridDim.x < 4096) PREP_FETCH(item + (int)gridDim.x, cur ^ 1);
        {
            const int rr = lane >> 3, cp = lane & 7, i = 8 * w + rr;
            h16* gp = Pdn + (tok0 + i) * 4096 + h * 128 + 16 * cp;
            const float bt_i = bts[i];
#pragma unroll
            for (int seg = 0; seg < 3; ++seg) {
                float y[16];
#pragma unroll
                for (int e = 0; e < 16; ++e) y[e] = 0.f;
#pragma unroll
                for (int j = 0; j < 4; ++j) {
                    const h16x8 x0 = *(const h16x8*)(raw + (i + j) * RP + seg * 128 + 16 * cp), x1 = *(const h16x8*)(raw + (i + j) * RP + seg * 128 + 16 * cp + 8);
                    const f32x4* cwp = (const f32x4*)(cw + j * 384 + seg * 128 + 16 * cp);
                    const f32x4 c0 = cwp[0], c1 = cwp[1], c2 = cwp[2], c3 = cwp[3];
#pragma unroll
                    for (int e = 0; e < 4; ++e) {
                        y[e] += c0[e] * (float)x0[e]; y[4 + e] += c1[e] * (float)x0[4 + e];
                        y[8 + e] += c2[e] * (float)x1[e]; y[12 + e] += c3[e] * (float)x1[4 + e];
                    }
                }
#pragma unroll
                for (int e = 0; e < 16; ++e) y[e] = silu_f(y[e]);
                float scl = bt_i;
                if (seg < 2) {
                    float ss = 0.f;
#pragma unroll
                    for (int e = 0; e < 16; ++e) ss += y[e] * y[e];
                    ss += shx(ss, 1, lane); ss += shx(ss, 2, lane); ss += shx(ss, 4, lane);
                    scl = rsqrtf(ss + 1e-6f) * (seg == 0 ? 0.08838834764831845f : 1.0f);
                }
                h16x8 o0, o1;
#pragma unroll
                for (int e = 0; e < 8; ++e) { o0[e] = (h16)(y[e] * scl); o1[e] = (h16)(y[8 + e] * scl); }
                if (seg == 0) { *(h16x8*)(qn + i * 136 + 16 * cp) = o0; *(h16x8*)(qn + i * 136 + 16 * cp + 8) = o1; }
                if (seg == 1) { *(h16x8*)(kn + i * 136 + 16 * cp) = o0; *(h16x8*)(kn + i * 136 + 16 * cp + 8) = o1; }
                gst((h16x8*)(gp + seg * 1024), o0); gst((h16x8*)(gp + seg * 1024 + 8), o1);
            }
        }
        LDS_BARRIER();
#pragma unroll
        for (int idx0 = 0; idx0 < 4; ++idx0) {
            const int idx = w + 8 * idx0;
            const int isqk = idx >> 4, ti = (idx >> 2) & 3, tj = idx & 3;
            f32x4 acc = {0.f, 0.f, 0.f, 0.f};
            if (tj <= ti) {
                const h16* As = isqk ? qn : kn;
#pragma unroll
                for (int kk = 0; kk < 4; ++kk) {
                    const h16x8 a = *(const h16x8*)(As + (16 * ti + fr) * 136 + 32 * kk + 8 * g);
                    const h16x8 bb = *(const h16x8*)(kn + (16 * tj + fr) * 136 + 32 * kk + 8 * g);
                    acc = MFMA16(a, bb, acc);
                }
            }
#pragma unroll
            for (int rg = 0; rg < 4; ++rg) {
                const int i = 16 * ti + 4 * g + rg, j = 16 * tj + fr;
                const float dec = fexp(fminf(gcs[i] - gcs[j], 0.f));
                if (!isqk) Mm[i * 68 + j] = (j < i) ? acc[rg] * bts[i] * dec : 0.f;
                else gst(qkg + (bh0 + i) * 64 + j, (h16)((j <= i) ? acc[rg] * dec : 0.f));
            }
        }
        for (int e = tl; e < 4096; e += 512) { const int r = e >> 6, c = e & 63; if ((c >> 4) > (r >> 4)) X[r * 68 + c] = 0.f; }
        LDS_BARRIER();
        if (w < 4 && lane < 16) {
            const int q = w, c = lane;
            float x[16];
#pragma unroll
            for (int i = 0; i < 16; ++i) {
                float mrow[16];
#pragma unroll
                for (int q4 = 0; q4 < 4; ++q4) { const f32x4 t4 = *(const f32x4*)(Mm + (16 * q + i) * 68 + 16 * q + 4 * q4); mrow[4 * q4] = t4[0]; mrow[4 * q4 + 1] = t4[1]; mrow[4 * q4 + 2] = t4[2]; mrow[4 * q4 + 3] = t4[3]; }
                float sacc = (i == c) ? 1.f : 0.f;
#pragma unroll
                for (int j = 0; j < 16; ++j) if (j < i) sacc -= mrow[j] * x[j];
                x[i] = sacc;
            }
#pragma unroll
            for (int i = 0; i < 16; ++i) X[(16 * q + i) * 68 + 16 * q + c] = x[i];
        }
        LDS_BARRIER();
        {
            const int which = tl >> 8, r = (tl >> 4) & 15, c = tl & 15, rb = which ? 48 : 16, cb = which ? 32 : 0;
            float sacc = 0.f;
#pragma unroll
            for (int k = 0; k < 16; ++k) sacc += Mm[(rb + r) * 68 + cb + k] * X[(cb + k) * 68 + cb + c];
            Zs[(which * 16 + r) * 17 + c] = sacc;
        }
        LDS_BARRIER();
        {
            const int which = tl >> 8, r = (tl >> 4) & 15, c = tl & 15, rb = which ? 48 : 16, cb = which ? 32 : 0;
            float sacc = 0.f;
#pragma unroll
            for (int m = 0; m < 16; ++m) sacc += X[(rb + r) * 68 + rb + m] * Zs[(which * 16 + m) * 17 + c];
            X[(rb + r) * 68 + cb + c] = -sacc;
        }
        LDS_BARRIER();
        {
            float zv[2];
#pragma unroll
            for (int it = 0; it < 2; ++it) {
                const int e = tl + 512 * it, r = e >> 5, c = e & 31;
                float sacc = 0.f;
#pragma unroll
                for (int k = 0; k < 32; ++k) sacc += Mm[(32 + r) * 68 + k] * X[k * 68 + c];
                zv[it] = sacc;
            }
#pragma unroll
            for (int it = 0; it < 2; ++it) { const int e = tl + 512 * it, r = e >> 5, c = e & 31; Zs[r * 33 + c] = zv[it]; }
        }
        LDS_BARRIER();
#pragma unroll
        for (int it = 0; it < 2; ++it) {
            const int e = tl + 512 * it, r = e >> 5, c = e & 31;
            float sacc = 0.f;
#pragma unroll
            for (int m = 0; m < 32; ++m) sacc += X[(32 + r) * 68 + 32 + m] * Zs[m * 33 + c];
            X[(32 + r) * 68 + c] = -sacc;
        }
        LDS_BARRIER();
        {
            const int i = tl >> 3, part = tl & 7;
            h16x8 o;
#pragma unroll
            for (int e = 0; e < 8; ++e) o[e] = (h16)X[i * 68 + 8 * part + e];
            gst((h16x8*)(Tg + (bh0 + i) * 64 + 8 * part), o);
        }
        LDS_BARRIER();
    }
#undef PREP_FETCH
}

__device__ __forceinline__ void phase_scan(h16* Pdn, const h16* Tg, const h16* qkg, const float* gcg, const float* betag, unsigned char* ldsb) {
    int tid = threadIdx.x; LAUNDER_V(tid); int bid = blockIdx.x; LAUNDER_S(bid);
    const int lane = tid & 63, w = __builtin_amdgcn_readfirstlane(tid >> 6), fr = lane & 15, g = lane >> 4;
    constexpr int OQ = 0, OK_ = 64 * 136, OT = 2 * 64 * 136, OQK = OT + 64 * 72, OV = OQK + 64 * 72, OSC = OV + 64 * 64, BUFH = OSC + 256;
    if (bid < 128) {
        const int item = bid;
        const int bh = (item & 7) * 8 + (item >> 4), s = (item >> 3) & 1, b = bh >> 3, h = bh & 7;
        f32x4 S[8];
#pragma unroll
        for (int tk = 0; tk < 8; ++tk) S[tk] = (f32x4){0.f, 0.f, 0.f, 0.f};
#define SCAN_LD(n_, R_) do { const unsigned tok0_ = (unsigned)b * SEQ + 64 * (n_), bh0_ = (unsigned)bh * SEQ + 64 * (n_); int lt = tid - 256; LAUNDER_V(lt); \
            _Pragma("unroll") for (int it = 0; it < 4; ++it) { const int c = lt + 256 * it, i = c >> 4, part = c & 15; const h16* rp = Pdn + (tok0_ + i) * 4096 + h * 128 + part * 8; \
                R_[it] = gld((const h16x8*)rp); R_[4 + it] = gld((const h16x8*)(rp + 1024)); } \
            _Pragma("unroll") for (int it = 0; it < 2; ++it) { const int c = lt + 256 * it, i = c >> 3, part = c & 7; \
                R_[8 + it] = gld((const h16x8*)(Tg + (bh0_ + i) * 64 + part * 8)); R_[10 + it] = gld((const h16x8*)(qkg + (bh0_ + i) * 64 + part * 8)); \
                R_[12 + it] = gld((const h16x8*)(Pdn + (tok0_ + i) * 4096 + 2048 + h * 128 + 64 * s + part * 8)); } \
            if (lt < 32) R_[14] = gld((const h16x8*)(((lt < 16) ? gcg : betag) + bh0_ + 4 * (lt & 15))); } while (0)
#define SCAN_ST(buf_, R_) do { h16* B_ = (h16*)ldsb + (buf_) * BUFH; int lt = tid - 256; LAUNDER_V(lt); \
            _Pragma("unroll") for (int it = 0; it < 4; ++it) { const int c = lt + 256 * it, i = c >> 4, part = c & 15; \
                *(h16x8*)(B_ + OQ + i * 136 + part * 8) = R_[it]; *(h16x8*)(B_ + OK_ + i * 136 + part * 8) = R_[4 + it]; } \
            _Pragma("unroll") for (int it = 0; it < 2; ++it) { const int c = lt + 256 * it, i = c >> 3, part = c & 7; \
                *(h16x8*)(B_ + OT + i * 72 + part * 8) = R_[8 + it]; *(h16x8*)(B_ + OQK + i * 72 + part * 8) = R_[10 + it]; *(h16x8*)(B_ + OV + i * 64 + part * 8) = R_[12 + it]; } \
            if (lt < 32) *(h16x8*)(B_ + OSC + 8 * lt) = R_[14]; } while (0)
        if (w >= 4) {
            h16x8 R0[15], R1[15], R2[15];
            SCAN_LD(0, R0); SCAN_ST(0, R0);
            SCAN_LD(1, R1); SCAN_LD(2, R2); SCAN_LD(3, R0);
            LDS_BARRIER();
#pragma unroll 1
            for (int n = 0; n < 63; n += 3) {
                SCAN_ST((n + 1) & 1, R1); if (n + 4 < 64) SCAN_LD(n + 4, R1);
                LDS_BARRIER();
                SCAN_ST((n + 2) & 1, R2); if (n + 5 < 64) SCAN_LD(n + 5, R2);
                LDS_BARRIER();
                SCAN_ST((n + 3) & 1, R0); if (n + 6 < 64) SCAN_LD(n + 6, R0);
                LDS_BARRIER();
            }
            LDS_BARRIER();
        } else {
        int tc = tid; LAUNDER_V(tc);
        const int lane = tc & 63, fr = lane & 15, g = lane >> 4; (void)lane;
        LDS_BARRIER();
#pragma unroll 1
        for (int n = 0; n < 64; ++n) {
            const unsigned tok0 = (unsigned)b * SEQ + 64 * n;
            const h16* B = (const h16*)ldsb + (n & 1) * BUFH;
            const h16* qn = B + OQ; const h16* kn = B + OK_; const h16* Tm = B + OT; const h16* qkm = B + OQK; const h16* vbs = B + OV;
            const float* gcs = (const float*)(B + OSC); const float* bts = gcs + 64;
            {
                GAS h16* ob = (GAS h16*)(Pdn + (tok0 * 4096 + 2048 + h * 128 + 64 * s));
                const float g_last = gcs[63], e_last = fexp(g_last);
                h16x8 Sf[4];
#pragma unroll
                for (int kk = 0; kk < 4; ++kk)
#pragma unroll
                    for (int rg = 0; rg < 4; ++rg) { Sf[kk][rg] = (h16)S[2 * kk][rg]; Sf[kk][4 + rg] = (h16)S[2 * kk + 1][rg]; }
#define LD_A(F, ti_) do { _Pragma("unroll") for (int kk = 0; kk < 4; ++kk) { const h16* kp = kn + (16 * (ti_) + fr) * 136 + 32 * kk + 4 * g; const h16* qp = qn + (16 * (ti_) + fr) * 136 + 32 * kk + 4 * g; \
                    F[2 * kk] = cat8(*(const h16x4*)kp, *(const h16x4*)(kp + 16)); F[2 * kk + 1] = cat8(*(const h16x4*)qp, *(const h16x4*)(qp + 16)); } } while (0)
#define LD_T(F, base_) do { _Pragma("unroll") for (int ti = 0; ti < 4; ++ti) _Pragma("unroll") for (int k2 = 0; k2 < 2; ++k2) { const h16* tp = (base_) + (16 * ti + fr) * 72 + 32 * k2 + 4 * g; \
                    F[2 * ti + k2] = cat8(*(const h16x4*)tp, *(const h16x4*)(tp + 16)); } } while (0)
#define LD_K(F, tk0_) do { _Pragma("unroll") for (int t = 0; t < 4; ++t) _Pragma("unroll") for (int k2 = 0; k2 < 2; ++k2) { const h16* kp = kn + (32 * k2 + 4 * g + (fr >> 2)) * 136 + 16 * ((tk0_) + t) + 4 * (fr & 3); \
                    F[2 * t + k2] = cat8(tr_read4(kp), tr_read4(kp + 16 * 136)); } } while (0)
#define CP_F(D, S_) do { _Pragma("unroll") for (int q = 0; q < 8; ++q) D[q] = S_[q]; } while (0)
#define LD_S(G_, B_, V_, ti_) do { G_ = *(const f32x4*)(gcs + 16 * (ti_) + 4 * g); B_ = *(const f32x4*)(bts + 16 * (ti_) + 4 * g); V_ = tr_read4(vbs + (16 * (ti_) + 4 * g + (fr >> 2)) * 64 + 16 * w + 4 * (fr & 3)); } while (0)
                h16x8 F0[8], F1[8];
                f32x4 gc0, bt0, gc1 = {0.f, 0.f, 0.f, 0.f}, bt1 = {0.f, 0.f, 0.f, 0.f}; h16x4 vb0, vb1 = {0, 0, 0, 0};
                LD_A(F0, 0); LD_S(gc0, bt0, vb0, 0);
                f32x4 R[4], O[4];
#pragma unroll
                for (int ti = 0; ti < 4; ++ti) {
                    if (ti < 3) { LD_A(F1, ti + 1); LD_S(gc1, bt1, vb1, ti + 1); } else LD_T(F1, Tm);
                    __builtin_amdgcn_sched_barrier(0);
                    f32x4 ka = {0.f, 0.f, 0.f, 0.f}, qa = {0.f, 0.f, 0.f, 0.f};
#pragma unroll
                    for (int kk = 0; kk < 4; ++kk) { ka = MFMA16(F0[2 * kk], Sf[kk], ka); qa = MFMA16(F0[2 * kk + 1], Sf[kk], qa); }
#pragma unroll
                    for (int rg = 0; rg < 4; ++rg) { const float eg = fexp(gc0[rg]); R[ti][rg] = (float)vb0[rg] - bt0[rg] * eg * ka[rg]; O[ti][rg] = eg * qa[rg]; }
                    CP_F(F0, F1); gc0 = gc1; bt0 = bt1; vb0 = vb1;
                }
                h16x8 Rf[2];
#pragma unroll
                for (int k2 = 0; k2 < 2; ++k2)
#pragma unroll
                    for (int rg = 0; rg < 4; ++rg) { Rf[k2][rg] = (h16)R[2 * k2][rg]; Rf[k2][4 + rg] = (h16)R[2 * k2 + 1][rg]; }
                LD_T(F1, qkm);
                __builtin_amdgcn_sched_barrier(0);
                f32x4 Vn[4];
#pragma unroll
                for (int ti = 0; ti < 4; ++ti) {
                    f32x4 acc = {0.f, 0.f, 0.f, 0.f};
#pragma unroll
                    for (int k2 = 0; k2 < 2; ++k2) acc = MFMA16(F0[2 * ti + k2], Rf[k2], acc);
                    Vn[ti] = acc;
                }
                CP_F(F0, F1);
                h16x8 Vf[2], V2f[2];
#pragma unroll
                for (int k2 = 0; k2 < 2; ++k2) {
                    const f32x4 gca = *(const f32x4*)(gcs + 32 * k2 + 4 * g), gcb = *(const f32x4*)(gcs + 32 * k2 + 16 + 4 * g);
#pragma unroll
                    for (int rg = 0; rg < 4; ++rg) {
                        Vf[k2][rg] = (h16)Vn[2 * k2][rg]; Vf[k2][4 + rg] = (h16)Vn[2 * k2 + 1][rg];
                        V2f[k2][rg] = (h16)(Vn[2 * k2][rg] * fexp(g_last - gca[rg])); V2f[k2][4 + rg] = (h16)(Vn[2 * k2 + 1][rg] * fexp(g_last - gcb[rg]));
                    }
                }
                LD_K(F1, 0);
                __builtin_amdgcn_sched_barrier(0);
#pragma unroll
                for (int ti = 0; ti < 4; ++ti) {
#pragma unroll
                    for (int k2 = 0; k2 < 2; ++k2) O[ti] = MFMA16(F0[2 * ti + k2], Vf[k2], O[ti]);
#pragma unroll
                    for (int rg = 0; rg < 4; ++rg) {
                        const int i = 16 * ti + 4 * g + rg;
                        ob[i * 4096 + 16 * w + fr] = (h16)O[ti][rg];
                    }
                }
                CP_F(F0, F1);
                LD_K(F1, 4);
                __builtin_amdgcn_sched_barrier(0);
#pragma unroll
                for (int t = 0; t < 4; ++t) {
                    f32x4 acc = S[t] * e_last;
#pragma unroll
                    for (int k2 = 0; k2 < 2; ++k2) acc = MFMA16(F0[2 * t + k2], V2f[k2], acc);
                    S[t] = acc;
                }
                __builtin_amdgcn_sched_barrier(0);
#pragma unroll
                for (int t = 0; t < 4; ++t) {
                    f32x4 acc = S[4 + t] * e_last;
#pragma unroll
                    for (int k2 = 0; k2 < 2; ++k2) acc = MFMA16(F1[2 * t + k2], V2f[k2], acc);
                    S[4 + t] = acc;
                }
#undef LD_A
#undef LD_S
#undef LD_T
#undef LD_K
#undef CP_F
            }
            LDS_BARRIER();
        }
        }
#undef SCAN_LD
#undef SCAN_ST
    }
}

__device__ __forceinline__ void phase_gnorm(h16* Pdn, const float* dn_norm) {
    int tid = threadIdx.x; LAUNDER_V(tid); int bid = blockIdx.x; LAUNDER_S(bid);
    const int lane = tid & 63, w = __builtin_amdgcn_readfirstlane(tid >> 6);
    const int hh = lane >> 3, cp = lane & 7;
    const int stride = gridDim.x * 16, half = gridDim.x * 8;
    float gn[16];
#pragma unroll
    for (int q4 = 0; q4 < 4; ++q4) { const f32x4 t4 = *(const f32x4*)(dn_norm + 16 * cp + 4 * q4); gn[4 * q4] = t4[0]; gn[4 * q4 + 1] = t4[1]; gn[4 * q4 + 2] = t4[2]; gn[4 * q4 + 3] = t4[3]; }
    h16x8 oc[2][2], zc[2][2], on[2][2], zn[2][2];
#define GN_LOAD(O_, Z_, r0_) do { _Pragma("unroll") for (int u = 0; u < 2; ++u) { const int row = (r0_) + u * half; if (row < M_TOK) { const h16* rp = Pdn + (unsigned)row * 4096 + 2048 + hh * 128 + 16 * cp; \
        O_[u][0] = gld((const h16x8*)rp); O_[u][1] = gld((const h16x8*)(rp + 8)); Z_[u][0] = gld((const h16x8*)(rp + 1024)); Z_[u][1] = gld((const h16x8*)(rp + 1032)); } } } while (0)
    int row0 = bid * 8 + w;
    if (row0 < M_TOK) GN_LOAD(oc, zc, row0);
    for (; row0 < M_TOK; row0 += stride) {
        if (row0 + stride < M_TOK) GN_LOAD(on, zn, row0 + stride);
#pragma unroll
        for (int u = 0; u < 2; ++u) {
            const int row = row0 + u * half;
            if (row < M_TOK) {
                float ss = 0.f;
#pragma unroll
                for (int e = 0; e < 8; ++e) { const float a0 = (float)oc[u][0][e], a1 = (float)oc[u][1][e]; ss += a0 * a0 + a1 * a1; }
                ss += shx(ss, 1, lane); ss += shx(ss, 2, lane); ss += shx(ss, 4, lane);
                const float rstd = rsqrtf(ss * (1.0f / 128.0f) + 1e-6f);
                h16x8 r0, r1;
#pragma unroll
                for (int e = 0; e < 8; ++e) {
                    r0[e] = (h16)((float)oc[u][0][e] * rstd * gn[e] * silu_f((float)zc[u][0][e]));
                    r1[e] = (h16)((float)oc[u][1][e] * rstd * gn[8 + e] * silu_f((float)zc[u][1][e]));
                }
                h16* wp = Pdn + (unsigned)row * 4096 + 2048 + hh * 128 + 16 * cp;
                gst((h16x8*)wp, r0); gst((h16x8*)(wp + 8), r1);
            }
        }
#pragma unroll
        for (int u = 0; u < 2; ++u) { oc[u][0] = on[u][0]; oc[u][1] = on[u][1]; zc[u][0] = zn[u][0]; zc[u][1] = zn[u][1]; }
    }
#undef GN_LOAD
}

#define XB_TMO      128
#define XB_XCNT(j)  (256  + 64 * (j))
#define XB_XSUB(j)  (1280 + 64 * (j))
#define XB_XGEN(j)  (2304 + 64 * (j))
#define XB_TOP      3328
#define XB_TOPGEN   3392
#define XCD_BAR_WORDS 3456
#define XB_SPIN_CAP (1u << 18)
__device__ __forceinline__ unsigned xb_ld(unsigned* p)              { return __hip_atomic_load(p, __ATOMIC_RELAXED, __HIP_MEMORY_SCOPE_AGENT); }
__device__ __forceinline__ unsigned xb_add(unsigned* p, unsigned v) { return __hip_atomic_fetch_add(p, v, __ATOMIC_RELAXED, __HIP_MEMORY_SCOPE_AGENT); }
__device__ __forceinline__ unsigned xb_xcc_id() { return (unsigned)__builtin_amdgcn_s_getreg((3 << 11) | 20) & 0xFu; }
#define XB_SPIN(cond, bar) do { unsigned _sp = 0; while (cond) { __builtin_amdgcn_s_sleep(1); \
    if ((++_sp & 255u) == 0u) { if (xb_ld(&(bar)[XB_TMO])) break; if (_sp > XB_SPIN_CAP) { atomicAdd(&(bar)[XB_TMO], 1u); break; } } } } while (0)
__device__ __forceinline__ void xcd_barrier_complete(unsigned* bar, unsigned x, unsigned& nloc, unsigned& nx) {
    const unsigned G = gridDim.x * gridDim.y * gridDim.z;
    unsigned sum, cnt, mine, sp = 0u;
    for (;;) {
        sum = 0u; cnt = 0u; mine = 0u;
#pragma unroll
        for (unsigned j = 0; j < 16; ++j) { const unsigned c = xb_ld(&bar[XB_XCNT(j)]); sum += c; cnt += (c > 0u) ? 1u : 0u; mine = (j == x) ? c : mine; }
        if (sum == G) break;
        __builtin_amdgcn_s_sleep(1);
        if ((++sp & 255u) == 0u) { if (xb_ld(&bar[XB_TMO])) break; if (sp > XB_SPIN_CAP) { atomicAdd(&bar[XB_TMO], 1u); break; } }
    }
    nloc = mine > 0u ? mine : 1u; nx = cnt > 0u ? cnt : 1u;
}
__device__ __forceinline__ void xcd_barrier(unsigned* bar, unsigned x, volatile LAS unsigned* st) {
    asm volatile("s_waitcnt vmcnt(0)" ::: "memory");
    __syncthreads();
    if (threadIdx.x == 0) {
        __builtin_amdgcn_s_waitcnt(0);
        unsigned nloc = st[0], nx = st[1];
        if (nloc == 0u) { xcd_barrier_complete(bar, x, nloc, nx); st[0] = nloc; st[1] = nx; }
        const unsigned old = xb_add(&bar[XB_XSUB(x)], 1u);
        const unsigned gen = old / nloc;
        if (old + 1u == (gen + 1u) * nloc) {
            __builtin_amdgcn_fence(__ATOMIC_RELEASE, "agent");
            asm volatile("s_waitcnt vmcnt(0)" ::: "memory");
            const unsigned og = xb_add(&bar[XB_TOP], 1u);
            const unsigned tg = og / nx;
            if (og + 1u == (tg + 1u) * nx) xb_add(&bar[XB_TOPGEN], 1u);
            else XB_SPIN(xb_ld(&bar[XB_TOPGEN]) == tg, bar);
            __builtin_amdgcn_fence(__ATOMIC_ACQUIRE, "agent");
            xb_add(&bar[XB_XGEN(x)], 1u);
            asm volatile("s_waitcnt vmcnt(0)" ::: "memory");
        } else {
            XB_SPIN(xb_ld(&bar[XB_XGEN(x)]) == gen, bar);
            __builtin_amdgcn_fence(__ATOMIC_ACQUIRE, "agent");
            asm volatile("s_waitcnt vmcnt(0)" ::: "memory");
        }
    }
    __syncthreads();
}

#ifndef PROBE_GEMM2
constexpr int NPROG = 15;
__constant__ unsigned char PROG[NPROG] = {0, 1, 2, 4, 5, 6, 7, 8, 10, 11, 13, 14, 15, 17, 18};
#else
constexpr int NPROG = 24;
__constant__ unsigned char PROG[NPROG] = {0, 1, 1, 2, 3, 4, 4, 5, 6, 7, 8, 8, 9, 10, 11, 12, 13, 13, 14, 15, 16, 17, 17, 18};
#endif
__global__ void __launch_bounds__(512, 2) fwd_mega(Params p) {
    extern __shared__ __attribute__((aligned(16))) unsigned char lds[];
    cg::grid_group grid = cg::this_grid();
    LAS unsigned char* ldsl = (LAS unsigned char*)lds;
    volatile LAS unsigned* bst = (volatile LAS unsigned*)(ldsl + 161792);
    if (threadIdx.x == 0) { bst[0] = 0u; bst[1] = 0u; (void)xb_add((unsigned*)(p.ws + R4_BAR) + XB_XCNT(xb_xcc_id()), 1u); }
    __syncthreads();
    { unsigned char* ws0 = p.ws; LAUNDER_S(ws0); phase_mod(p.in[1], p.in[2], p.in[3], (float*)(ws0 + R4_MOD), lds); }
    if (p.ws == nullptr) grid.sync();
    xcd_barrier((unsigned*)(p.ws + R4_BAR), xb_xcc_id(), bst);
#pragma unroll 1
    for (int pc = 0; pc < NPROG * 2; ++pc) {
        const int l = (pc >= NPROG) ? 1 : 0;
        const int sl = PROG[pc - NPROG * l];
        const int step = 19 * l + sl;
        if (l == 1 && sl == 0) continue;
        unsigned char* ws = p.ws; LAUNDER_S(ws);
            const int G = gridDim.x; int bid = blockIdx.x; LAUNDER_S(bid);
        const float* x = p.in[0];
        h16* hbuf = (h16*)p.out;
        h16* XN = (h16*)(ws + R1);
        h16* HID = (h16*)(ws + R0);
        h16* Pda = (h16*)(ws + R0);
        h16* Pdn = (h16*)(ws + R0);
        h16* OB = (h16*)(ws + R2);
        h16* GATES = (h16*)(ws + R3);
        h16* Tg = (h16*)(ws + R3_T); h16* QKg = (h16*)(ws + R3_QK); h16* HALO = (h16*)(ws + R3_HALO);
        h16* Wdn = (h16*)(ws + R3_WDN); h16* Wda = (h16*)(ws + R3_WDA);
        const size_t ffoff = (l == 1 && (sl == 1 || sl == 2)) ? 32 * MiB : 0;
        h16* W1t = (h16*)(ws + R3_W1 + ffoff); h16* W2t = (h16*)(ws + R3_W2 + ffoff);
        h16* Wg = (h16*)(ws + R4_WG); h16* Wa = (h16*)(ws + R4_WA); h16* Wb = (h16*)(ws + R4_WB); h16* Wo = (h16*)(ws + R4_WO);
        float* MOD = (float*)(ws + R4_MOD); float* BD = (float*)(ws + R4_BD); float* LSE = (float*)(ws + R4_LSE);
        float* GC = (float*)(ws + R4_GC); float* BETA = (float*)(ws + R4_BETA);


        const float* modl = MOD + (unsigned)l * 8 * 9216;
        const bool first = (step == 0) || (step == 2);
        const float* hin32 = first ? x : (const float*)nullptr;
        if (sl == 0) {
            if (step == 0) phase_norm(hin32, hbuf, p.in[4], modl, 0, 1, XN);
        } else if (sl == 1 || sl == 17) {
            pg8::Gemm gm{XN, W1t, M_TOK, 2 * FF, 1024, 1024}; pg8::StaticOrder S; S.init(M_TOK, 2 * FF, G, bid);
            pg8::EpiSwiglu E{HID}; pg8::gemm_phase(ldsl, gm, S, E);
        } else if (sl == 2 || sl == 18 || sl == 15) {
            const bool wo = (sl == 15);
            pg8::Gemm gm{wo ? XN : HID, wo ? Wo : W2t, M_TOK, 1024, wo ? 1024 : FF, wo ? 1024 : FF}; pg8::StaticOrder S; S.init(M_TOK, 1024, G, bid);
            const bool lastffn = (l == 1 && sl == 18);
            h16* HB2 = (h16*)(ws + R3 + 32 * MiB);
            if (!lastffn) {
                const int nl = (sl == 18) ? 1 : l;
                const float* modn = MOD + (unsigned)nl * 8 * 9216;
                const int nsh = (sl == 2) ? 3 : (sl == 15 ? 6 : 0);
                const float* lnn = ((sl == 2) ? p.in[5] : (sl == 15 ? p.in[6] : p.in[4])) + nl * 1024;
                const unsigned use = (l == 0) ? (sl == 2 ? 1u : (sl == 15 ? 2u : 3u)) : (sl == 2 ? 4u : 5u);
                if (first) {
                    pg8::EpiResidNorm<true> E{x, hbuf, hbuf, modl + 2 * 1024, 0.5f, XN, lnn, modn + nsh * 1024, modn + (nsh + 1) * 1024,
                                              (float*)(ws + R2), (unsigned*)(p.ws + R4_BAR + 16384), 4u * use, (float*)nullptr, ldsl + 131072};
                    pg8::gemm_phase(ldsl, gm, S, E);
                } else {
                    pg8::EpiResidNorm<false> E{nullptr, hbuf, (wo && l == 1) ? HB2 : hbuf, modl + (wo ? 5 : (sl == 2 ? 2 : 8)) * 1024, wo ? 1.0f : 0.5f, XN, lnn, modn + nsh * 1024, modn + (nsh + 1) * 1024,
                                               (float*)(ws + R2), (unsigned*)(p.ws + R4_BAR + 16384), 4u * use, (float*)nullptr, ldsl + 131072};
                    pg8::gemm_phase(ldsl, gm, S, E);
                }
            } else {
                pg8::EpiResidNorm<false, true> E{nullptr, HB2, HB2, modl + 8 * 1024, 0.5f, XN, p.in[21], p.in[21], p.in[21],
                                                 (float*)(ws + R2), (unsigned*)(p.ws + R4_BAR + 16384), 4u * 6u, p.out, ldsl + 131072};
                pg8::gemm_phase(ldsl, gm, S, E);
            }
        } else if (sl == 4 || sl == 8 || sl == 13) {
            if (sl == 13) phase_gnorm(Pdn, p.in[14] + l * 128);
            const int N = (sl == 4) ? 2560 : (sl == 8 ? 4096 : 2048);
            pg8::Gemm gm{XN, sl == 4 ? Wda : (sl == 8 ? Wdn : Wg), M_TOK, N, 1024, 1024}; pg8::StaticOrder S; S.init(M_TOK, N, G, bid);
            pg8::EpiStore E{sl == 4 ? Pda : (sl == 8 ? Pdn : GATES), sl == 4 ? 2304 : (sl == 8 ? 4096 : 2048), BD, sl == 4 ? 9 : (sl == 8 ? 16 : 8), sl == 13 ? 1 : 0, sl == 8 ? HALO : (h16*)nullptr};
            pg8::gemm_phase(ldsl, gm, S, E);
        } else if (sl >= 5 && sl <= 7) {
            phase_attn(Pda, OB, LSE, sl - 5, lds);
        } else if (sl == 10) {
            phase_dnprep(Pdn, HALO, BD, p.in[11] + (unsigned)l * 4 * 3072, p.in[12] + l * 8, p.in[13] + l * 8, Tg, QKg, GC, BETA, ldsl, lds);
        } else if (sl == 11) {
            phase_scan(Pdn, Tg, QKg, GC, BETA, lds);
        } else if (sl == 14) {
#pragma unroll 1
            for (int q = 0; q < 2; ++q) {
                pg8::Gemm gm{q ? OB : Pdn + 2048, q ? Wb : Wa, M_TOK, 1024, q ? 768 : 1024, q ? 768 : 4096}; pg8::StaticOrder S; S.init(M_TOK, 1024, G, bid);
                pg8::EpiMerge E{XN, GATES, q ? 1024 : 0, q}; pg8::gemm_phase(ldsl, gm, S, E);
                __syncthreads();
            }
        }
        {
            const int ck = (sl == 0) ? 0 : (sl == 2 ? 3 : (sl == 15 ? 16 : ((sl == 18 && l == 0) ? 0 : -1)));
            const int cl = (sl == 18) ? 1 : l;
            h16* cW1 = (h16*)(ws + R3_W1 + ((sl == 18) ? 32 * MiB : 0)); h16* cW2 = (h16*)(ws + R3_W2 + ((sl == 18) ? 32 * MiB : 0));
            if (ck >= 0) {
            const int nconv = (ck == 3) ? 7 : 3;
    #pragma unroll 1
                for (int ci = 0; ci < nconv; ++ci) {
                    const float* src; int ldsrc, coloff = 0, nvalid, Ntot, K = 1024, inter = -1; h16* dst;
                    if (ck == 3) {
                        const float* win = p.in[10] + (unsigned)l * 1024 * 8464;
                        if (ci == 0)      { src = win; ldsrc = 8464; coloff = 4112; nvalid = 2304; Ntot = 2304; dst = Wda; }
                        else if (ci == 1) { src = win; ldsrc = 8464; coloff = 0;    nvalid = 4096; Ntot = 4096; dst = Wdn; }
                        else if (ci == 6) { src = win; ldsrc = 8464; coloff = 4096; nvalid = 16;   Ntot = 256;  dst = Wda + 2304 * 1024; }
                        else if (ci == 2) { src = win; ldsrc = 8464; coloff = 6416; nvalid = 2048; Ntot = 2048; dst = Wg; }
                        else if (ci == 3) { src = p.in[15] + (unsigned)l * 1024 * 1024; ldsrc = 1024; nvalid = 1024; Ntot = 1024; dst = Wa; }
                        else if (ci == 4) { src = p.in[16] + (unsigned)l * 768 * 1024;  ldsrc = 1024; nvalid = 1024; Ntot = 1024; K = 768; dst = Wb; }
                        else              { src = p.in[17] + (unsigned)l * 1024 * 1024; ldsrc = 1024; nvalid = 1024; Ntot = 1024; dst = Wo; }
                    } else {
                        const bool f2 = (ck == 16);
                        if (ci == 0)      { src = (f2 ? p.in[18] : p.in[7]) + (unsigned)cl * 1024 * FF; ldsrc = FF; nvalid = FF; Ntot = FF; dst = cW1; inter = 0; }
                        else if (ci == 1) { src = (f2 ? p.in[19] : p.in[8]) + (unsigned)cl * 1024 * FF; ldsrc = FF; nvalid = FF; Ntot = FF; dst = cW1; inter = 1; }
                        else              { src = (f2 ? p.in[20] : p.in[9]) + (unsigned)cl * FF * 1024; ldsrc = 1024; nvalid = 1024; Ntot = 1024; K = FF; dst = cW2; }
                    }
                    conv_w(src, ldsrc, coloff, nvalid, Ntot, K, dst, inter, lds);
                }

            }
        }
        xcd_barrier((unsigned*)(p.ws + R4_BAR), xb_xcc_id(), bst);
    }
}

extern "C" void kernel_launch(void* const* d_in, const int* in_sizes, int n_in, void* d_out, int out_size, void* d_ws, size_t ws_size, hipStream_t stream) {
    static int grid = 0;
    if (grid == 0) {
        if (n_in != 22 || ws_size < WS_NEED) { fprintf(stderr, "kernel_launch: unexpected n_in %d or ws_size %zu (< %zu)\n", n_in, ws_size, (size_t)WS_NEED); grid = -1; return; }
        int dev = 0, cus = 0, per_cu = 0;
        hipGetDevice(&dev);
        hipDeviceGetAttribute(&cus, hipDeviceAttributeMultiprocessorCount, dev);
        hipFuncSetAttribute((const void*)fwd_mega, hipFuncAttributeMaxDynamicSharedMemorySize, LDS_BYTES);
        hipOccupancyMaxActiveBlocksPerMultiprocessor(&per_cu, (const void*)fwd_mega, 512, LDS_BYTES);
        if (per_cu < 1) per_cu = 1;
        if (per_cu > 1) per_cu = 1;
        grid = cus * per_cu;
        (void)hipGetLastError();
    }
    if (grid < 0) return;
    Params p{};
    for (int i = 0; i < 22; ++i) p.in[i] = (const float*)d_in[i];
    p.out = (float*)d_out; p.ws = (unsigned char*)d_ws;
    (void)hipMemsetAsync((unsigned char*)d_ws + R4_BAR, 0, 32768, stream);
    void* args[] = {&p};
    hipError_t e = hipLaunchCooperativeKernel((const void*)fwd_mega, dim3(grid), dim3(512), args, LDS_BYTES, stream);
    if (e != hipSuccess) fprintf(stderr, "cooperative launch failed: %s (grid %d)\n", hipGetErrorString(e), grid);
}
```

```cpp
#include <hip/hip_runtime.h>
#include <hip/hip_cooperative_groups.h>
#include <cstdio>
namespace cg = cooperative_groups;

typedef _Float16 h16;
typedef _Float16 h16x2 __attribute__((ext_vector_type(2)));
typedef _Float16 h16x4 __attribute__((ext_vector_type(4)));
typedef _Float16 h16x8 __attribute__((ext_vector_type(8)));
typedef float f32x4 __attribute__((ext_vector_type(4)));
#define LAS __attribute__((address_space(3)))
#define GAS __attribute__((address_space(1)))
template <class T> __device__ __forceinline__ T gld(const T* p) { return *(const GAS T*)p; }
template <class T> __device__ __forceinline__ void gst(T* p, T v) { *(GAS T*)p = v; }

constexpr int M_TOK = 32768, DM = 1024, FF = 2816, SEQ = 4096;
constexpr size_t MiB = 1024ull * 1024ull;
constexpr size_t R0 = 0;
constexpr size_t R1 = 256 * MiB;
constexpr size_t R2 = 320 * MiB;
constexpr size_t R3 = 368 * MiB;
constexpr size_t R4 = 496 * MiB;
constexpr size_t R3_T = R3, R3_QK = R3 + 32 * MiB, R3_HALO = R3 + 64 * MiB, R3_WDN = R3 + 74 * MiB, R3_WDA = R3 + 83 * MiB;
constexpr size_t R3_W1 = R3, R3_W2 = R3 + 12 * MiB;
constexpr size_t KiB = 1024ull;
constexpr size_t R4_WG = R4, R4_WA = R4 + 4096 * KiB, R4_WB = R4 + 6144 * KiB, R4_WO = R4 + 7680 * KiB, R4_MOD = R4 + 9728 * KiB,
                 R4_BD = R4 + 10496 * KiB, R4_LSE = R4 + 12544 * KiB, R4_GC = R4 + 14080 * KiB, R4_BETA = R4 + 15104 * KiB, R4_BAR = R4 + 16256 * KiB;
constexpr size_t WS_NEED = 512 * MiB;
constexpr int LDS_BYTES = 161792 + 64;

__device__ __forceinline__ float shx(float v, int m, int lane) { return __int_as_float(__builtin_amdgcn_ds_bpermute((lane ^ m) << 2, __float_as_int(v))); }
__device__ __forceinline__ float wave_sum(float v, int lane) {
#pragma unroll
    for (int o = 32; o > 0; o >>= 1) v += shx(v, o, lane);
    return v;
}
__device__ __forceinline__ float fexp(float x) { return __builtin_amdgcn_exp2f(x * 1.4426950408889634f); }
__device__ __forceinline__ float flog(float x) { return __builtin_amdgcn_logf(x) * 0.6931471805599453f; }
__device__ __forceinline__ float silu_f(float x) { return x * __builtin_amdgcn_rcpf(1.0f + fexp(-x)); }
__device__ __forceinline__ float sigm_f(float x) { return __builtin_amdgcn_rcpf(1.0f + fexp(-x)); }
__device__ __forceinline__ h16x8 cat8(h16x4 a, h16x4 b) { return __builtin_shufflevector(a, b, 0, 1, 2, 3, 4, 5, 6, 7); }
typedef short s16x4v __attribute__((__vector_size__(8)));
__device__ __forceinline__ h16x4 tr_read4(const h16* p) { return __builtin_bit_cast(h16x4, __builtin_amdgcn_ds_read_tr16_b64_v4i16((LAS s16x4v*)p)); }
#define LDS_BARRIER() do { asm volatile("s_waitcnt lgkmcnt(0)" ::: "memory"); __builtin_amdgcn_s_barrier(); asm volatile("" ::: "memory"); } while (0)
#define LAUNDER_V(x) asm volatile("" : "+v"(x))
#define LAUNDER_S(x) asm volatile("" : "+s"(x))
#define MFMA16(a, b, c) __builtin_amdgcn_mfma_f32_16x16x32_f16((a), (b), (c), 0, 0, 0)

namespace pg8 {
constexpr int BM = 256, BK = 64, HALF = 128, HTB = HALF * BK * 2, NXCD = 8, WGM = 8;
__device__ __forceinline__ int lds_byte(int r, int c) { const int st = (r >> 4) * 2 + (c >> 5), rr = r & 15, cc = c & 31, ob = rr * 64 + cc * 2; return st * 1024 + (ob ^ (((ob >> 9) & 1) << 5)); }
__device__ __forceinline__ void stage_rc(int b, int& R, int& C) { const int st = b / 1024, sb = b % 1024, swz = sb ^ (((sb >> 9) & 1) << 5); R = (st >> 1) * 16 + swz / 64; C = (st & 1) * 32 + (swz % 64) / 2; }
__device__ __forceinline__ int perm32(int rho) { const int n = rho >> 4, i = rho & 15; return 8 * (i >> 2) + 4 * n + (i & 3); }
struct Unit { int pm, pn; };
struct Gemm { const h16* A; const h16* Bt; int M, N, K, lda; };
struct StaticOrder {
    int nM, nN, nwg, G, c;
    __device__ void init(int M, int N, int G_, int c_) { nM = M / BM; nN = N / BM; nwg = nM * nN; G = G_; c = c_; }
    __device__ bool next(int i, Unit& u) const {
        const long L = (long)i * G + c; if (L >= nwg) return false;
        int wgid = (int)L; { const int q = nwg / NXCD, r = nwg % NXCD, xcd = wgid % NXCD, off = wgid / NXCD; wgid = (xcd < r ? xcd * (q + 1) : r * (q + 1) + (xcd - r) * q) + off; }
        const int nig = WGM * nN, gid = wgid / nig, fm = gid * WGM, gsz = (nM - fm) < WGM ? (nM - fm) : WGM;
        u.pm = fm + ((wgid % nig) % gsz); u.pn = (wgid % nig) / gsz; return true;
    }
};

struct EpiSwiglu {
    static constexpr bool PERM = true;
    h16* O;
    __device__ __forceinline__ void operator()(const f32x4 (&acc)[2][2][4][2], const Unit& u, int wr, int wc, int fr, int fq) const {
        const int row0 = u.pm * BM + wr * 64 + fr, col0 = u.pn * 128 + wc * 32 + 8 * fq;
#pragma unroll
        for (int ai = 0; ai < 2; ++ai)
#pragma unroll
            for (int m = 0; m < 4; ++m) {
                h16x8 o;
#pragma unroll
                for (int n = 0; n < 2; ++n)
#pragma unroll
                    for (int j = 0; j < 4; ++j) o[4 * n + j] = (h16)(silu_f(acc[ai][0][m][n][j]) * acc[ai][1][m][n][j]);
                *(h16x8*)(O + (unsigned)(row0 + ai * HALF + m * 16) * FF + col0) = o;
            }
    }
};
struct EpiStore {
    static constexpr bool PERM = true;
    h16* O; int ldc; float* bd; int nmain; int act; h16* halo;
    __device__ __forceinline__ void operator()(const f32x4 (&acc)[2][2][4][2], const Unit& u, int wr, int wc, int fr, int fq) const {
        const int row0 = u.pm * BM + wr * 64 + fr;
        if (u.pn < nmain) {
            const int col0 = u.pn * BM + wc * 32 + 8 * fq;
#pragma unroll
            for (int ai = 0; ai < 2; ++ai)
#pragma unroll
                for (int m = 0; m < 4; ++m)
#pragma unroll
                    for (int bj = 0; bj < 2; ++bj) {
                        h16x8 o;
#pragma unroll
                        for (int n = 0; n < 2; ++n)
#pragma unroll
                            for (int j = 0; j < 4; ++j) { float v = acc[ai][bj][m][n][j]; if (act) v = sigm_f(v); o[4 * n + j] = (h16)v; }
                        *(h16x8*)(O + (unsigned)(row0 + ai * HALF + m * 16) * ldc + col0 + bj * HALF) = o;
                        if (halo && m == 3 && fr >= 13 && u.pn < 12) {
                            const int row = row0 + ai * HALF + 48, nc = ((row & 4095) >> 6) + 1;
                            if (nc < 64) *(h16x8*)(halo + ((unsigned)((row >> 12) * 64 + nc) * 3 + (fr - 13)) * 3072 + col0 + bj * HALF) = o;
                        }
                    }
        } else if (wc == 0 && fq < 2) {
#pragma unroll
            for (int ai = 0; ai < 2; ++ai)
#pragma unroll
                for (int m = 0; m < 4; ++m)
#pragma unroll
                    for (int n = 0; n < 2; ++n) *(f32x4*)(bd + (unsigned)(row0 + ai * HALF + m * 16) * 16 + 8 * fq + 4 * n) = acc[ai][0][m][n];
        }
    }
};
struct EpiResid {
    static constexpr bool PERM = true;
    const float* in32; const h16* in16; h16* out; const float* gate; float coef;
    __device__ __forceinline__ void operator()(const f32x4 (&acc)[2][2][4][2], const Unit& u, int wr, int wc, int fr, int fq) const {
        const int row0 = u.pm * BM + wr * 64 + fr, col0 = u.pn * BM + wc * 32 + 8 * fq;
        const int b = (u.pm * BM) >> 12;
        f32x4 gv[2][2];
#pragma unroll
        for (int bj = 0; bj < 2; ++bj)
#pragma unroll
            for (int n = 0; n < 2; ++n) gv[bj][n] = *(const f32x4*)(gate + b * 9216 + col0 + bj * HALF + 4 * n) * coef;
        if (in32) {
#pragma unroll
            for (int ai = 0; ai < 2; ++ai)
#pragma unroll
                for (int m = 0; m < 4; ++m)
#pragma unroll
                    for (int bj = 0; bj < 2; ++bj) {
                        const unsigned off = (unsigned)(row0 + ai * HALF + m * 16) * DM + col0 + bj * HALF;
                        const f32x4 x0 = *(const f32x4*)(in32 + off), x1 = *(const f32x4*)(in32 + off + 4);
                        h16x8 o;
#pragma unroll
                        for (int j = 0; j < 4; ++j) { o[j] = (h16)(x0[j] + gv[bj][0][j] * acc[ai][bj][m][0][j]); o[4 + j] = (h16)(x1[j] + gv[bj][1][j] * acc[ai][bj][m][1][j]); }
                        *(h16x8*)(out + off) = o;
                    }
        } else {
#pragma unroll
            for (int ai = 0; ai < 2; ++ai)
#pragma unroll
                for (int m = 0; m < 4; ++m)
#pragma unroll
                    for (int bj = 0; bj < 2; ++bj) {
                        const unsigned off = (unsigned)(row0 + ai * HALF + m * 16) * DM + col0 + bj * HALF;
                        const h16x8 xv = *(const h16x8*)(in16 + off);
                        h16x8 o;
#pragma unroll
                        for (int j = 0; j < 4; ++j) { o[j] = (h16)((float)xv[j] + gv[bj][0][j] * acc[ai][bj][m][0][j]); o[4 + j] = (h16)((float)xv[4 + j] + gv[bj][1][j] * acc[ai][bj][m][1][j]); }
                        *(h16x8*)(out + off) = o;
                    }
        }
    }
};
template <bool F32IN, bool FINAL = false> struct EpiResidNorm {
    static constexpr bool PERM = true;
    const float* in32; const h16* in16; h16* out; const float* gate; float coef;
    h16* xn; const float* ln; const float* shp; const float* scp;
    float* ss; unsigned* cnt; unsigned target;
    float* fout;
    LAS unsigned char* sm;
    __device__ __forceinline__ void operator()(const f32x4 (&acc)[2][2][4][2], const Unit& u, int wr, int wc, int fr, int fq) const {
        const int lane = fq * 16 + fr, wid = wr * 4 + wc, tid = wid * 64 + lane;
        const int row0 = u.pm * BM + wr * 64 + fr, col0 = u.pn * BM + wc * 32 + 8 * fq;
        const int b = (u.pm * BM) >> 12;
        LAS float* red = (LAS float*)sm; LAS float* rs = red + 1024;
        f32x4 gv[2][2];
#pragma unroll
        for (int bj = 0; bj < 2; ++bj)
#pragma unroll
            for (int n = 0; n < 2; ++n) gv[bj][n] = *(const f32x4*)(gate + b * 9216 + col0 + bj * HALF + 4 * n) * coef;
        h16x8 ov[2][4][2];
#pragma unroll
        for (int ai = 0; ai < 2; ++ai)
#pragma unroll
            for (int m = 0; m < 4; ++m) {
                float sq = 0.f;
#pragma unroll
                for (int bj = 0; bj < 2; ++bj) {
                    const unsigned off = (unsigned)(row0 + ai * HALF + m * 16) * DM + col0 + bj * HALF;
                    f32x4 xa, xb;
                    if (F32IN) { xa = *(const f32x4*)(in32 + off); xb = *(const f32x4*)(in32 + off + 4); }
                    else { const h16x8 xv = *(const h16x8*)(in16 + off); xa = (f32x4){(float)xv[0], (float)xv[1], (float)xv[2], (float)xv[3]}; xb = (f32x4){(float)xv[4], (float)xv[5], (float)xv[6], (float)xv[7]}; }
                    h16x8 o;
#pragma unroll
                    for (int j = 0; j < 4; ++j) { o[j] = (h16)(xa[j] + gv[bj][0][j] * acc[ai][bj][m][0][j]); o[4 + j] = (h16)(xb[j] + gv[bj][1][j] * acc[ai][bj][m][1][j]); }
                    if (!FINAL) *(h16x8*)(out + off) = o;
                    ov[ai][m][bj] = o;
#pragma unroll
                    for (int j = 0; j < 8; ++j) sq += (float)o[j] * (float)o[j];
                }
                sq += shx(sq, 16, lane); sq += shx(sq, 32, lane);
                if (fq == 0) red[(ai * HALF + wr * 64 + m * 16 + fr) * 4 + wc] = sq;
            }
        asm volatile("s_waitcnt lgkmcnt(0)" ::: "memory"); __builtin_amdgcn_s_barrier(); asm volatile("" ::: "memory");
        if (tid < 256) {
            const float part = (red[tid * 4 + 0] + red[tid * 4 + 1]) + (red[tid * 4 + 2] + red[tid * 4 + 3]);
            __hip_atomic_store(ss + (unsigned)(u.pm * 4 + u.pn) * 256 + tid, part, __ATOMIC_RELAXED, __HIP_MEMORY_SCOPE_AGENT);
        }
        asm volatile("s_waitcnt vmcnt(0)" ::: "memory");
        __builtin_amdgcn_s_barrier(); asm volatile("" ::: "memory");
        if (tid == 0) {
            (void)__hip_atomic_fetch_add(cnt + 16 * u.pm, 1u, __ATOMIC_RELAXED, __HIP_MEMORY_SCOPE_AGENT);
            unsigned spins = 0;
            while (__hip_atomic_load(cnt + 16 * u.pm, __ATOMIC_RELAXED, __HIP_MEMORY_SCOPE_AGENT) < target) { __builtin_amdgcn_s_sleep(1); if (++spins > (1u << 20)) break; }
        }
        __builtin_amdgcn_s_barrier(); asm volatile("" ::: "memory");
        if (tid < 256) {
            float tot = 0.f;
#pragma unroll
            for (int q = 0; q < 4; ++q) tot += __hip_atomic_load(ss + (unsigned)(u.pm * 4 + q) * 256 + tid, __ATOMIC_RELAXED, __HIP_MEMORY_SCOPE_AGENT);
            rs[tid] = rsqrtf(tot * (1.0f / 1024.0f) + 1e-6f);
        }
        asm volatile("s_waitcnt lgkmcnt(0)" ::: "memory"); __builtin_amdgcn_s_barrier(); asm volatile("" ::: "memory");
        const float* sh = FINAL ? ln : shp + b * 9216; const float* sc = FINAL ? ln : scp + b * 9216;
#pragma unroll
        for (int bj = 0; bj < 2; ++bj) {
            const int col = col0 + bj * HALF;
            const f32x4 l0 = *(const f32x4*)(ln + col), l1 = *(const f32x4*)(ln + col + 4), s0 = *(const f32x4*)(sh + col), s1 = *(const f32x4*)(sh + col + 4),
                        c0 = *(const f32x4*)(sc + col), c1 = *(const f32x4*)(sc + col + 4);
#pragma unroll
            for (int ai = 0; ai < 2; ++ai)
#pragma unroll
                for (int m = 0; m < 4; ++m) {
                    const float rstd = rs[ai * HALF + wr * 64 + m * 16 + fr];
                    const h16x8 o = ov[ai][m][bj];
                    if (FINAL) {
                        f32x4 y0, y1;
#pragma unroll
                        for (int j = 0; j < 4; ++j) { y0[j] = (float)o[j] * rstd * l0[j]; y1[j] = (float)o[4 + j] * rstd * l1[j]; }
                        float* yp = fout + (unsigned)(row0 + ai * HALF + m * 16) * DM + col;
                        *(f32x4*)yp = y0; *(f32x4*)(yp + 4) = y1;
                    } else {
                        h16x8 y;
#pragma unroll
                        for (int j = 0; j < 4; ++j) { y[j] = (h16)((float)o[j] * rstd * l0[j] * (1.0f + c0[j]) + s0[j]); y[4 + j] = (h16)((float)o[4 + j] * rstd * l1[j] * (1.0f + c1[j]) + s1[j]); }
                        *(h16x8*)(xn + (unsigned)(row0 + ai * HALF + m * 16) * DM + col) = y;
                    }
                }
        }
    }
};
struct EpiMerge {
    static constexpr bool PERM = true;
    h16* Mg; const h16* gates; int add;
    __device__ __forceinline__ void operator()(const f32x4 (&acc)[2][2][4][2], const Unit& u, int wr, int wc, int fr, int fq) const {
        const int row0 = u.pm * BM + wr * 64 + fr, col0 = u.pn * BM + wc * 32 + 8 * fq;
#pragma unroll
        for (int ai = 0; ai < 2; ++ai)
#pragma unroll
            for (int m = 0; m < 4; ++m)
#pragma unroll
                for (int bj = 0; bj < 2; ++bj) {
                    const unsigned row = (unsigned)(row0 + ai * HALF + m * 16);
                    const int col = col0 + bj * HALF;
                    const h16x8 gv = *(const h16x8*)(gates + row * DM + col);
                    h16x8 pv = {0, 0, 0, 0, 0, 0, 0, 0};
                    if (add) pv = *(const h16x8*)(Mg + row * DM + col);
                    h16x8 o;
#pragma unroll
                    for (int n = 0; n < 2; ++n)
#pragma unroll
                        for (int j = 0; j < 4; ++j) o[4 * n + j] = (h16)((float)pv[4 * n + j] + (float)gv[4 * n + j] * acc[ai][bj][m][n][j]);
                    *(h16x8*)(Mg + row * DM + col) = o;
                }
    }
};

template <class Epi>
__device__ __forceinline__ void gemm_phase(LAS unsigned char* lds, const Gemm g, const StaticOrder& S, const Epi& E) {
    int tid = threadIdx.x; LAUNDER_V(tid);
    const int wid = __builtin_amdgcn_readfirstlane(tid >> 6), lane = tid & 63, wr = wid >> 2, wc = wid & 3, fr = lane & 15, fq = lane >> 4;
    const int K = g.K, nt = K / BK;
    unsigned voffA[2], voffB[2];
#pragma unroll
    for (int i = 0; i < 2; ++i) { int R, C; stage_rc(tid * 16 + i * 8192, R, C); const int Rb = Epi::PERM ? ((R & ~31) + perm32(R & 31)) : R;
        voffA[i] = (unsigned)(R * g.lda + C) * 2u; voffB[i] = (unsigned)(Rb * K + C) * 2u; }
    const size_t kstep = (size_t)(BK * 2);
    const size_t hstepA = (size_t)HALF * g.lda * 2, hstepB = (size_t)HALF * K * 2;
    const size_t tstepA = 2 * hstepA, tstepB = 2 * hstepB;
    const unsigned ldsw = (unsigned)wid * 1024u;
    const int aoff = lds_byte(wr * 64 + fr, fq * 8), boff = lds_byte(wc * 32 + fr, fq * 8);
#define PG8_SA(b, h) (((b) * 2 + (h)) * HTB)
#define PG8_SB(b, h) ((4 + (b) * 2 + (h)) * HTB)
#define PG8_STAGE(bufoff, gbase, voff) do { _Pragma("unroll") for (int _i = 0; _i < 2; ++_i) \
        __builtin_amdgcn_global_load_lds((const unsigned*)((const char*)(gbase) + (voff)[_i]), (LAS unsigned*)(lds + (bufoff) + ldsw + _i * 8192), 16, 0, 0); } while (0)
#define PG8_LDA(dst, b, h) do { _Pragma("unroll") for (int m = 0; m < 4; ++m) _Pragma("unroll") for (int k = 0; k < 2; ++k) dst[m][k] = *(const LAS h16x8*)(lds + PG8_SA(b, h) + aoff + m * 2048 + k * 1024); } while (0)
#define PG8_LDB(dst, b, h) do { _Pragma("unroll") for (int n = 0; n < 2; ++n) _Pragma("unroll") for (int k = 0; k < 2; ++k) dst[n][k] = *(const LAS h16x8*)(lds + PG8_SB(b, h) + boff + n * 2048 + k * 1024); } while (0)
#define PG8_MMA(ai, bj, At, Bt) do { __builtin_amdgcn_s_setprio(1); _Pragma("unroll") for (int m = 0; m < 4; ++m) _Pragma("unroll") for (int n = 0; n < 2; ++n) _Pragma("unroll") for (int k = 0; k < 2; ++k) \
        acc[ai][bj][m][n] = __builtin_amdgcn_mfma_f32_16x16x32_f16(Bt[n][k], At[m][k], acc[ai][bj][m][n], 0, 0, 0); __builtin_amdgcn_s_setprio(0); } while (0)
#define PG8_WAIT_V(n) asm volatile("s_waitcnt vmcnt(" #n ")" ::: "memory")
#define PG8_WAIT_L(n) asm volatile("s_waitcnt lgkmcnt(" #n ")" ::: "memory")
#define PG8_BAR __builtin_amdgcn_s_barrier()
#define PG8_SCHED __builtin_amdgcn_sched_barrier(0)
    Unit cur, nxt; int ui = 0;
    if (!S.next(0, cur)) return;
    f32x4 acc[2][2][4][2];
#pragma unroll
    for (int a = 0; a < 2; ++a)
#pragma unroll
        for (int b = 0; b < 2; ++b)
#pragma unroll
            for (int m = 0; m < 4; ++m)
#pragma unroll
                for (int n = 0; n < 2; ++n) acc[a][b][m][n] = (f32x4){0.f, 0.f, 0.f, 0.f};
    h16x8 At[4][2], B0[2][2], B1[2][2];
    const char* cA = (const char*)g.A + (size_t)cur.pm * tstepA; const char* cB = (const char*)g.Bt + (size_t)cur.pn * tstepB;
    PG8_STAGE(PG8_SB(0, 0), cB, voffB); PG8_STAGE(PG8_SB(0, 1), cB + hstepB, voffB); PG8_STAGE(PG8_SA(0, 0), cA, voffA); PG8_STAGE(PG8_SA(0, 1), cA + hstepA, voffA);
    if (wr == 1) PG8_BAR;
    PG8_WAIT_V(2); PG8_BAR;
    PG8_STAGE(PG8_SB(1, 0), cB + kstep, voffB); PG8_STAGE(PG8_SA(1, 0), cA + kstep, voffA); PG8_STAGE(PG8_SB(1, 1), cB + hstepB + kstep, voffB);
    PG8_WAIT_V(6); PG8_BAR;
    for (;;) {
        const bool has_next = S.next(ui + 1, nxt);
        const char* nA = has_next ? (const char*)g.A + (size_t)nxt.pm * tstepA : cA; const char* nB = has_next ? (const char*)g.Bt + (size_t)nxt.pn * tstepB : cB;
        for (int t = 0; t < nt; t += 2) {
            const bool last = (t == nt - 2);
            const char* a1 = cA + (size_t)(t + 1) * kstep;
            const char* a2 = last ? nA : cA + (size_t)(t + 2) * kstep; const char* b2 = last ? nB : cB + (size_t)(t + 2) * kstep;
            const char* a3 = a2 + kstep; const char* b3 = b2 + kstep;
            PG8_LDB(B0, 0, 0); PG8_LDB(B1, 0, 1); PG8_SCHED; PG8_LDA(At, 0, 0); PG8_STAGE(PG8_SA(1, 1), a1 + hstepA, voffA);
            PG8_WAIT_V(8); PG8_WAIT_L(0); PG8_BAR; PG8_MMA(0, 0, At, B0); PG8_MMA(0, 1, At, B1); PG8_BAR; PG8_SCHED;
            PG8_LDA(At, 0, 1); PG8_STAGE(PG8_SB(0, 0), b2, voffB); PG8_STAGE(PG8_SB(0, 1), b2 + hstepB, voffB); PG8_STAGE(PG8_SA(0, 0), a2, voffA);
            PG8_WAIT_V(8); PG8_WAIT_L(0); PG8_BAR; PG8_MMA(1, 0, At, B0); PG8_MMA(1, 1, At, B1); PG8_BAR; PG8_SCHED;
            PG8_LDB(B0, 1, 0); PG8_LDB(B1, 1, 1); PG8_SCHED; PG8_LDA(At, 1, 0); PG8_STAGE(PG8_SA(0, 1), a2 + hstepA, voffA);
            PG8_WAIT_V(8); PG8_WAIT_L(0); PG8_BAR; PG8_MMA(0, 0, At, B0); PG8_MMA(0, 1, At, B1); PG8_BAR; PG8_SCHED;
            PG8_LDA(At, 1, 1); PG8_STAGE(PG8_SB(1, 0), b3, voffB); PG8_STAGE(PG8_SB(1, 1), b3 + hstepB, voffB); PG8_STAGE(PG8_SA(1, 0), a3, voffA);
            PG8_WAIT_V(8); PG8_WAIT_L(0); PG8_BAR; PG8_MMA(1, 0, At, B0); PG8_MMA(1, 1, At, B1); PG8_BAR; PG8_SCHED;
        }
        if (wr == 0) PG8_BAR;
        E(acc, cur, wr, wc, fr, fq);
        if (!has_next) break;
#pragma unroll
        for (int a = 0; a < 2; ++a)
#pragma unroll
            for (int b = 0; b < 2; ++b)
#pragma unroll
                for (int m = 0; m < 4; ++m)
#pragma unroll
                    for (int n = 0; n < 2; ++n) acc[a][b][m][n] = (f32x4){0.f, 0.f, 0.f, 0.f};
        cur = nxt; cA = nA; cB = nB; ++ui;
        if (wr == 1) PG8_BAR;
    }
    PG8_WAIT_V(0);
    PG8_BAR;
#undef PG8_SA
#undef PG8_SB
#undef PG8_STAGE
#undef PG8_LDA
#undef PG8_LDB
#undef PG8_MMA
#undef PG8_WAIT_V
#undef PG8_WAIT_L
#undef PG8_BAR
#undef PG8_SCHED
}
}

struct Params {
    const float* in[22];
    float* out;
    unsigned char* ws;
};

__device__ __forceinline__ void phase_mod(const float* c, const float* ada_w, const float* ada_b, float* mod, unsigned char* ldsb) {
    float* cact = (float*)ldsb;
    float* red = cact + 8192;
    int tid = threadIdx.x; LAUNDER_V(tid); int bid = blockIdx.x; LAUNDER_S(bid);
    const int lane = tid & 63, w = __builtin_amdgcn_readfirstlane(tid >> 6);
    for (int i = tid; i < 8192; i += 512) cact[i] = silu_f(c[i]);
    LDS_BARRIER();
    for (int item = bid; item < 288; item += gridDim.x) {
        const int l = item / 144, n0 = (item % 144) * 64;
        const float* W = ada_w + (unsigned)l * 1024 * 9216 + n0 + lane;
        float acc[8];
#pragma unroll
        for (int b = 0; b < 8; ++b) acc[b] = 0.f;
        const int k0 = w * 128;
#pragma unroll 16
        for (int k = k0; k < k0 + 128; ++k) {
            const float wv = W[(unsigned)k * 9216];
#pragma unroll
            for (int b = 0; b < 8; ++b) acc[b] += cact[b * 1024 + k] * wv;
        }
#pragma unroll
        for (int b = 0; b < 8; ++b) red[(w * 8 + b) * 64 + lane] = acc[b];
        LDS_BARRIER();
        {
            const int b = w;
            float s = ada_b[l * 9216 + n0 + lane];
#pragma unroll
            for (int ww = 0; ww < 8; ++ww) s += red[(ww * 8 + b) * 64 + lane];
            mod[(unsigned)(l * 8 + b) * 9216 + n0 + lane] = s;
        }
        LDS_BARRIER();
    }
}

__device__ __forceinline__ void conv_w(const float* src, int ldsrc, int coloff, int nvalid, int Ntot, int K, h16* dst, int inter, unsigned char* ldsb) {
    float* tile = (float*)ldsb;
    int tid = threadIdx.x; LAUNDER_V(tid); int bid = blockIdx.x; LAUNDER_S(bid);
    const int nkt = K / 64, ntiles = (Ntot / 128) * nkt;
    float v[16];
#define CONVW_LOAD(t_) do { const int n0_ = ((t_) / nkt) * 128, k0_ = ((t_) % nkt) * 64; \
        _Pragma("unroll") for (int it = 0; it < 16; ++it) { const int e = tid + 512 * it, kk = e >> 7, nn = e & 127, n = n0_ + nn; \
            const int nc_ = (n < nvalid) ? n : (nvalid - 1); const float x_ = gld(src + (unsigned)(k0_ + kk) * ldsrc + nc_ + coloff); v[it] = (n < nvalid) ? x_ : 0.f; } } while (0)
    if (bid < ntiles) CONVW_LOAD(bid);
    for (int t = bid; t < ntiles; t += gridDim.x) {
        const int n0 = (t / nkt) * 128, k0 = (t % nkt) * 64;
#pragma unroll
        for (int it = 0; it < 16; ++it) { const int e = tid + 512 * it, kk = e >> 7, nn = e & 127; tile[kk * 129 + nn] = v[it]; }
        LDS_BARRIER();
        if (t + (int)gridDim.x < ntiles) CONVW_LOAD(t + (int)gridDim.x);
#pragma unroll
        for (int it = 0; it < 8; ++it) {
            const int e = tid + 512 * it, nn = e >> 5, kp = e & 31, n = n0 + nn;
            const int dr = (inter >= 0) ? ((n >> 7) * 256 + inter * 128 + (n & 127)) : n;
            h16x2 o; o[0] = (h16)tile[(2 * kp) * 129 + nn]; o[1] = (h16)tile[(2 * kp + 1) * 129 + nn];
            gst((h16x2*)(dst + (unsigned)dr * K + k0 + 2 * kp), o);
        }
        LDS_BARRIER();
    }
#undef CONVW_LOAD
}

__device__ __forceinline__ void phase_norm(const float* src32, const h16* src16, const float* ln, const float* modl, int shi, int sci, h16* dst) {
    int tid = threadIdx.x; LAUNDER_V(tid); int bid = blockIdx.x; LAUNDER_S(bid);
    const int lane = tid & 63, w = __builtin_amdgcn_readfirstlane(tid >> 6);
    const int stride = gridDim.x * 16, half = gridDim.x * 8;
    f32x4 vc[2][4], vn[2][4];
#define NORM_LOAD(V, r0_) do { _Pragma("unroll") for (int u = 0; u < 2; ++u) { const int row = (r0_) + u * half; if (row < M_TOK) { \
        if (src32) { _Pragma("unroll") for (int i = 0; i < 4; ++i) V[u][i] = gld((const f32x4*)(src32 + (unsigned)row * DM + 4 * lane + 256 * i)); } \
        else { const h16x8 a_ = gld((const h16x8*)(src16 + (unsigned)row * DM + 16 * lane)), b_ = gld((const h16x8*)(src16 + (unsigned)row * DM + 16 * lane + 8)); \
               _Pragma("unroll") for (int j = 0; j < 4; ++j) { V[u][0][j] = (float)a_[j]; V[u][1][j] = (float)a_[4 + j]; V[u][2][j] = (float)b_[j]; V[u][3][j] = (float)b_[4 + j]; } } } } } while (0)
    int row0 = bid * 8 + w;
    if (row0 < M_TOK) NORM_LOAD(vc, row0);
    for (; row0 < M_TOK; row0 += stride) {
        if (row0 + stride < M_TOK) NORM_LOAD(vn, row0 + stride);
#pragma unroll
        for (int u = 0; u < 2; ++u) {
            const int row = row0 + u * half;
            if (row < M_TOK) {
                float ss = 0.f;
#pragma unroll
                for (int i = 0; i < 4; ++i) ss += vc[u][i][0] * vc[u][i][0] + vc[u][i][1] * vc[u][i][1] + vc[u][i][2] * vc[u][i][2] + vc[u][i][3] * vc[u][i][3];
                ss = wave_sum(ss, lane);
                const float rstd = rsqrtf(ss * (1.0f / 1024.0f) + 1e-6f);
                const int b = row >> 12;
                const float* sh = modl + b * 9216 + shi * 1024; const float* sc = modl + b * 9216 + sci * 1024;
#pragma unroll
                for (int i = 0; i < 4; ++i) {
                    const int col = src32 ? (4 * lane + 256 * i) : (16 * lane + 4 * i);
                    const f32x4 gv = *(const f32x4*)(ln + col), sv = *(const f32x4*)(sh + col), cv = *(const f32x4*)(sc + col);
                    h16x4 o;
#pragma unroll
                    for (int j = 0; j < 4; ++j) o[j] = (h16)(vc[u][i][j] * rstd * gv[j] * (1.0f + cv[j]) + sv[j]);
                    gst((h16x4*)(dst + (unsigned)row * DM + col), o);
                }
            }
        }
#pragma unroll
        for (int u = 0; u < 2; ++u)
#pragma unroll
            for (int i = 0; i < 4; ++i) vc[u][i] = vn[u][i];
    }
#undef NORM_LOAD
}
__device__ __forceinline__ void phase_final(const h16* src, float* outp, const float* ln) {
    int tid = threadIdx.x; LAUNDER_V(tid); int bid = blockIdx.x; LAUNDER_S(bid);
    const int lane = tid & 63, w = __builtin_amdgcn_readfirstlane(tid >> 6);
    const int stride = gridDim.x * 16, half = gridDim.x * 8;
    h16x8 vc[2][2], vn[2][2];
#define FIN_LOAD(V, r0_) do { _Pragma("unroll") for (int u = 0; u < 2; ++u) { const int row = (r0_) + u * half; if (row < M_TOK) { \
        V[u][0] = gld((const h16x8*)(src + (unsigned)row * DM + 16 * lane)); V[u][1] = gld((const h16x8*)(src + (unsigned)row * DM + 16 * lane + 8)); } } } while (0)
    f32x4 gv[4];
#pragma unroll
    for (int i = 0; i < 4; ++i) gv[i] = *(const f32x4*)(ln + 16 * lane + 4 * i);
    int row0 = bid * 8 + w;
    if (row0 < M_TOK) FIN_LOAD(vc, row0);
    for (; row0 < M_TOK; row0 += stride) {
        if (row0 + stride < M_TOK) FIN_LOAD(vn, row0 + stride);
#pragma unroll
        for (int u = 0; u < 2; ++u) {
            const int row = row0 + u * half;
            if (row < M_TOK) {
                float x[16]; float ss = 0.f;
#pragma unroll
                for (int e = 0; e < 8; ++e) { x[e] = (float)vc[u][0][e]; x[8 + e] = (float)vc[u][1][e]; }
#pragma unroll
                for (int e = 0; e < 16; ++e) ss += x[e] * x[e];
                ss = wave_sum(ss, lane);
                const float rstd = rsqrtf(ss * (1.0f / 1024.0f) + 1e-6f);
#pragma unroll
                for (int i = 0; i < 4; ++i) {
                    f32x4 o;
#pragma unroll
                    for (int j = 0; j < 4; ++j) o[j] = x[4 * i + j] * rstd * gv[i][j];
                    gst((f32x4*)(outp + (unsigned)row * DM + 16 * lane + 4 * i), o);
                }
            }
        }
#pragma unroll
        for (int u = 0; u < 2; ++u) { vc[u][0] = vn[u][0]; vc[u][1] = vn[u][1]; }
    }
#undef FIN_LOAD
}

__device__ __forceinline__ void phase_attn(const h16* Pda, h16* ob, float* lse, int pat, unsigned char* ldsb) {
    int tid = threadIdx.x; LAUNDER_V(tid); int bid = blockIdx.x; LAUNDER_S(bid);
    const int lane = tid & 63, w = __builtin_amdgcn_readfirstlane(tid >> 6), fr = lane & 15, g = lane >> 4;
    const int r = (pat == 0) ? 1 : (pat == 1 ? 4 : 16);
    const int nbk2 = 16 / r;
    h16* Ks = (h16*)ldsb;
    h16* Vs = Ks + 384 * 72;
    h16* Qs = Vs + 384 * 72;
    h16x8 pk[6], pv[6], pq[4];
#define ATT_MAP(v_) ((((v_) & 7) * 192) + ((v_) >> 3))
#define ATT_LOAD(vitem_) do { const int item_ = ATT_MAP(vitem_); const int b_ = (item_) / 192, rem_ = (item_) % 192, h_ = rem_ / 16, rest_ = rem_ % 16, p_ = rest_ / nbk2, nbA_ = 2 * (rest_ % nbk2); \
        int tl_ = tid; LAUNDER_V(tl_); const h16* base_ = Pda + (unsigned)b_ * SEQ * 2304 + h_ * 64; \
        _Pragma("unroll") for (int it = 0; it < 6; ++it) { const int c = tl_ + 512 * it, j = c >> 3, part = c & 7, s = 128 * (nbA_ - 1) + j; \
            pk[it] = (h16x8){0, 0, 0, 0, 0, 0, 0, 0}; pv[it] = pk[it]; \
            if (s >= 0) { const h16* rowp = base_ + (unsigned)(p_ + r * s) * 2304 + part * 8; pk[it] = gld((const h16x8*)(rowp + 768)); pv[it] = gld((const h16x8*)(rowp + 1536)); } } \
        _Pragma("unroll") for (int it = 0; it < 4; ++it) { const int c = tl_ + 512 * it, i = c >> 3, part = c & 7, s = 128 * nbA_ + i; \
            pq[it] = gld((const h16x8*)(base_ + (unsigned)(p_ + r * s) * 2304 + part * 8)); } } while (0)
    const int G_ = (int)gridDim.x;
    if (bid < 1536) ATT_LOAD(bid);
    for (int item = bid; item < 1536; item += G_) {
        {
        {
        const int mitem = ATT_MAP(item);
        const int b = mitem / 192, rem = mitem % 192, h = rem / 16, rest = rem % 16;
        const int p = rest / nbk2, nbA = 2 * (rest % nbk2);
#pragma unroll
        for (int it = 0; it < 6; ++it) {
            const int c = tid + 512 * it, j = c >> 3, part = c & 7;
            *(h16x8*)(Ks + j * 72 + part * 8) = pk[it];
            *(h16x8*)(Vs + j * 72 + part * 8) = pv[it];
        }
#pragma unroll
        for (int it = 0; it < 4; ++it) {
            const int c = tid + 512 * it, i = c >> 3, part = c & 7;
            *(h16x8*)(Qs + i * 72 + part * 8) = pq[it] * (h16)0.18033688f;
        }
        LDS_BARRIER();
        if (item + G_ < 1536) ATT_LOAD(item + G_);
#pragma unroll
        for (int qb = 0; qb < 2; ++qb) {
        const int nb = nbA + qb;
        const h16* Kb = Ks + 128 * qb * 72; const h16* Vb = Vs + 128 * qb * 72; const h16* Qb = Qs + 128 * qb * 72;
        float lp_pre = 0.f; h16x4 prev_pre[4];
#pragma unroll
        for (int dt = 0; dt < 4; ++dt) prev_pre[dt] = (h16x4){0, 0, 0, 0};
        if (pat > 0) {
            const unsigned tok_ = (unsigned)b * SEQ + p + r * (128 * nb + 16 * w + fr);
            lp_pre = gld(lse + tok_ * 12 + h);
#pragma unroll
            for (int dt = 0; dt < 4; ++dt) prev_pre[dt] = gld((const h16x4*)(ob + tok_ * 768 + h * 64 + 4 * g + 16 * dt));
        }
        const float slope = __builtin_amdgcn_exp2f(-8.0f * (float)(h + 1) / 12.0f);
        const float sr = slope * (float)r * 1.4426950408889634f;
        h16x8 qf[2];
#pragma unroll
        for (int kk = 0; kk < 2; ++kk) qf[kk] = *(const h16x8*)(Qb + (16 * w + fr) * 72 + 32 * kk + 8 * g);
        float sc[9][4];
        float mx = -1e30f;
        const int iq = 16 * w + fr;
        float brg[4];
#pragma unroll
        for (int rg = 0; rg < 4; ++rg) brg[rg] = -sr * (float)(fr + 128 - 4 * g - rg);
#pragma unroll
        for (int tt = 0; tt < 9; ++tt) {
            const int jt = w + tt;
            const bool tile_ok = (jt <= 15) && (nb > 0 || jt >= 8);
            if (tile_ok) {
                f32x4 acc = {0.f, 0.f, 0.f, 0.f};
#pragma unroll
                for (int kk = 0; kk < 2; ++kk) { const h16x8 kf = *(const h16x8*)(Kb + (16 * jt + fr) * 72 + 32 * kk + 8 * g); acc = MFMA16(kf, qf[kk], acc); }
                const float bt = sr * (float)(16 * tt);
#pragma unroll
                for (int rg = 0; rg < 4; ++rg) {
                    float sv = acc[rg] + (brg[rg] + bt);
                    if (tt == 0) sv = (4 * g + rg >= fr) ? sv : -1e30f;
                    if (tt == 8) sv = (4 * g + rg <= fr) ? sv : -1e30f;
                    sc[tt][rg] = sv; mx = fmaxf(mx, sv);
                }
            } else {
#pragma unroll
                for (int rg = 0; rg < 4; ++rg) sc[tt][rg] = -1e30f;
            }
        }
        mx = fmaxf(mx, shx(mx, 16, lane)); mx = fmaxf(mx, shx(mx, 32, lane));
        float lsum = 0.f;
#pragma unroll
        for (int tt = 0; tt < 9; ++tt)
#pragma unroll
            for (int rg = 0; rg < 4; ++rg) { const float pv = __builtin_amdgcn_exp2f(sc[tt][rg] - mx); sc[tt][rg] = pv; lsum += pv; }
        lsum += shx(lsum, 16, lane); lsum += shx(lsum, 32, lane);
        f32x4 o[4];
#pragma unroll
        for (int dt = 0; dt < 4; ++dt) o[dt] = (f32x4){0.f, 0.f, 0.f, 0.f};
#pragma unroll
        for (int kk2 = 0; kk2 < 5; ++kk2) {
            const int ta = 2 * kk2, tb = 2 * kk2 + 1;
            h16x8 pf;
#pragma unroll
            for (int rg = 0; rg < 4; ++rg) { pf[rg] = (h16)sc[ta][rg]; pf[4 + rg] = (tb <= 8) ? (h16)sc[tb < 9 ? tb : 8][rg] : (h16)0.f; }
            const int ja = (w + ta) < 15 ? (w + ta) : 15, jb = (w + tb) < 15 ? (w + tb) : 15;
#pragma unroll
            for (int dt = 0; dt < 4; ++dt) {
                const h16x4 va = tr_read4(Vb + (16 * ja + 4 * g + (fr >> 2)) * 72 + 16 * dt + 4 * (fr & 3));
                const h16x4 vb = tr_read4(Vb + (16 * jb + 4 * g + (fr >> 2)) * 72 + 16 * dt + 4 * (fr & 3));
                o[dt] = MFMA16(cat8(va, vb), pf, o[dt]);
            }
        }
        {
            const int t = p + r * (128 * nb + iq);
            const unsigned tok = (unsigned)b * SEQ + t;
            const float inv = 1.0f / lsum, lse_p = (mx + __builtin_amdgcn_logf(lsum)) * 0.6931471805599453f;
            float w1 = 0.f, w2 = inv, lse_new = lse_p;
            if (pat > 0) {
                const float lp = lp_pre, m2 = fmaxf(lp, lse_p), e1 = fexp(lp - m2), e2 = fexp(lse_p - m2), den = e1 + e2;
                w1 = e1 / den; w2 = e2 * inv / den; lse_new = m2 + flog(den);
            }
            h16* op = ob + tok * 768 + h * 64 + 4 * g;
#pragma unroll
            for (int dt = 0; dt < 4; ++dt) {
                h16x4 prev = {0, 0, 0, 0};
                if (pat > 0) prev = prev_pre[dt];
                h16x4 res;
#pragma unroll
                for (int rg = 0; rg < 4; ++rg) res[rg] = (h16)(w1 * (float)prev[rg] + w2 * o[dt][rg]);
                gst((h16x4*)(op + 16 * dt), res);
            }
            if (pat < 2 && g == 0) gst(lse + tok * 12 + h, lse_new);
        }
        }
        LDS_BARRIER();
        }
    }
    }
#undef ATT_LOAD
#undef ATT_MAP
}

__device__ __forceinline__ void phase_halo(const h16* Pdn, h16* halo) {
    const int total = 8 * 64 * 3 * 384;
    int tid = threadIdx.x; LAUNDER_V(tid); int bid = blockIdx.x; LAUNDER_S(bid);
    for (int c = bid * 512 + tid; c < total; c += gridDim.x * 512) {
        const int part = c % 384, e = (c / 384) % 3, bn = c / (384 * 3), n = bn & 63, b = bn >> 6;
        if (n == 0) continue;
        *(h16x8*)(halo + ((unsigned)bn * 3 + e) * 3072 + part * 8) = *(const h16x8*)(Pdn + ((unsigned)b * SEQ + 64 * n - 3 + e) * 4096 + part * 8);
    }
}

__device__ __forceinline__ void phase_dnprep(h16* Pdn, const h16* halo, const float* bd, const float* convw, const float* a_log, const float* dt_bias,
                             h16* Tg, h16* qkg, float* gcg, float* betag, LAS unsigned char* ldsl, unsigned char* ldsb) {
    int bid = blockIdx.x; LAUNDER_S(bid);
    const int w = __builtin_amdgcn_readfirstlane((int)threadIdx.x >> 6);
    constexpr int RP = 384;
    constexpr int RAWB = 67 * RP * 2;
    h16* qn = (h16*)(ldsb + 2 * RAWB);
    h16* kn = qn + 64 * 136;
    float* Mm = (float*)(kn + 64 * 136);
    float* cw = Mm + 64 * 68;
    float* gcs = cw + 4 * 384;
    float* bts = gcs + 64;
    float cv[4] = {0.f, 0.f, 0.f, 0.f}, pbr = 0.f, par_ = 0.f;
#define PREP_FETCH(item_, buf_) do { const int b_ = (item_) >> 9, h_ = ((item_) >> 6) & 7, n_ = (item_) & 63; int t_ = threadIdx.x; LAUNDER_V(t_); const int ln_ = t_ & 63; const unsigned tok0_ = (unsigned)b_ * SEQ + 64 * n_; \
        _Pragma("unroll") for (int it = 0; it < 7; ++it) { const int blk = w + 8 * it; if (blk < 51) { const int L = blk * 1024 + ln_ * 16, row = L / 768, q = (L - row * 768) >> 4; \
            const int coff_ = (q >> 4) * 1024 + h_ * 128 + (q & 15) * 8; \
            const h16* src = (row >= 3) ? Pdn + (tok0_ + row - 3) * 4096 + coff_ : halo + ((unsigned)(b_ * 64 + n_) * 3 + row) * 3072 + coff_; \
            if (L < RAWB && (row >= 3 || n_ > 0)) __builtin_amdgcn_global_load_lds((const unsigned*)src, (LAS unsigned*)(ldsl + (buf_) * RAWB + blk * 1024), 16, 0, 0); } } \
        _Pragma("unroll") for (int j = 0; j < 4; ++j) { if (t_ < 384) cv[j] = gld(convw + j * 3072 + (t_ >> 7) * 1024 + h_ * 128 + (t_ & 127)); } \
        if (w == 0) { pbr = gld(bd + (tok0_ + ln_) * 16 + h_); par_ = gld(bd + (tok0_ + ln_) * 16 + 8 + h_); } } while (0)
    if (bid < 4096) PREP_FETCH(bid, 0);
    int cur = 0;
    for (int item = bid; item < 4096; item += gridDim.x, cur ^= 1) {
        const int b = item >> 9, h = (item >> 6) & 7, n = item & 63;
        int tl = threadIdx.x; LAUNDER_V(tl);
        const int lane = tl & 63, fr = lane & 15, g = lane >> 4;
        const unsigned tok0 = (unsigned)b * SEQ + 64 * n;
        const unsigned bh0 = (unsigned)(b * 8 + h) * SEQ + 64 * n;
        h16* raw = (h16*)(ldsb + cur * RAWB);
        float* X = (float*)raw;
        float* Zs = X + 64 * 68;
        asm volatile("s_waitcnt vmcnt(0)" ::: "memory");
        if (n == 0 && tl < 144) { int z0 = 0; LAUNDER_V(z0); const float zf = __int_as_float(z0); *(f32x4*)(raw + tl * 8) = (f32x4){zf, zf, zf, zf}; }
#pragma unroll
        for (int j = 0; j < 4; ++j) if (tl < 384) cw[j * 384 + tl] = cv[j];
        if (w == 0) {
            const float br = pbr, ar = par_;
            const float beta = 1.0f / (1.0f + fexp(-br));
            const float xs = ar + dt_bias[h];
            const float sp = (xs > 20.f) ? xs : flog(1.0f + fexp(xs));
            float gg = -fexp(a_log[h]) * sp;
#pragma unroll
            for (int o = 1; o < 64; o <<= 1) { const float t = __int_as_float(__builtin_amdgcn_ds_bpermute(((lane >= o) ? (lane - o) : lane) << 2, __float_as_int(gg))); if (lane >= o) gg += t; }
            gcs[lane] = gg; bts[lane] = beta; gst(gcg + bh0 + lane, gg); gst(betag + bh0 + lane, beta);
        }
        LDS_BARRIER();
        if (item + (int)gridDim.x < 4096) PREP_FETCH(item + (int)gridDim.x, cur ^ 1);
        {
            const int rr = lane >> 3, cp = lane & 7, i = 8 * w + rr;
            h16* gp = Pdn + (tok0 + i) * 4096 + h * 128 + 16 * cp;
            const float bt_i = bts[i];
#pragma unroll
            for (int seg = 0; seg < 3; ++seg) {
                float y[16];
#pragma unroll
                for (int e = 0; e < 16; ++e) y[e] = 0.f;
#pragma unroll
                for (int j = 0; j < 4; ++j) {
                    const h16x8 x0 = *(const h16x8*)(raw + (i + j) * RP + seg * 128 + 16 * cp), x1 = *(const h16x8*)(raw + (i + j) * RP + seg * 128 + 16 * cp + 8);
                    const f32x4* cwp = (const f32x4*)(cw + j * 384 + seg * 128 + 16 * cp);
                    const f32x4 c0 = cwp[0], c1 = cwp[1], c2 = cwp[2], c3 = cwp[3];
#pragma unroll
                    for (int e = 0; e < 4; ++e) {
                        y[e] += c0[e] * (float)x0[e]; y[4 + e] += c1[e] * (float)x0[4 + e];
                        y[8 + e] += c2[e] * (float)x1[e]; y[12 + e] += c3[e] * (float)x1[4 + e];
                    }
                }
#pragma unroll
                for (int e = 0; e < 16; ++e) y[e] = silu_f(y[e]);
                float scl = bt_i;
                if (seg < 2) {
                    float ss = 0.f;
#pragma unroll
                    for (int e = 0; e < 16; ++e) ss += y[e] * y[e];
                    ss += shx(ss, 1, lane); ss += shx(ss, 2, lane); ss += shx(ss, 4, lane);
                    scl = rsqrtf(ss + 1e-6f) * (seg == 0 ? 0.08838834764831845f : 1.0f);
                }
                h16x8 o0, o1;
#pragma unroll
                for (int e = 0; e < 8; ++e) { o0[e] = (h16)(y[e] * scl); o1[e] = (h16)(y[8 + e] * scl); }
                if (seg == 0) { *(h16x8*)(qn + i * 136 + 16 * cp) = o0; *(h16x8*)(qn + i * 136 + 16 * cp + 8) = o1; }
                if (seg == 1) { *(h16x8*)(kn + i * 136 + 16 * cp) = o0; *(h16x8*)(kn + i * 136 + 16 * cp + 8) = o1; }
                gst((h16x8*)(gp + seg * 1024), o0); gst((h16x8*)(gp + seg * 1024 + 8), o1);
            }
        }
        LDS_BARRIER();
#pragma unroll
        for (int idx0 = 0; idx0 < 4; ++idx0) {
            const int idx = w + 8 * idx0;
            const int isqk = idx >> 4, ti = (idx >> 2) & 3, tj = idx & 3;
            f32x4 acc = {0.f, 0.f, 0.f, 0.f};
            if (tj <= ti) {
                const h16* As = isqk ? qn : kn;
#pragma unroll
                for (int kk = 0; kk < 4; ++kk) {
                    const h16x8 a = *(const h16x8*)(As + (16 * ti + fr) * 136 + 32 * kk + 8 * g);
                    const h16x8 bb = *(const h16x8*)(kn + (16 * tj + fr) * 136 + 32 * kk + 8 * g);
                    acc = MFMA16(a, bb, acc);
                }
            }
#pragma unroll
            for (int rg = 0; rg < 4; ++rg) {
                const int i = 16 * ti + 4 * g + rg, j = 16 * tj + fr;
                const float dec = fexp(fminf(gcs[i] - gcs[j], 0.f));
                if (!isqk) Mm[i * 68 + j] = (j < i) ? acc[rg] * bts[i] * dec : 0.f;
                else gst(qkg + (bh0 + i) * 64 + j, (h16)((j <= i) ? acc[rg] * dec : 0.f));
            }
        }
        for (int e = tl; e < 4096; e += 512) { const int r = e >> 6, c = e & 63; if ((c >> 4) > (r >> 4)) X[r * 68 + c] = 0.f; }
        LDS_BARRIER();
        if (w < 4 && lane < 16) {
            const int q = w, c = lane;
            float x[16];
#pragma unroll
            for (int i = 0; i < 16; ++i) {
                float mrow[16];
#pragma unroll
                for (int q4 = 0; q4 < 4; ++q4) { const f32x4 t4 = *(const f32x4*)(Mm + (16 * q + i) * 68 + 16 * q + 4 * q4); mrow[4 * q4] = t4[0]; mrow[4 * q4 + 1] = t4[1]; mrow[4 * q4 + 2] = t4[2]; mrow[4 * q4 + 3] = t4[3]; }
                float sacc = (i == c) ? 1.f : 0.f;
#pragma unroll
                for (int j = 0; j < 16; ++j) if (j < i) sacc -= mrow[j] * x[j];
                x[i] = sacc;
            }
#pragma unroll
            for (int i = 0; i < 16; ++i) X[(16 * q + i) * 68 + 16 * q + c] = x[i];
        }
        LDS_BARRIER();
        {
            const int which = tl >> 8, r = (tl >> 4) & 15, c = tl & 15, rb = which ? 48 : 16, cb = which ? 32 : 0;
            float sacc = 0.f;
#pragma unroll
            for (int k = 0; k < 16; ++k) sacc += Mm[(rb + r) * 68 + cb + k] * X[(cb + k) * 68 + cb + c];
            Zs[(which * 16 + r) * 17 + c] = sacc;
        }
        LDS_BARRIER();
        {
            const int which = tl >> 8, r = (tl >> 4) & 15, c = tl & 15, rb = which ? 48 : 16, cb = which ? 32 : 0;
            float sacc = 0.f;
#pragma unroll
            for (int m = 0; m < 16; ++m) sacc += X[(rb + r) * 68 + rb + m] * Zs[(which * 16 + m) * 17 + c];
            X[(rb + r) * 68 + cb + c] = -sacc;
        }
        LDS_BARRIER();
        {
            float zv[2];
#pragma unroll
            for (int it = 0; it < 2; ++it) {
                const int e = tl + 512 * it, r = e >> 5, c = e & 31;
                float sacc = 0.f;
#pragma unroll
                for (int k = 0; k < 32; ++k) sacc += Mm[(32 + r) * 68 + k] * X[k * 68 + c];
                zv[it] = sacc;
            }
#pragma unroll
            for (int it = 0; it < 2; ++it) { const int e = tl + 512 * it, r = e >> 5, c = e & 31; Zs[r * 33 + c] = zv[it]; }
        }
        LDS_BARRIER();
#pragma unroll
        for (int it = 0; it < 2; ++it) {
            const int e = tl + 512 * it, r = e >> 5, c = e & 31;
            float sacc = 0.f;
#pragma unroll
            for (int m = 0; m < 32; ++m) sacc += X[(32 + r) * 68 + 32 + m] * Zs[m * 33 + c];
            X[(32 + r) * 68 + c] = -sacc;
        }
        LDS_BARRIER();
        {
            const int i = tl >> 3, part = tl & 7;
            h16x8 o;
#pragma unroll
            for (int e = 0; e < 8; ++e) o[e] = (h16)X[i * 68 + 8 * part + e];
            gst((h16x8*)(Tg + (bh0 + i) * 64 + 8 * part), o);
        }
        LDS_BARRIER();
    }
#undef PREP_FETCH
}

__device__ __forceinline__ void phase_scan(h16* Pdn, const h16* Tg, const h16* qkg, const float* gcg, const float* betag, unsigned char* ldsb) {
    int tid = threadIdx.x; LAUNDER_V(tid); int bid = blockIdx.x; LAUNDER_S(bid);
    const int lane = tid & 63, w = __builtin_amdgcn_readfirstlane(tid >> 6), fr = lane & 15, g = lane >> 4;
    constexpr int OQ = 0, OK_ = 64 * 136, OT = 2 * 64 * 136, OQK = OT + 64 * 72, OV = OQK + 64 * 72, OSC = OV + 64 * 64, BUFH = OSC + 256;
    if (bid < 128) {
        const int item = bid;
        const int bh = (item & 7) * 8 + (item >> 4), s = (item >> 3) & 1, b = bh >> 3, h = bh & 7;
        f32x4 S[8];
#pragma unroll
        for (int tk = 0; tk < 8; ++tk) S[tk] = (f32x4){0.f, 0.f, 0.f, 0.f};
#define SCAN_LD(n_, R_) do { const unsigned tok0_ = (unsigned)b * SEQ + 64 * (n_), bh0_ = (unsigned)bh * SEQ + 64 * (n_); int lt = tid - 256; LAUNDER_V(lt); \
            _Pragma("unroll") for (int it = 0; it < 4; ++it) { const int c = lt + 256 * it, i = c >> 4, part = c & 15; const h16* rp = Pdn + (tok0_ + i) * 4096 + h * 128 + part * 8; \
                R_[it] = gld((const h16x8*)rp); R_[4 + it] = gld((const h16x8*)(rp + 1024)); } \
            _Pragma("unroll") for (int it = 0; it < 2; ++it) { const int c = lt + 256 * it, i = c >> 3, part = c & 7; \
                R_[8 + it] = gld((const h16x8*)(Tg + (bh0_ + i) * 64 + part * 8)); R_[10 + it] = gld((const h16x8*)(qkg + (bh0_ + i) * 64 + part * 8)); \
                R_[12 + it] = gld((const h16x8*)(Pdn + (tok0_ + i) * 4096 + 2048 + h * 128 + 64 * s + part * 8)); } \
            if (lt < 32) R_[14] = gld((const h16x8*)(((lt < 16) ? gcg : betag) + bh0_ + 4 * (lt & 15))); } while (0)
#define SCAN_ST(buf_, R_) do { h16* B_ = (h16*)ldsb + (buf_) * BUFH; int lt = tid - 256; LAUNDER_V(lt); \
            _Pragma("unroll") for (int it = 0; it < 4; ++it) { const int c = lt + 256 * it, i = c >> 4, part = c & 15; \
                *(h16x8*)(B_ + OQ + i * 136 + part * 8) = R_[it]; *(h16x8*)(B_ + OK_ + i * 136 + part * 8) = R_[4 + it]; } \
            _Pragma("unroll") for (int it = 0; it < 2; ++it) { const int c = lt + 256 * it, i = c >> 3, part = c & 7; \
                *(h16x8*)(B_ + OT + i * 72 + part * 8) = R_[8 + it]; *(h16x8*)(B_ + OQK + i * 72 + part * 8) = R_[10 + it]; *(h16x8*)(B_ + OV + i * 64 + part * 8) = R_[12 + it]; } \
            if (lt < 32) *(h16x8*)(B_ + OSC + 8 * lt) = R_[14]; } while (0)
        if (w >= 4) {
            h16x8 R0[15], R1[15], R2[15];
            SCAN_LD(0, R0); SCAN_ST(0, R0);
            SCAN_LD(1, R1); SCAN_LD(2, R2); SCAN_LD(3, R0);
            LDS_BARRIER();
#pragma unroll 1
            for (int n = 0; n < 63; n += 3) {
                SCAN_ST((n + 1) & 1, R1); if (n + 4 < 64) SCAN_LD(n + 4, R1);
                LDS_BARRIER();
                SCAN_ST((n + 2) & 1, R2); if (n + 5 < 64) SCAN_LD(n + 5, R2);
                LDS_BARRIER();
                SCAN_ST((n + 3) & 1, R0); if (n + 6 < 64) SCAN_LD(n + 6, R0);
                LDS_BARRIER();
            }
            LDS_BARRIER();
        } else {
        int tc = tid; LAUNDER_V(tc);
        const int lane = tc & 63, fr = lane & 15, g = lane >> 4; (void)lane;
        LDS_BARRIER();
#pragma unroll 1
        for (int n = 0; n < 64; ++n) {
            const unsigned tok0 = (unsigned)b * SEQ + 64 * n;
            const h16* B = (const h16*)ldsb + (n & 1) * BUFH;
            const h16* qn = B + OQ; const h16* kn = B + OK_; const h16* Tm = B + OT; const h16* qkm = B + OQK; const h16* vbs = B + OV;
            const float* gcs = (const float*)(B + OSC); const float* bts = gcs + 64;
            {
                GAS h16* ob = (GAS h16*)(Pdn + (tok0 * 4096 + 2048 + h * 128 + 64 * s));
                const float g_last = gcs[63], e_last = fexp(g_last);
                h16x8 Sf[4];
#pragma unroll
                for (int kk = 0; kk < 4; ++kk)
#pragma unroll
                    for (int rg = 0; rg < 4; ++rg) { Sf[kk][rg] = (h16)S[2 * kk][rg]; Sf[kk][4 + rg] = (h16)S[2 * kk + 1][rg]; }
#define LD_A(F, ti_) do { _Pragma("unroll") for (int kk = 0; kk < 4; ++kk) { const h16* kp = kn + (16 * (ti_) + fr) * 136 + 32 * kk + 4 * g; const h16* qp = qn + (16 * (ti_) + fr) * 136 + 32 * kk + 4 * g; \
                    F[2 * kk] = cat8(*(const h16x4*)kp, *(const h16x4*)(kp + 16)); F[2 * kk + 1] = cat8(*(const h16x4*)qp, *(const h16x4*)(qp + 16)); } } while (0)
#define LD_T(F, base_) do { _Pragma("unroll") for (int ti = 0; ti < 4; ++ti) _Pragma("unroll") for (int k2 = 0; k2 < 2; ++k2) { const h16* tp = (base_) + (16 * ti + fr) * 72 + 32 * k2 + 4 * g; \
                    F[2 * ti + k2] = cat8(*(const h16x4*)tp, *(const h16x4*)(tp + 16)); } } while (0)
#define LD_K(F, tk0_) do { _Pragma("unroll") for (int t = 0; t < 4; ++t) _Pragma("unroll") for (int k2 = 0; k2 < 2; ++k2) { const h16* kp = kn + (32 * k2 + 4 * g + (fr >> 2)) * 136 + 16 * ((tk0_) + t) + 4 * (fr & 3); \
                    F[2 * t + k2] = cat8(tr_read4(kp), tr_read4(kp + 16 * 136)); } } while (0)
#define CP_F(D, S_) do { _Pragma("unroll") for (int q = 0; q < 8; ++q) D[q] = S_[q]; } while (0)
#define LD_S(G_, B_, V_, ti_) do { G_ = *(const f32x4*)(gcs + 16 * (ti_) + 4 * g); B_ = *(const f32x4*)(bts + 16 * (ti_) + 4 * g); V_ = tr_read4(vbs + (16 * (ti_) + 4 * g + (fr >> 2)) * 64 + 16 * w + 4 * (fr & 3)); } while (0)
                h16x8 F0[8], F1[8];
                f32x4 gc0, bt0, gc1 = {0.f, 0.f, 0.f, 0.f}, bt1 = {0.f, 0.f, 0.f, 0.f}; h16x4 vb0, vb1 = {0, 0, 0, 0};
                LD_A(F0, 0); LD_S(gc0, bt0, vb0, 0);
                f32x4 R[4], O[4];
#pragma unroll
                for (int ti = 0; ti < 4; ++ti) {
                    if (ti < 3) { LD_A(F1, ti + 1); LD_S(gc1, bt1, vb1, ti + 1); } else LD_T(F1, Tm);
                    __builtin_amdgcn_sched_barrier(0);
                    f32x4 ka = {0.f, 0.f, 0.f, 0.f}, qa = {0.f, 0.f, 0.f, 0.f};
#pragma unroll
                    for (int kk = 0; kk < 4; ++kk) { ka = MFMA16(F0[2 * kk], Sf[kk], ka); qa = MFMA16(F0[2 * kk + 1], Sf[kk], qa); }
#pragma unroll
                    for (int rg = 0; rg < 4; ++rg) { const float eg = fexp(gc0[rg]); R[ti][rg] = (float)vb0[rg] - bt0[rg] * eg * ka[rg]; O[ti][rg] = eg * qa[rg]; }
                    CP_F(F0, F1); gc0 = gc1; bt0 = bt1; vb0 = vb1;
                }
                h16x8 Rf[2];
#pragma unroll
                for (int k2 = 0; k2 < 2; ++k2)
#pragma unroll
                    for (int rg = 0; rg < 4; ++rg) { Rf[k2][rg] = (h16)R[2 * k2][rg]; Rf[k2][4 + rg] = (h16)R[2 * k2 + 1][rg]; }
                LD_T(F1, qkm);
                __builtin_amdgcn_sched_barrier(0);
                f32x4 Vn[4];
#pragma unroll
                for (int ti = 0; ti < 4; ++ti) {
                    f32x4 acc = {0.f, 0.f, 0.f, 0.f};
#pragma unroll
                    for (int k2 = 0; k2 < 2; ++k2) acc = MFMA16(F0[2 * ti + k2], Rf[k2], acc);
                    Vn[ti] = acc;
                }
                CP_F(F0, F1);
                h16x8 Vf[2], V2f[2];
#pragma unroll
                for (int k2 = 0; k2 < 2; ++k2) {
                    const f32x4 gca = *(const f32x4*)(gcs + 32 * k2 + 4 * g), gcb = *(const f32x4*)(gcs + 32 * k2 + 16 + 4 * g);
#pragma unroll
                    for (int rg = 0; rg < 4; ++rg) {
                        Vf[k2][rg] = (h16)Vn[2 * k2][rg]; Vf[k2][4 + rg] = (h16)Vn[2 * k2 + 1][rg];
                        V2f[k2][rg] = (h16)(Vn[2 * k2][rg] * fexp(g_last - gca[rg])); V2f[k2][4 + rg] = (h16)(Vn[2 * k2 + 1][rg] * fexp(g_last - gcb[rg]));
                    }
                }
                LD_K(F1, 0);
                __builtin_amdgcn_sched_barrier(0);
#pragma unroll
                for (int ti = 0; ti < 4; ++ti) {
#pragma unroll
                    for (int k2 = 0; k2 < 2; ++k2) O[ti] = MFMA16(F0[2 * ti + k2], Vf[k2], O[ti]);
#pragma unroll
                    for (int rg = 0; rg < 4; ++rg) {
                        const int i = 16 * ti + 4 * g + rg;
                        ob[i * 4096 + 16 * w + fr] = (h16)O[ti][rg];
                    }
                }
                CP_F(F0, F1);
                LD_K(F1, 4);
                __builtin_amdgcn_sched_barrier(0);
#pragma unroll
                for (int t = 0; t < 4; ++t) {
                    f32x4 acc = S[t] * e_last;
#pragma unroll
                    for (int k2 = 0; k2 < 2; ++k2) acc = MFMA16(F0[2 * t + k2], V2f[k2], acc);
                    S[t] = acc;
                }
                __builtin_amdgcn_sched_barrier(0);
#pragma unroll
                for (int t = 0; t < 4; ++t) {
                    f32x4 acc = S[4 + t] * e_last;
#pragma unroll
                    for (int k2 = 0; k2 < 2; ++k2) acc = MFMA16(F1[2 * t + k2], V2f[k2], acc);
                    S[4 + t] = acc;
                }
#undef LD_A
#undef LD_S
#undef LD_T
#undef LD_K
#undef CP_F
            }
            LDS_BARRIER();
        }
        }
#undef SCAN_LD
#undef SCAN_ST
    }
}

__device__ __forceinline__ void phase_gnorm(h16* Pdn, const float* dn_norm) {
    int tid = threadIdx.x; LAUNDER_V(tid); int bid = blockIdx.x; LAUNDER_S(bid);
    const int lane = tid & 63, w = __builtin_amdgcn_readfirstlane(tid >> 6);
    const int hh = lane >> 3, cp = lane & 7;
    const int stride = gridDim.x * 16, half = gridDim.x * 8;
    float gn[16];
#pragma unroll
    for (int q4 = 0; q4 < 4; ++q4) { const f32x4 t4 = *(const f32x4*)(dn_norm + 16 * cp + 4 * q4); gn[4 * q4] = t4[0]; gn[4 * q4 + 1] = t4[1]; gn[4 * q4 + 2] = t4[2]; gn[4 * q4 + 3] = t4[3]; }
    h16x8 oc[2][2], zc[2][2], on[2][2], zn[2][2];
#define GN_LOAD(O_, Z_, r0_) do { _Pragma("unroll") for (int u = 0; u < 2; ++u) { const int row = (r0_) + u * half; if (row < M_TOK) { const h16* rp = Pdn + (unsigned)row * 4096 + 2048 + hh * 128 + 16 * cp; \
        O_[u][0] = gld((const h16x8*)rp); O_[u][1] = gld((const h16x8*)(rp + 8)); Z_[u][0] = gld((const h16x8*)(rp + 1024)); Z_[u][1] = gld((const h16x8*)(rp + 1032)); } } } while (0)
    int row0 = bid * 8 + w;
    if (row0 < M_TOK) GN_LOAD(oc, zc, row0);
    for (; row0 < M_TOK; row0 += stride) {
        if (row0 + stride < M_TOK) GN_LOAD(on, zn, row0 + stride);
#pragma unroll
        for (int u = 0; u < 2; ++u) {
            const int row = row0 + u * half;
            if (row < M_TOK) {
                float ss = 0.f;
#pragma unroll
                for (int e = 0; e < 8; ++e) { const float a0 = (float)oc[u][0][e], a1 = (float)oc[u][1][e]; ss += a0 * a0 + a1 * a1; }
                ss += shx(ss, 1, lane); ss += shx(ss, 2, lane); ss += shx(ss, 4, lane);
                const float rstd = rsqrtf(ss * (1.0f / 128.0f) + 1e-6f);
                h16x8 r0, r1;
#pragma unroll
                for (int e = 0; e < 8; ++e) {
                    r0[e] = (h16)((float)oc[u][0][e] * rstd * gn[e] * silu_f((float)zc[u][0][e]));
                    r1[e] = (h16)((float)oc[u][1][e] * rstd * gn[8 + e] * silu_f((float)zc[u][1][e]));
                }
                h16* wp = Pdn + (unsigned)row * 4096 + 2048 + hh * 128 + 16 * cp;
                gst((h16x8*)wp, r0); gst((h16x8*)(wp + 8), r1);
            }
        }
#pragma unroll
        for (int u = 0; u < 2; ++u) { oc[u][0] = on[u][0]; oc[u][1] = on[u][1]; zc[u][0] = zn[u][0]; zc[u][1] = zn[u][1]; }
    }
#undef GN_LOAD
}

#define XB_TMO      128
#define XB_XCNT(j)  (256  + 64 * (j))
#define XB_XSUB(j)  (1280 + 64 * (j))
#define XB_XGEN(j)  (2304 + 64 * (j))
#define XB_TOP      3328
#define XB_TOPGEN   3392
#define XCD_BAR_WORDS 3456
#define XB_SPIN_CAP (1u << 18)
__device__ __forceinline__ unsigned xb_ld(unsigned* p)              { return __hip_atomic_load(p, __ATOMIC_RELAXED, __HIP_MEMORY_SCOPE_AGENT); }
__device__ __forceinline__ unsigned xb_add(unsigned* p, unsigned v) { return __hip_atomic_fetch_add(p, v, __ATOMIC_RELAXED, __HIP_MEMORY_SCOPE_AGENT); }
__device__ __forceinline__ unsigned xb_xcc_id() { return (unsigned)__builtin_amdgcn_s_getreg((3 << 11) | 20) & 0xFu; }
#define XB_SPIN(cond, bar) do { unsigned _sp = 0; while (cond) { __builtin_amdgcn_s_sleep(1); \
    if ((++_sp & 255u) == 0u) { if (xb_ld(&(bar)[XB_TMO])) break; if (_sp > XB_SPIN_CAP) { atomicAdd(&(bar)[XB_TMO], 1u); break; } } } } while (0)
__device__ __forceinline__ void xcd_barrier_complete(unsigned* bar, unsigned x, unsigned& nloc, unsigned& nx) {
    const unsigned G = gridDim.x * gridDim.y * gridDim.z;
    unsigned sum, cnt, mine, sp = 0u;
    for (;;) {
        sum = 0u; cnt = 0u; mine = 0u;
#pragma unroll
        for (unsigned j = 0; j < 16; ++j) { const unsigned c = xb_ld(&bar[XB_XCNT(j)]); sum += c; cnt += (c > 0u) ? 1u : 0u; mine = (j == x) ? c : mine; }
        if (sum == G) break;
        __builtin_amdgcn_s_sleep(1);
        if ((++sp & 255u) == 0u) { if (xb_ld(&bar[XB_TMO])) break; if (sp > XB_SPIN_CAP) { atomicAdd(&bar[XB_TMO], 1u); break; } }
    }
    nloc = mine > 0u ? mine : 1u; nx = cnt > 0u ? cnt : 1u;
}
__device__ __forceinline__ void xcd_barrier(unsigned* bar, unsigned x, volatile LAS unsigned* st) {
    asm volatile("s_waitcnt vmcnt(0)" ::: "memory");
    __syncthreads();
    if (threadIdx.x == 0) {
        __builtin_amdgcn_s_waitcnt(0);
        unsigned nloc = st[0], nx = st[1];
        if (nloc == 0u) { xcd_barrier_complete(bar, x, nloc, nx); st[0] = nloc; st[1] = nx; }
        const unsigned old = xb_add(&bar[XB_XSUB(x)], 1u);
        const unsigned gen = old / nloc;
        if (old + 1u == (gen + 1u) * nloc) {
            __builtin_amdgcn_fence(__ATOMIC_RELEASE, "agent");
            asm volatile("s_waitcnt vmcnt(0)" ::: "memory");
            const unsigned og = xb_add(&bar[XB_TOP], 1u);
            const unsigned tg = og / nx;
            if (og + 1u == (tg + 1u) * nx) xb_add(&bar[XB_TOPGEN], 1u);
            else XB_SPIN(xb_ld(&bar[XB_TOPGEN]) == tg, bar);
            __builtin_amdgcn_fence(__ATOMIC_ACQUIRE, "agent");
            xb_add(&bar[XB_XGEN(x)], 1u);
            asm volatile("s_waitcnt vmcnt(0)" ::: "memory");
        } else {
            XB_SPIN(xb_ld(&bar[XB_XGEN(x)]) == gen, bar);
            __builtin_amdgcn_fence(__ATOMIC_ACQUIRE, "agent");
            asm volatile("s_waitcnt vmcnt(0)" ::: "memory");
        }
    }
    __syncthreads();
}

#ifndef PROBE_GEMM2
constexpr int NPROG = 15;
__constant__ unsigned char PROG[NPROG] = {0, 1, 2, 4, 5, 6, 7, 8, 10, 11, 13, 14, 15, 17, 18};
#else
constexpr int NPROG = 24;
__constant__ unsigned char PROG[NPROG] = {0, 1, 1, 2, 3, 4, 4, 5, 6, 7, 8, 8, 9, 10, 11, 12, 13, 13, 14, 15, 16, 17, 17, 18};
#endif
__global__ void __launch_bounds__(512, 2) fwd_mega(Params p) {
    extern __shared__ __attribute__((aligned(16))) unsigned char lds[];
    cg::grid_group grid = cg::this_grid();
    LAS unsigned char* ldsl = (LAS unsigned char*)lds;
    volatile LAS unsigned* bst = (volatile LAS unsigned*)(ldsl + 161792);
    if (threadIdx.x == 0) { bst[0] = 0u; bst[1] = 0u; (void)xb_add((unsigned*)(p.ws + R4_BAR) + XB_XCNT(xb_xcc_id()), 1u); }
    __syncthreads();
    { unsigned char* ws0 = p.ws; LAUNDER_S(ws0); phase_mod(p.in[1], p.in[2], p.in[3], (float*)(ws0 + R4_MOD), lds); }
    if (p.ws == nullptr) grid.sync();
    xcd_barrier((unsigned*)(p.ws + R4_BAR), xb_xcc_id(), bst);
#pragma unroll 1
    for (int pc = 0; pc < NPROG * 2; ++pc) {
        const int l = (pc >= NPROG) ? 1 : 0;
        const int sl = PROG[pc - NPROG * l];
        const int step = 19 * l + sl;
        if (l == 1 && sl == 0) continue;
        unsigned char* ws = p.ws; LAUNDER_S(ws);
            const int G = gridDim.x; int bid = blockIdx.x; LAUNDER_S(bid);
        const float* x = p.in[0];
        h16* hbuf = (h16*)p.out;
        h16* XN = (h16*)(ws + R1);
        h16* HID = (h16*)(ws + R0);
        h16* Pda = (h16*)(ws + R0);
        h16* Pdn = (h16*)(ws + R0);
        h16* OB = (h16*)(ws + R2);
        h16* GATE_A = (h16*)(ws + R3 + 64 * MiB); h16* GATE_B = (h16*)(ws + R3);
        h16* Tg = (h16*)(ws + R3_T); h16* QKg = (h16*)(ws + R3_QK); h16* HALO = (h16*)(ws + R3_HALO);
        h16* Wdn = (h16*)(ws + R3_WDN); h16* Wda = (h16*)(ws + R3_WDA);
        const size_t ffoff = (l == 1 && (sl == 1 || sl == 2)) ? 32 * MiB : 0;
        h16* W1t = (h16*)(ws + R3_W1 + ffoff); h16* W2t = (h16*)(ws + R3_W2 + ffoff);
        h16* Wg = (h16*)(ws + R4_WG); h16* Wa = (h16*)(ws + R4_WA); h16* Wb = (h16*)(ws + R4_WB); h16* Wo = (h16*)(ws + R4_WO);
        float* MOD = (float*)(ws + R4_MOD); float* BD = (float*)(ws + R4_BD); float* LSE = (float*)(ws + R4_LSE);
        float* GC = (float*)(ws + R4_GC); float* BETA = (float*)(ws + R4_BETA);


        const float* modl = MOD + (unsigned)l * 8 * 9216;
        const bool first = (step == 0) || (step == 2);
        const float* hin32 = first ? x : (const float*)nullptr;
        if (sl == 0) {
            if (step == 0) phase_norm(hin32, hbuf, p.in[4], modl, 0, 1, XN);
        } else if (sl == 1 || sl == 17) {
            pg8::Gemm gm{XN, W1t, M_TOK, 2 * FF, 1024, 1024}; pg8::StaticOrder S; S.init(M_TOK, 2 * FF, G, bid);
            pg8::EpiSwiglu E{HID}; pg8::gemm_phase(ldsl, gm, S, E);
        } else if (sl == 2 || sl == 18 || sl == 15) {
            const bool wo = (sl == 15);
            pg8::Gemm gm{wo ? XN : HID, wo ? Wo : W2t, M_TOK, 1024, wo ? 1024 : FF, wo ? 1024 : FF}; pg8::StaticOrder S; S.init(M_TOK, 1024, G, bid);
            const bool lastffn = (l == 1 && sl == 18);
            h16* HB2 = (h16*)(ws + R3 + 32 * MiB);
            if (!lastffn) {
                const int nl = (sl == 18) ? 1 : l;
                const float* modn = MOD + (unsigned)nl * 8 * 9216;
                const int nsh = (sl == 2) ? 3 : (sl == 15 ? 6 : 0);
                const float* lnn = ((sl == 2) ? p.in[5] : (sl == 15 ? p.in[6] : p.in[4])) + nl * 1024;
                const unsigned use = (l == 0) ? (sl == 2 ? 1u : (sl == 15 ? 2u : 3u)) : (sl == 2 ? 4u : 5u);
                if (first) {
                    pg8::EpiResidNorm<true> E{x, hbuf, hbuf, modl + 2 * 1024, 0.5f, XN, lnn, modn + nsh * 1024, modn + (nsh + 1) * 1024,
                                              (float*)(ws + R2), (unsigned*)(p.ws + R4_BAR + 16384), 4u * use, (float*)nullptr, ldsl + 131072};
                    pg8::gemm_phase(ldsl, gm, S, E);
                } else {
                    pg8::EpiResidNorm<false> E{nullptr, hbuf, (wo && l == 1) ? HB2 : hbuf, modl + (wo ? 5 : (sl == 2 ? 2 : 8)) * 1024, wo ? 1.0f : 0.5f, XN, lnn, modn + nsh * 1024, modn + (nsh + 1) * 1024,
                                               (float*)(ws + R2), (unsigned*)(p.ws + R4_BAR + 16384), 4u * use, (float*)nullptr, ldsl + 131072};
                    pg8::gemm_phase(ldsl, gm, S, E);
                }
            } else {
                pg8::EpiResidNorm<false, true> E{nullptr, HB2, HB2, modl + 8 * 1024, 0.5f, XN, p.in[21], p.in[21], p.in[21],
                                                 (float*)(ws + R2), (unsigned*)(p.ws + R4_BAR + 16384), 4u * 6u, p.out, ldsl + 131072};
                pg8::gemm_phase(ldsl, gm, S, E);
            }
        } else if (sl == 4 || sl == 8 || sl == 13) {
            if (sl == 13) phase_gnorm(Pdn, p.in[14] + l * 128);
            const int N = (sl == 4) ? 2560 : (sl == 8 ? 4096 : 1024);
            pg8::Gemm gm{XN, sl == 4 ? Wda : (sl == 8 ? Wdn : Wg + 1024 * 1024), M_TOK, N, 1024, 1024}; pg8::StaticOrder S; S.init(M_TOK, N, G, bid);
            pg8::EpiStore E{sl == 4 ? Pda : (sl == 8 ? Pdn : GATE_B), sl == 4 ? 2304 : (sl == 8 ? 4096 : 1024), BD, sl == 4 ? 9 : (sl == 8 ? 16 : 4), sl == 13 ? 1 : 0, sl == 8 ? HALO : (h16*)nullptr};
            pg8::gemm_phase(ldsl, gm, S, E);
        } else if (sl >= 5 && sl <= 7) {
            phase_attn(Pda, OB, LSE, sl - 5, lds);
        } else if (sl == 10) {
            phase_dnprep(Pdn, HALO, BD, p.in[11] + (unsigned)l * 4 * 3072, p.in[12] + l * 8, p.in[13] + l * 8, Tg, QKg, GC, BETA, ldsl, lds);
        } else if (sl == 11) {
            if (bid < 128) {
                phase_scan(Pdn, Tg, QKg, GC, BETA, lds);
            } else {
                pg8::Gemm gm{XN, Wg, M_TOK, 1024, 1024, 1024}; pg8::StaticOrder S; S.init(M_TOK, 1024, G - 128, bid - 128);
                pg8::EpiStore E{GATE_A, 1024, BD, 4, 1, (h16*)nullptr}; pg8::gemm_phase(ldsl, gm, S, E);
            }
        } else if (sl == 14) {
#pragma unroll 1
            for (int q = 0; q < 2; ++q) {
                pg8::Gemm gm{q ? OB : Pdn + 2048, q ? Wb : Wa, M_TOK, 1024, q ? 768 : 1024, q ? 768 : 4096}; pg8::StaticOrder S; S.init(M_TOK, 1024, G, bid);
                pg8::EpiMerge E{XN, q ? GATE_B : GATE_A, q}; pg8::gemm_phase(ldsl, gm, S, E);
                __syncthreads();
            }
        }
        {
            const int ck = (sl == 0) ? 0 : (sl == 2 ? 3 : (sl == 15 ? 16 : ((sl == 18 && l == 0) ? 0 : -1)));
            const int cl = (sl == 18) ? 1 : l;
            h16* cW1 = (h16*)(ws + R3_W1 + ((sl == 18) ? 32 * MiB : 0)); h16* cW2 = (h16*)(ws + R3_W2 + ((sl == 18) ? 32 * MiB : 0));
            if (ck >= 0) {
            const int nconv = (ck == 3) ? 7 : 3;
    #pragma unroll 1
                for (int ci = 0; ci < nconv; ++ci) {
                    const float* src; int ldsrc, coloff = 0, nvalid, Ntot, K = 1024, inter = -1; h16* dst;
                    if (ck == 3) {
                        const float* win = p.in[10] + (unsigned)l * 1024 * 8464;
                        if (ci == 0)      { src = win; ldsrc = 8464; coloff = 4112; nvalid = 2304; Ntot = 2304; dst = Wda; }
                        else if (ci == 1) { src = win; ldsrc = 8464; coloff = 0;    nvalid = 4096; Ntot = 4096; dst = Wdn; }
                        else if (ci == 6) { src = win; ldsrc = 8464; coloff = 4096; nvalid = 16;   Ntot = 256;  dst = Wda + 2304 * 1024; }
                        else if (ci == 2) { src = win; ldsrc = 8464; coloff = 6416; nvalid = 2048; Ntot = 2048; dst = Wg; }
                        else if (ci == 3) { src = p.in[15] + (unsigned)l * 1024 * 1024; ldsrc = 1024; nvalid = 1024; Ntot = 1024; dst = Wa; }
                        else if (ci == 4) { src = p.in[16] + (unsigned)l * 768 * 1024;  ldsrc = 1024; nvalid = 1024; Ntot = 1024; K = 768; dst = Wb; }
                        else              { src = p.in[17] + (unsigned)l * 1024 * 1024; ldsrc = 1024; nvalid = 1024; Ntot = 1024; dst = Wo; }
                    } else {
                        const bool f2 = (ck == 16);
                        if (ci == 0)      { src = (f2 ? p.in[18] : p.in[7]) + (unsigned)cl * 1024 * FF; ldsrc = FF; nvalid = FF; Ntot = FF; dst = cW1; inter = 0; }
                        else if (ci == 1) { src = (f2 ? p.in[19] : p.in[8]) + (unsigned)cl * 1024 * FF; ldsrc = FF; nvalid = FF; Ntot = FF; dst = cW1; inter = 1; }
                        else              { src = (f2 ? p.in[20] : p.in[9]) + (unsigned)cl * FF * 1024; ldsrc = 1024; nvalid = 1024; Ntot = 1024; K = FF; dst = cW2; }
                    }
                    conv_w(src, ldsrc, coloff, nvalid, Ntot, K, dst, inter, lds);
                }

            }
        }
        xcd_barrier((unsigned*)(p.ws + R4_BAR), xb_xcc_id(), bst);
    }
}

extern "C" void kernel_launch(void* const* d_in, const int* in_sizes, int n_in, void* d_out, int out_size, void* d_ws, size_t ws_size, hipStream_t stream) {
    static int grid = 0;
    if (grid == 0) {
        if (n_in != 22 || ws_size < WS_NEED) { fprintf(stderr, "kernel_launch: unexpected n_in %d or ws_size %zu (< %zu)\n", n_in, ws_size, (size_t)WS_NEED); grid = -1; return; }
        int dev = 0, cus = 0, per_cu = 0;
        hipGetDevice(&dev);
        hipDeviceGetAttribute(&cus, hipDeviceAttributeMultiprocessorCount, dev);
        hipFuncSetAttribute((const void*)fwd_mega, hipFuncAttributeMaxDynamicSharedMemorySize, LDS_BYTES);
        hipOccupancyMaxActiveBlocksPerMultiprocessor(&per_cu, (const void*)fwd_mega, 512, LDS_BYTES);
        if (per_cu < 1) per_cu = 1;
        if (per_cu > 1) per_cu = 1;
        grid = cus * per_cu;
        (void)hipGetLastError();
    }
    if (grid < 0) return;
    Params p{};
    for (int i = 0; i < 22; ++i) p.in[i] = (const float*)d_in[i];
    p.out = (float*)d_out; p.ws = (unsigned char*)d_ws;
    (void)hipMemsetAsync((unsigned char*)d_ws + R4_BAR, 0, 32768, stream);
    void* args[] = {&p};
    hipError_t e = hipLaunchCooperativeKernel((const void*)fwd_mega, dim3(grid), dim3(512), args, LDS_BYTES, stream);
    if (e != hipSuccess) fprintf(stderr, "cooperative launch failed: %s (grid %d)\n", hipGetErrorString(e), grid);
}
```

```cpp
#include <hip/hip_runtime.h>
#include <hip/hip_cooperative_groups.h>
#include <cstdio>
namespace cg = cooperative_groups;

typedef _Float16 h16;
typedef _Float16 h16x2 __attribute__((ext_vector_type(2)));
typedef _Float16 h16x4 __attribute__((ext_vector_type(4)));
typedef _Float16 h16x8 __attribute__((ext_vector_type(8)));
typedef float f32x4 __attribute__((ext_vector_type(4)));
#define LAS __attribute__((address_space(3)))
#define GAS __attribute__((address_space(1)))
template <class T> __device__ __forceinline__ T gld(const T* p) { return *(const GAS T*)p; }
template <class T> __device__ __forceinline__ void gst(T* p, T v) { *(GAS T*)p = v; }

constexpr int M_TOK = 32768, DM = 1024, FF = 2816, SEQ = 4096;
constexpr size_t MiB = 1024ull * 1024ull;
constexpr size_t R0 = 0;
constexpr size_t R1 = 256 * MiB;
constexpr size_t R2 = 320 * MiB;
constexpr size_t R3 = 368 * MiB;
constexpr size_t R4 = 496 * MiB;
constexpr size_t R3_T = R3, R3_QK = R3 + 32 * MiB, R3_HALO = R3 + 64 * MiB, R3_WDN = R3 + 74 * MiB, R3_WDA = R3 + 83 * MiB;
constexpr size_t R3_W1 = R3, R3_W2 = R3 + 12 * MiB;
constexpr size_t KiB = 1024ull;
constexpr size_t R4_WG = R4, R4_WA = R4 + 4096 * KiB, R4_WB = R4 + 6144 * KiB, R4_WO = R4 + 7680 * KiB, R4_MOD = R4 + 9728 * KiB,
                 R4_BD = R4 + 10496 * KiB, R4_LSE = R4 + 12544 * KiB, R4_GC = R4 + 14080 * KiB, R4_BETA = R4 + 15104 * KiB, R4_BAR = R4 + 16256 * KiB;
constexpr size_t WS_NEED = 512 * MiB;
constexpr int LDS_BYTES = 161792 + 64;

__device__ __forceinline__ float shx(float v, int m, int lane) { return __int_as_float(__builtin_amdgcn_ds_bpermute((lane ^ m) << 2, __float_as_int(v))); }
__device__ __forceinline__ float wave_sum(float v, int lane) {
#pragma unroll
    for (int o = 32; o > 0; o >>= 1) v += shx(v, o, lane);
    return v;
}
__device__ __forceinline__ float fexp(float x) { return __builtin_amdgcn_exp2f(x * 1.4426950408889634f); }
__device__ __forceinline__ float flog(float x) { return __builtin_amdgcn_logf(x) * 0.6931471805599453f; }
__device__ __forceinline__ float silu_f(float x) { return x * __builtin_amdgcn_rcpf(1.0f + fexp(-x)); }
__device__ __forceinline__ float sigm_f(float x) { return __builtin_amdgcn_rcpf(1.0f + fexp(-x)); }
__device__ __forceinline__ h16x8 cat8(h16x4 a, h16x4 b) { return __builtin_shufflevector(a, b, 0, 1, 2, 3, 4, 5, 6, 7); }
typedef short s16x4v __attribute__((__vector_size__(8)));
__device__ __forceinline__ h16x4 tr_read4(const h16* p) { return __builtin_bit_cast(h16x4, __builtin_amdgcn_ds_read_tr16_b64_v4i16((LAS s16x4v*)p)); }
#define LDS_BARRIER() do { asm volatile("s_waitcnt lgkmcnt(0)" ::: "memory"); __builtin_amdgcn_s_barrier(); asm volatile("" ::: "memory"); } while (0)
#define LAUNDER_V(x) asm volatile("" : "+v"(x))
#define LAUNDER_S(x) asm volatile("" : "+s"(x))
#define MFMA16(a, b, c) __builtin_amdgcn_mfma_f32_16x16x32_f16((a), (b), (c), 0, 0, 0)

namespace pg8 {
constexpr int BM = 256, BK = 64, HALF = 128, HTB = HALF * BK * 2, NXCD = 8, WGM = 8;
__device__ __forceinline__ int lds_byte(int r, int c) { const int st = (r >> 4) * 2 + (c >> 5), rr = r & 15, cc = c & 31, ob = rr * 64 + cc * 2; return st * 1024 + (ob ^ (((ob >> 9) & 1) << 5)); }
__device__ __forceinline__ void stage_rc(int b, int& R, int& C) { const int st = b / 1024, sb = b % 1024, swz = sb ^ (((sb >> 9) & 1) << 5); R = (st >> 1) * 16 + swz / 64; C = (st & 1) * 32 + (swz % 64) / 2; }
__device__ __forceinline__ int perm32(int rho) { const int n = rho >> 4, i = rho & 15; return 8 * (i >> 2) + 4 * n + (i & 3); }
struct Unit { int pm, pn; };
struct Gemm { const h16* A; const h16* Bt; int M, N, K, lda; };
struct StaticOrder {
    int nM, nN, nwg, G, c;
    __device__ void init(int M, int N, int G_, int c_) { nM = M / BM; nN = N / BM; nwg = nM * nN; G = G_; c = c_; }
    __device__ bool next(int i, Unit& u) const {
        const long L = (long)i * G + c; if (L >= nwg) return false;
        int wgid = (int)L; { const int q = nwg / NXCD, r = nwg % NXCD, xcd = wgid % NXCD, off = wgid / NXCD; wgid = (xcd < r ? xcd * (q + 1) : r * (q + 1) + (xcd - r) * q) + off; }
        const int nig = WGM * nN, gid = wgid / nig, fm = gid * WGM, gsz = (nM - fm) < WGM ? (nM - fm) : WGM;
        u.pm = fm + ((wgid % nig) % gsz); u.pn = (wgid % nig) / gsz; return true;
    }
};

struct EpiSwiglu {
    static constexpr bool PERM = true;
    h16* O;
    __device__ __forceinline__ void operator()(const f32x4 (&acc)[2][2][4][2], const Unit& u, int wr, int wc, int fr, int fq) const {
        const int row0 = u.pm * BM + wr * 64 + fr, col0 = u.pn * 128 + wc * 32 + 8 * fq;
#pragma unroll
        for (int ai = 0; ai < 2; ++ai)
#pragma unroll
            for (int m = 0; m < 4; ++m) {
                h16x8 o;
#pragma unroll
                for (int n = 0; n < 2; ++n)
#pragma unroll
                    for (int j = 0; j < 4; ++j) o[4 * n + j] = (h16)(silu_f(acc[ai][0][m][n][j]) * acc[ai][1][m][n][j]);
                *(h16x8*)(O + (unsigned)(row0 + ai * HALF + m * 16) * FF + col0) = o;
            }
    }
};
struct EpiStore {
    static constexpr bool PERM = true;
    h16* O; int ldc; float* bd; int nmain; int act; h16* halo;
    __device__ __forceinline__ void operator()(const f32x4 (&acc)[2][2][4][2], const Unit& u, int wr, int wc, int fr, int fq) const {
        const int row0 = u.pm * BM + wr * 64 + fr;
        if (u.pn < nmain) {
            const int col0 = u.pn * BM + wc * 32 + 8 * fq;
#pragma unroll
            for (int ai = 0; ai < 2; ++ai)
#pragma unroll
                for (int m = 0; m < 4; ++m)
#pragma unroll
                    for (int bj = 0; bj < 2; ++bj) {
                        h16x8 o;
#pragma unroll
                        for (int n = 0; n < 2; ++n)
#pragma unroll
                            for (int j = 0; j < 4; ++j) { float v = acc[ai][bj][m][n][j]; if (act) v = sigm_f(v); o[4 * n + j] = (h16)v; }
                        *(h16x8*)(O + (unsigned)(row0 + ai * HALF + m * 16) * ldc + col0 + bj * HALF) = o;
                        if (halo && m == 3 && fr >= 13 && u.pn < 12) {
                            const int row = row0 + ai * HALF + 48, nc = ((row & 4095) >> 6) + 1;
                            if (nc < 64) *(h16x8*)(halo + ((unsigned)((row >> 12) * 64 + nc) * 3 + (fr - 13)) * 3072 + col0 + bj * HALF) = o;
                        }
                    }
        } else if (wc == 0 && fq < 2) {
#pragma unroll
            for (int ai = 0; ai < 2; ++ai)
#pragma unroll
                for (int m = 0; m < 4; ++m)
#pragma unroll
                    for (int n = 0; n < 2; ++n) *(f32x4*)(bd + (unsigned)(row0 + ai * HALF + m * 16) * 16 + 8 * fq + 4 * n) = acc[ai][0][m][n];
        }
    }
};
struct EpiResid {
    static constexpr bool PERM = true;
    const float* in32; const h16* in16; h16* out; const float* gate; float coef;
    __device__ __forceinline__ void operator()(const f32x4 (&acc)[2][2][4][2], const Unit& u, int wr, int wc, int fr, int fq) const {
        const int row0 = u.pm * BM + wr * 64 + fr, col0 = u.pn * BM + wc * 32 + 8 * fq;
        const int b = (u.pm * BM) >> 12;
        f32x4 gv[2][2];
#pragma unroll
        for (int bj = 0; bj < 2; ++bj)
#pragma unroll
            for (int n = 0; n < 2; ++n) gv[bj][n] = *(const f32x4*)(gate + b * 9216 + col0 + bj * HALF + 4 * n) * coef;
        if (in32) {
#pragma unroll
            for (int ai = 0; ai < 2; ++ai)
#pragma unroll
                for (int m = 0; m < 4; ++m)
#pragma unroll
                    for (int bj = 0; bj < 2; ++bj) {
                        const unsigned off = (unsigned)(row0 + ai * HALF + m * 16) * DM + col0 + bj * HALF;
                        const f32x4 x0 = *(const f32x4*)(in32 + off), x1 = *(const f32x4*)(in32 + off + 4);
                        h16x8 o;
#pragma unroll
                        for (int j = 0; j < 4; ++j) { o[j] = (h16)(x0[j] + gv[bj][0][j] * acc[ai][bj][m][0][j]); o[4 + j] = (h16)(x1[j] + gv[bj][1][j] * acc[ai][bj][m][1][j]); }
                        *(h16x8*)(out + off) = o;
                    }
        } else {
#pragma unroll
            for (int ai = 0; ai < 2; ++ai)
#pragma unroll
                for (int m = 0; m < 4; ++m)
#pragma unroll
                    for (int bj = 0; bj < 2; ++bj) {
                        const unsigned off = (unsigned)(row0 + ai * HALF + m * 16) * DM + col0 + bj * HALF;
                        const h16x8 xv = *(const h16x8*)(in16 + off);
                        h16x8 o;
#pragma unroll
                        for (int j = 0; j < 4; ++j) { o[j] = (h16)((float)xv[j] + gv[bj][0][j] * acc[ai][bj][m][0][j]); o[4 + j] = (h16)((float)xv[4 + j] + gv[bj][1][j] * acc[ai][bj][m][1][j]); }
                        *(h16x8*)(out + off) = o;
                    }
        }
    }
};
template <bool F32IN, bool FINAL = false> struct EpiResidNorm {
    static constexpr bool PERM = true;
    const float* in32; const h16* in16; h16* out; const float* gate; float coef;
    h16* xn; const float* ln; const float* shp; const float* scp;
    float* ss; unsigned* cnt; unsigned target;
    float* fout;
    LAS unsigned char* sm;
    __device__ __forceinline__ void operator()(const f32x4 (&acc)[2][2][4][2], const Unit& u, int wr, int wc, int fr, int fq) const {
        const int lane = fq * 16 + fr, wid = wr * 4 + wc, tid = wid * 64 + lane;
        const int row0 = u.pm * BM + wr * 64 + fr, col0 = u.pn * BM + wc * 32 + 8 * fq;
        const int b = (u.pm * BM) >> 12;
        LAS float* red = (LAS float*)sm; LAS float* rs = red + 1024;
        f32x4 gv[2][2];
#pragma unroll
        for (int bj = 0; bj < 2; ++bj)
#pragma unroll
            for (int n = 0; n < 2; ++n) gv[bj][n] = *(const f32x4*)(gate + b * 9216 + col0 + bj * HALF + 4 * n) * coef;
        h16x8 ov[2][4][2];
#pragma unroll
        for (int ai = 0; ai < 2; ++ai)
#pragma unroll
            for (int m = 0; m < 4; ++m) {
                float sq = 0.f;
#pragma unroll
                for (int bj = 0; bj < 2; ++bj) {
                    const unsigned off = (unsigned)(row0 + ai * HALF + m * 16) * DM + col0 + bj * HALF;
                    f32x4 xa, xb;
                    if (F32IN) { xa = *(const f32x4*)(in32 + off); xb = *(const f32x4*)(in32 + off + 4); }
                    else { const h16x8 xv = *(const h16x8*)(in16 + off); xa = (f32x4){(float)xv[0], (float)xv[1], (float)xv[2], (float)xv[3]}; xb = (f32x4){(float)xv[4], (float)xv[5], (float)xv[6], (float)xv[7]}; }
                    h16x8 o;
#pragma unroll
                    for (int j = 0; j < 4; ++j) { o[j] = (h16)(xa[j] + gv[bj][0][j] * acc[ai][bj][m][0][j]); o[4 + j] = (h16)(xb[j] + gv[bj][1][j] * acc[ai][bj][m][1][j]); }
                    if (!FINAL) *(h16x8*)(out + off) = o;
                    ov[ai][m][bj] = o;
#pragma unroll
                    for (int j = 0; j < 8; ++j) sq += (float)o[j] * (float)o[j];
                }
                sq += shx(sq, 16, lane); sq += shx(sq, 32, lane);
                if (fq == 0) red[(ai * HALF + wr * 64 + m * 16 + fr) * 4 + wc] = sq;
            }
        asm volatile("s_waitcnt lgkmcnt(0)" ::: "memory"); __builtin_amdgcn_s_barrier(); asm volatile("" ::: "memory");
        if (tid < 256) {
            const float part = (red[tid * 4 + 0] + red[tid * 4 + 1]) + (red[tid * 4 + 2] + red[tid * 4 + 3]);
            __hip_atomic_store(ss + (unsigned)(u.pm * 4 + u.pn) * 256 + tid, part, __ATOMIC_RELAXED, __HIP_MEMORY_SCOPE_AGENT);
        }
        asm volatile("s_waitcnt vmcnt(0)" ::: "memory");
        __builtin_amdgcn_s_barrier(); asm volatile("" ::: "memory");
        if (tid == 0) {
            (void)__hip_atomic_fetch_add(cnt + 16 * u.pm, 1u, __ATOMIC_RELAXED, __HIP_MEMORY_SCOPE_AGENT);
            unsigned spins = 0;
            while (__hip_atomic_load(cnt + 16 * u.pm, __ATOMIC_RELAXED, __HIP_MEMORY_SCOPE_AGENT) < target) { __builtin_amdgcn_s_sleep(1); if (++spins > (1u << 20)) break; }
        }
        __builtin_amdgcn_s_barrier(); asm volatile("" ::: "memory");
        if (tid < 256) {
            float tot = 0.f;
#pragma unroll
            for (int q = 0; q < 4; ++q) tot += __hip_atomic_load(ss + (unsigned)(u.pm * 4 + q) * 256 + tid, __ATOMIC_RELAXED, __HIP_MEMORY_SCOPE_AGENT);
            rs[tid] = rsqrtf(tot * (1.0f / 1024.0f) + 1e-6f);
        }
        asm volatile("s_waitcnt lgkmcnt(0)" ::: "memory"); __builtin_amdgcn_s_barrier(); asm volatile("" ::: "memory");
        const float* sh = FINAL ? ln : shp + b * 9216; const float* sc = FINAL ? ln : scp + b * 9216;
#pragma unroll
        for (int bj = 0; bj < 2; ++bj) {
            const int col = col0 + bj * HALF;
            const f32x4 l0 = *(const f32x4*)(ln + col), l1 = *(const f32x4*)(ln + col + 4), s0 = *(const f32x4*)(sh + col), s1 = *(const f32x4*)(sh + col + 4),
                        c0 = *(const f32x4*)(sc + col), c1 = *(const f32x4*)(sc + col + 4);
#pragma unroll
            for (int ai = 0; ai < 2; ++ai)
#pragma unroll
                for (int m = 0; m < 4; ++m) {
                    const float rstd = rs[ai * HALF + wr * 64 + m * 16 + fr];
                    const h16x8 o = ov[ai][m][bj];
                    if (FINAL) {
                        f32x4 y0, y1;
#pragma unroll
                        for (int j = 0; j < 4; ++j) { y0[j] = (float)o[j] * rstd * l0[j]; y1[j] = (float)o[4 + j] * rstd * l1[j]; }
                        float* yp = fout + (unsigned)(row0 + ai * HALF + m * 16) * DM + col;
                        *(f32x4*)yp = y0; *(f32x4*)(yp + 4) = y1;
                    } else {
                        h16x8 y;
#pragma unroll
                        for (int j = 0; j < 4; ++j) { y[j] = (h16)((float)o[j] * rstd * l0[j] * (1.0f + c0[j]) + s0[j]); y[4 + j] = (h16)((float)o[4 + j] * rstd * l1[j] * (1.0f + c1[j]) + s1[j]); }
                        *(h16x8*)(xn + (unsigned)(row0 + ai * HALF + m * 16) * DM + col) = y;
                    }
                }
        }
    }
};
struct EpiMerge {
    static constexpr bool PERM = true;
    h16* Mg; const h16* gates; int add;
    __device__ __forceinline__ void operator()(const f32x4 (&acc)[2][2][4][2], const Unit& u, int wr, int wc, int fr, int fq) const {
        const int row0 = u.pm * BM + wr * 64 + fr, col0 = u.pn * BM + wc * 32 + 8 * fq;
#pragma unroll
        for (int ai = 0; ai < 2; ++ai)
#pragma unroll
            for (int m = 0; m < 4; ++m)
#pragma unroll
                for (int bj = 0; bj < 2; ++bj) {
                    const unsigned row = (unsigned)(row0 + ai * HALF + m * 16);
                    const int col = col0 + bj * HALF;
                    const h16x8 gv = *(const h16x8*)(gates + row * DM + col);
                    h16x8 pv = {0, 0, 0, 0, 0, 0, 0, 0};
                    if (add) pv = *(const h16x8*)(Mg + row * DM + col);
                    h16x8 o;
#pragma unroll
                    for (int n = 0; n < 2; ++n)
#pragma unroll
                        for (int j = 0; j < 4; ++j) o[4 * n + j] = (h16)((float)pv[4 * n + j] + (float)gv[4 * n + j] * acc[ai][bj][m][n][j]);
                    *(h16x8*)(Mg + row * DM + col) = o;
                }
    }
};

template <class Epi>
__device__ __forceinline__ void gemm_phase(LAS unsigned char* lds, const Gemm g, const StaticOrder& S, const Epi& E) {
    int tid = threadIdx.x; LAUNDER_V(tid);
    const int wid = __builtin_amdgcn_readfirstlane(tid >> 6), lane = tid & 63, wr = wid >> 2, wc = wid & 3, fr = lane & 15, fq = lane >> 4;
    const int K = g.K, nt = K / BK;
    unsigned voffA[2], voffB[2];
#pragma unroll
    for (int i = 0; i < 2; ++i) { int R, C; stage_rc(tid * 16 + i * 8192, R, C); const int Rb = Epi::PERM ? ((R & ~31) + perm32(R & 31)) : R;
        voffA[i] = (unsigned)(R * g.lda + C) * 2u; voffB[i] = (unsigned)(Rb * K + C) * 2u; }
    const size_t kstep = (size_t)(BK * 2);
    const size_t hstepA = (size_t)HALF * g.lda * 2, hstepB = (size_t)HALF * K * 2;
    const size_t tstepA = 2 * hstepA, tstepB = 2 * hstepB;
    const unsigned ldsw = (unsigned)wid * 1024u;
    const int aoff = lds_byte(wr * 64 + fr, fq * 8), boff = lds_byte(wc * 32 + fr, fq * 8);
#define PG8_SA(b, h) (((b) * 2 + (h)) * HTB)
#define PG8_SB(b, h) ((4 + (b) * 2 + (h)) * HTB)
#define PG8_STAGE(bufoff, gbase, voff) do { _Pragma("unroll") for (int _i = 0; _i < 2; ++_i) \
        __builtin_amdgcn_global_load_lds((const unsigned*)((const char*)(gbase) + (voff)[_i]), (LAS unsigned*)(lds + (bufoff) + ldsw + _i * 8192), 16, 0, 0); } while (0)
#define PG8_LDA(dst, b, h) do { _Pragma("unroll") for (int m = 0; m < 4; ++m) _Pragma("unroll") for (int k = 0; k < 2; ++k) dst[m][k] = *(const LAS h16x8*)(lds + PG8_SA(b, h) + aoff + m * 2048 + k * 1024); } while (0)
#define PG8_LDB(dst, b, h) do { _Pragma("unroll") for (int n = 0; n < 2; ++n) _Pragma("unroll") for (int k = 0; k < 2; ++k) dst[n][k] = *(const LAS h16x8*)(lds + PG8_SB(b, h) + boff + n * 2048 + k * 1024); } while (0)
#define PG8_MMA(ai, bj, At, Bt) do { __builtin_amdgcn_s_setprio(1); _Pragma("unroll") for (int m = 0; m < 4; ++m) _Pragma("unroll") for (int n = 0; n < 2; ++n) _Pragma("unroll") for (int k = 0; k < 2; ++k) \
        acc[ai][bj][m][n] = __builtin_amdgcn_mfma_f32_16x16x32_f16(Bt[n][k], At[m][k], acc[ai][bj][m][n], 0, 0, 0); __builtin_amdgcn_s_setprio(0); } while (0)
#define PG8_WAIT_V(n) asm volatile("s_waitcnt vmcnt(" #n ")" ::: "memory")
#define PG8_WAIT_L(n) asm volatile("s_waitcnt lgkmcnt(" #n ")" ::: "memory")
#define PG8_BAR __builtin_amdgcn_s_barrier()
#define PG8_SCHED __builtin_amdgcn_sched_barrier(0)
    Unit cur, nxt; int ui = 0;
    if (!S.next(0, cur)) return;
    f32x4 acc[2][2][4][2];
#pragma unroll
    for (int a = 0; a < 2; ++a)
#pragma unroll
        for (int b = 0; b < 2; ++b)
#pragma unroll
            for (int m = 0; m < 4; ++m)
#pragma unroll
                for (int n = 0; n < 2; ++n) acc[a][b][m][n] = (f32x4){0.f, 0.f, 0.f, 0.f};
    h16x8 At[4][2], B0[2][2], B1[2][2];
    const char* cA = (const char*)g.A + (size_t)cur.pm * tstepA; const char* cB = (const char*)g.Bt + (size_t)cur.pn * tstepB;
    PG8_STAGE(PG8_SB(0, 0), cB, voffB); PG8_STAGE(PG8_SB(0, 1), cB + hstepB, voffB); PG8_STAGE(PG8_SA(0, 0), cA, voffA); PG8_STAGE(PG8_SA(0, 1), cA + hstepA, voffA);
    if (wr == 1) PG8_BAR;
    PG8_WAIT_V(2); PG8_BAR;
    PG8_STAGE(PG8_SB(1, 0), cB + kstep, voffB); PG8_STAGE(PG8_SA(1, 0), cA + kstep, voffA); PG8_STAGE(PG8_SB(1, 1), cB + hstepB + kstep, voffB);
    PG8_WAIT_V(6); PG8_BAR;
    for (;;) {
        const bool has_next = S.next(ui + 1, nxt);
        const char* nA = has_next ? (const char*)g.A + (size_t)nxt.pm * tstepA : cA; const char* nB = has_next ? (const char*)g.Bt + (size_t)nxt.pn * tstepB : cB;
        for (int t = 0; t < nt; t += 2) {
            const bool last = (t == nt - 2);
            const char* a1 = cA + (size_t)(t + 1) * kstep;
            const char* a2 = last ? nA : cA + (size_t)(t + 2) * kstep; const char* b2 = last ? nB : cB + (size_t)(t + 2) * kstep;
            const char* a3 = a2 + kstep; const char* b3 = b2 + kstep;
            PG8_LDB(B0, 0, 0); PG8_LDB(B1, 0, 1); PG8_SCHED; PG8_LDA(At, 0, 0); PG8_STAGE(PG8_SA(1, 1), a1 + hstepA, voffA);
            PG8_WAIT_V(8); PG8_WAIT_L(0); PG8_BAR; PG8_MMA(0, 0, At, B0); PG8_MMA(0, 1, At, B1); PG8_BAR; PG8_SCHED;
            PG8_LDA(At, 0, 1); PG8_STAGE(PG8_SB(0, 0), b2, voffB); PG8_STAGE(PG8_SB(0, 1), b2 + hstepB, voffB); PG8_STAGE(PG8_SA(0, 0), a2, voffA);
            PG8_WAIT_V(8); PG8_WAIT_L(0); PG8_BAR; PG8_MMA(1, 0, At, B0); PG8_MMA(1, 1, At, B1); PG8_BAR; PG8_SCHED;
            PG8_LDB(B0, 1, 0); PG8_LDB(B1, 1, 1); PG8_SCHED; PG8_LDA(At, 1, 0); PG8_STAGE(PG8_SA(0, 1), a2 + hstepA, voffA);
            PG8_WAIT_V(8); PG8_WAIT_L(0); PG8_BAR; PG8_MMA(0, 0, At, B0); PG8_MMA(0, 1, At, B1); PG8_BAR; PG8_SCHED;
            PG8_LDA(At, 1, 1); PG8_STAGE(PG8_SB(1, 0), b3, voffB); PG8_STAGE(PG8_SB(1, 1), b3 + hstepB, voffB); PG8_STAGE(PG8_SA(1, 0), a3, voffA);
            PG8_WAIT_V(8); PG8_WAIT_L(0); PG8_BAR; PG8_MMA(1, 0, At, B0); PG8_MMA(1, 1, At, B1); PG8_BAR; PG8_SCHED;
        }
        if (wr == 0) PG8_BAR;
        E(acc, cur, wr, wc, fr, fq);
        if (!has_next) break;
#pragma unroll
        for (int a = 0; a < 2; ++a)
#pragma unroll
            for (int b = 0; b < 2; ++b)
#pragma unroll
                for (int m = 0; m < 4; ++m)
#pragma unroll
                    for (int n = 0; n < 2; ++n) acc[a][b][m][n] = (f32x4){0.f, 0.f, 0.f, 0.f};
        cur = nxt; cA = nA; cB = nB; ++ui;
        if (wr == 1) PG8_BAR;
    }
    PG8_WAIT_V(0);
    PG8_BAR;
#undef PG8_SA
#undef PG8_SB
#undef PG8_STAGE
#undef PG8_LDA
#undef PG8_LDB
#undef PG8_MMA
#undef PG8_WAIT_V
#undef PG8_WAIT_L
#undef PG8_BAR
#undef PG8_SCHED
}
}

struct Params {
    const float* in[22];
    float* out;
    unsigned char* ws;
};

__device__ __forceinline__ void phase_mod(const float* c, const float* ada_w, const float* ada_b, float* mod, unsigned char* ldsb) {
    float* cact = (float*)ldsb;
    float* red = cact + 8192;
    int tid = threadIdx.x; LAUNDER_V(tid); int bid = blockIdx.x; LAUNDER_S(bid);
    const int lane = tid & 63, w = __builtin_amdgcn_readfirstlane(tid >> 6);
    for (int i = tid; i < 8192; i += 512) cact[i] = silu_f(c[i]);
    LDS_BARRIER();
    for (int item = bid; item < 288; item += gridDim.x) {
        const int l = item / 144, n0 = (item % 144) * 64;
        const float* W = ada_w + (unsigned)l * 1024 * 9216 + n0 + lane;
        float acc[8];
#pragma unroll
        for (int b = 0; b < 8; ++b) acc[b] = 0.f;
        const int k0 = w * 128;
#pragma unroll 16
        for (int k = k0; k < k0 + 128; ++k) {
            const float wv = W[(unsigned)k * 9216];
#pragma unroll
            for (int b = 0; b < 8; ++b) acc[b] += cact[b * 1024 + k] * wv;
        }
#pragma unroll
        for (int b = 0; b < 8; ++b) red[(w * 8 + b) * 64 + lane] = acc[b];
        LDS_BARRIER();
        {
            const int b = w;
            float s = ada_b[l * 9216 + n0 + lane];
#pragma unroll
            for (int ww = 0; ww < 8; ++ww) s += red[(ww * 8 + b) * 64 + lane];
            mod[(unsigned)(l * 8 + b) * 9216 + n0 + lane] = s;
        }
        LDS_BARRIER();
    }
}

__device__ __forceinline__ void conv_w(const float* src, int ldsrc, int coloff, int nvalid, int Ntot, int K, h16* dst, int inter, unsigned char* ldsb) {
    float* tile = (float*)ldsb;
    int tid = threadIdx.x; LAUNDER_V(tid); int bid = blockIdx.x; LAUNDER_S(bid);
    const int nkt = K / 64, ntiles = (Ntot / 128) * nkt;
    float v[16];
#define CONVW_LOAD(t_) do { const int n0_ = ((t_) / nkt) * 128, k0_ = ((t_) % nkt) * 64; \
        _Pragma("unroll") for (int it = 0; it < 16; ++it) { const int e = tid + 512 * it, kk = e >> 7, nn = e & 127, n = n0_ + nn; \
            const int nc_ = (n < nvalid) ? n : (nvalid - 1); const float x_ = gld(src + (unsigned)(k0_ + kk) * ldsrc + nc_ + coloff); v[it] = (n < nvalid) ? x_ : 0.f; } } while (0)
    if (bid < ntiles) CONVW_LOAD(bid);
    for (int t = bid; t < ntiles; t += gridDim.x) {
        const int n0 = (t / nkt) * 128, k0 = (t % nkt) * 64;
#pragma unroll
        for (int it = 0; it < 16; ++it) { const int e = tid + 512 * it, kk = e >> 7, nn = e & 127; tile[kk * 129 + nn] = v[it]; }
        LDS_BARRIER();
        if (t + (int)gridDim.x < ntiles) CONVW_LOAD(t + (int)gridDim.x);
#pragma unroll
        for (int it = 0; it < 8; ++it) {
            const int e = tid + 512 * it, nn = e >> 5, kp = e & 31, n = n0 + nn;
            const int dr = (inter >= 0) ? ((n >> 7) * 256 + inter * 128 + (n & 127)) : n;
            h16x2 o; o[0] = (h16)tile[(2 * kp) * 129 + nn]; o[1] = (h16)tile[(2 * kp + 1) * 129 + nn];
            gst((h16x2*)(dst + (unsigned)dr * K + k0 + 2 * kp), o);
        }
        LDS_BARRIER();
    }
#undef CONVW_LOAD
}

__device__ __forceinline__ void phase_norm(const float* src32, const h16* src16, const float* ln, const float* modl, int shi, int sci, h16* dst) {
    int tid = threadIdx.x; LAUNDER_V(tid); int bid = blockIdx.x; LAUNDER_S(bid);
    const int lane = tid & 63, w = __builtin_amdgcn_readfirstlane(tid >> 6);
    const int stride = gridDim.x * 16, half = gridDim.x * 8;
    f32x4 vc[2][4], vn[2][4];
#define NORM_LOAD(V, r0_) do { _Pragma("unroll") for (int u = 0; u < 2; ++u) { const int row = (r0_) + u * half; if (row < M_TOK) { \
        if (src32) { _Pragma("unroll") for (int i = 0; i < 4; ++i) V[u][i] = gld((const f32x4*)(src32 + (unsigned)row * DM + 4 * lane + 256 * i)); } \
        else { const h16x8 a_ = gld((const h16x8*)(src16 + (unsigned)row * DM + 16 * lane)), b_ = gld((const h16x8*)(src16 + (unsigned)row * DM + 16 * lane + 8)); \
               _Pragma("unroll") for (int j = 0; j < 4; ++j) { V[u][0][j] = (float)a_[j]; V[u][1][j] = (float)a_[4 + j]; V[u][2][j] = (float)b_[j]; V[u][3][j] = (float)b_[4 + j]; } } } } } while (0)
    int row0 = bid * 8 + w;
    if (row0 < M_TOK) NORM_LOAD(vc, row0);
    for (; row0 < M_TOK; row0 += stride) {
        if (row0 + stride < M_TOK) NORM_LOAD(vn, row0 + stride);
#pragma unroll
        for (int u = 0; u < 2; ++u) {
            const int row = row0 + u * half;
            if (row < M_TOK) {
                float ss = 0.f;
#pragma unroll
                for (int i = 0; i < 4; ++i) ss += vc[u][i][0] * vc[u][i][0] + vc[u][i][1] * vc[u][i][1] + vc[u][i][2] * vc[u][i][2] + vc[u][i][3] * vc[u][i][3];
                ss = wave_sum(ss, lane);
                const float rstd = rsqrtf(ss * (1.0f / 1024.0f) + 1e-6f);
                const int b = row >> 12;
                const float* sh = modl + b * 9216 + shi * 1024; const float* sc = modl + b * 9216 + sci * 1024;
#pragma unroll
                for (int i = 0; i < 4; ++i) {
                    const int col = src32 ? (4 * lane + 256 * i) : (16 * lane + 4 * i);
                    const f32x4 gv = *(const f32x4*)(ln + col), sv = *(const f32x4*)(sh + col), cv = *(const f32x4*)(sc + col);
                    h16x4 o;
#pragma unroll
                    for (int j = 0; j < 4; ++j) o[j] = (h16)(vc[u][i][j] * rstd * gv[j] * (1.0f + cv[j]) + sv[j]);
                    gst((h16x4*)(dst + (unsigned)row * DM + col), o);
                }
            }
        }
#pragma unroll
        for (int u = 0; u < 2; ++u)
#pragma unroll
            for (int i = 0; i < 4; ++i) vc[u][i] = vn[u][i];
    }
#undef NORM_LOAD
}
__device__ __forceinline__ void phase_final(const h16* src, float* outp, const float* ln) {
    int tid = threadIdx.x; LAUNDER_V(tid); int bid = blockIdx.x; LAUNDER_S(bid);
    const int lane = tid & 63, w = __builtin_amdgcn_readfirstlane(tid >> 6);
    const int stride = gridDim.x * 16, half = gridDim.x * 8;
    h16x8 vc[2][2], vn[2][2];
#define FIN_LOAD(V, r0_) do { _Pragma("unroll") for (int u = 0; u < 2; ++u) { const int row = (r0_) + u * half; if (row < M_TOK) { \
        V[u][0] = gld((const h16x8*)(src + (unsigned)row * DM + 16 * lane)); V[u][1] = gld((const h16x8*)(src + (unsigned)row * DM + 16 * lane + 8)); } } } while (0)
    f32x4 gv[4];
#pragma unroll
    for (int i = 0; i < 4; ++i) gv[i] = *(const f32x4*)(ln + 16 * lane + 4 * i);
    int row0 = bid * 8 + w;
    if (row0 < M_TOK) FIN_LOAD(vc, row0);
    for (; row0 < M_TOK; row0 += stride) {
        if (row0 + stride < M_TOK) FIN_LOAD(vn, row0 + stride);
#pragma unroll
        for (int u = 0; u < 2; ++u) {
            const int row = row0 + u * half;
            if (row < M_TOK) {
                float x[16]; float ss = 0.f;
#pragma unroll
                for (int e = 0; e < 8; ++e) { x[e] = (float)vc[u][0][e]; x[8 + e] = (float)vc[u][1][e]; }
#pragma unroll
                for (int e = 0; e < 16; ++e) ss += x[e] * x[e];
                ss = wave_sum(ss, lane);
                const float rstd = rsqrtf(ss * (1.0f / 1024.0f) + 1e-6f);
#pragma unroll
                for (int i = 0; i < 4; ++i) {
                    f32x4 o;
#pragma unroll
                    for (int j = 0; j < 4; ++j) o[j] = x[4 * i + j] * rstd * gv[i][j];
                    gst((f32x4*)(outp + (unsigned)row * DM + 16 * lane + 4 * i), o);
                }
            }
        }
#pragma unroll
        for (int u = 0; u < 2; ++u) { vc[u][0] = vn[u][0]; vc[u][1] = vn[u][1]; }
    }
#undef FIN_LOAD
}

__device__ __forceinline__ void phase_attn(const h16* Pda, h16* ob, float* lse, int pat, unsigned char* ldsb) {
    int tid = threadIdx.x; LAUNDER_V(tid); int bid = blockIdx.x; LAUNDER_S(bid);
    const int lane = tid & 63, w = __builtin_amdgcn_readfirstlane(tid >> 6), fr = lane & 15, g = lane >> 4;
    const int r = (pat == 0) ? 1 : (pat == 1 ? 4 : 16);
    const int nbk2 = 16 / r;
    h16* Ks = (h16*)ldsb;
    h16* Vs = Ks + 384 * 72;
    h16* Qs = Vs + 384 * 72;
    h16x8 pk[6], pv[6], pq[4];
#define ATT_MAP(v_) ((((v_) & 7) * 192) + ((v_) >> 3))
#define ATT_LOAD(vitem_) do { const int item_ = ATT_MAP(vitem_); const int b_ = (item_) / 192, rem_ = (item_) % 192, h_ = rem_ / 16, rest_ = rem_ % 16, p_ = rest_ / nbk2, nbA_ = 2 * (rest_ % nbk2); \
        int tl_ = tid; LAUNDER_V(tl_); const h16* base_ = Pda + (unsigned)b_ * SEQ * 2304 + h_ * 64; \
        _Pragma("unroll") for (int it = 0; it < 6; ++it) { const int c = tl_ + 512 * it, j = c >> 3, part = c & 7, s = 128 * (nbA_ - 1) + j; \
            pk[it] = (h16x8){0, 0, 0, 0, 0, 0, 0, 0}; pv[it] = pk[it]; \
            if (s >= 0) { const h16* rowp = base_ + (unsigned)(p_ + r * s) * 2304 + part * 8; pk[it] = gld((const h16x8*)(rowp + 768)); pv[it] = gld((const h16x8*)(rowp + 1536)); } } \
        _Pragma("unroll") for (int it = 0; it < 4; ++it) { const int c = tl_ + 512 * it, i = c >> 3, part = c & 7, s = 128 * nbA_ + i; \
            pq[it] = gld((const h16x8*)(base_ + (unsigned)(p_ + r * s) * 2304 + part * 8)); } } while (0)
    const int G_ = (int)gridDim.x;
    if (bid < 1536) ATT_LOAD(bid);
    for (int item = bid; item < 1536; item += G_) {
        {
        {
        const int mitem = ATT_MAP(item);
        const int b = mitem / 192, rem = mitem % 192, h = rem / 16, rest = rem % 16;
        const int p = rest / nbk2, nbA = 2 * (rest % nbk2);
#pragma unroll
        for (int it = 0; it < 6; ++it) {
            const int c = tid + 512 * it, j = c >> 3, part = c & 7;
            *(h16x8*)(Ks + j * 72 + part * 8) = pk[it];
            *(h16x8*)(Vs + j * 72 + part * 8) = pv[it];
        }
#pragma unroll
        for (int it = 0; it < 4; ++it) {
            const int c = tid + 512 * it, i = c >> 3, part = c & 7;
            *(h16x8*)(Qs + i * 72 + part * 8) = pq[it] * (h16)0.18033688f;
        }
        LDS_BARRIER();
        if (item + G_ < 1536) ATT_LOAD(item + G_);
#pragma unroll
        for (int qb = 0; qb < 2; ++qb) {
        const int nb = nbA + qb;
        const h16* Kb = Ks + 128 * qb * 72; const h16* Vb = Vs + 128 * qb * 72; const h16* Qb = Qs + 128 * qb * 72;
        float lp_pre = 0.f; h16x4 prev_pre[4];
#pragma unroll
        for (int dt = 0; dt < 4; ++dt) prev_pre[dt] = (h16x4){0, 0, 0, 0};
        if (pat > 0) {
            const unsigned tok_ = (unsigned)b * SEQ + p + r * (128 * nb + 16 * w + fr);
            lp_pre = gld(lse + tok_ * 12 + h);
#pragma unroll
            for (int dt = 0; dt < 4; ++dt) prev_pre[dt] = gld((const h16x4*)(ob + tok_ * 768 + h * 64 + 4 * g + 16 * dt));
        }
        const float slope = __builtin_amdgcn_exp2f(-8.0f * (float)(h + 1) / 12.0f);
        const float sr = slope * (float)r * 1.4426950408889634f;
        h16x8 qf[2];
#pragma unroll
        for (int kk = 0; kk < 2; ++kk) qf[kk] = *(const h16x8*)(Qb + (16 * w + fr) * 72 + 32 * kk + 8 * g);
        float sc[9][4];
        float mx = -1e30f;
        const int iq = 16 * w + fr;
        float brg[4];
#pragma unroll
        for (int rg = 0; rg < 4; ++rg) brg[rg] = -sr * (float)(fr + 128 - 4 * g - rg);
#pragma unroll
        for (int tt = 0; tt < 9; ++tt) {
            const int jt = w + tt;
            const bool tile_ok = (jt <= 15) && (nb > 0 || jt >= 8);
            if (tile_ok) {
                f32x4 acc = {0.f, 0.f, 0.f, 0.f};
#pragma unroll
                for (int kk = 0; kk < 2; ++kk) { const h16x8 kf = *(const h16x8*)(Kb + (16 * jt + fr) * 72 + 32 * kk + 8 * g); acc = MFMA16(kf, qf[kk], acc); }
                const float bt = sr * (float)(16 * tt);
#pragma unroll
                for (int rg = 0; rg < 4; ++rg) {
                    float sv = acc[rg] + (brg[rg] + bt);
                    if (tt == 0) sv = (4 * g + rg >= fr) ? sv : -1e30f;
                    if (tt == 8) sv = (4 * g + rg <= fr) ? sv : -1e30f;
                    sc[tt][rg] = sv; mx = fmaxf(mx, sv);
                }
            } else {
#pragma unroll
                for (int rg = 0; rg < 4; ++rg) sc[tt][rg] = -1e30f;
            }
        }
        mx = fmaxf(mx, shx(mx, 16, lane)); mx = fmaxf(mx, shx(mx, 32, lane));
        float lsum = 0.f;
#pragma unroll
        for (int tt = 0; tt < 9; ++tt)
#pragma unroll
            for (int rg = 0; rg < 4; ++rg) { const float pv = __builtin_amdgcn_exp2f(sc[tt][rg] - mx); sc[tt][rg] = pv; lsum += pv; }
        lsum += shx(lsum, 16, lane); lsum += shx(lsum, 32, lane);
        f32x4 o[4];
#pragma unroll
        for (int dt = 0; dt < 4; ++dt) o[dt] = (f32x4){0.f, 0.f, 0.f, 0.f};
#pragma unroll
        for (int kk2 = 0; kk2 < 5; ++kk2) {
            const int ta = 2 * kk2, tb = 2 * kk2 + 1;
            h16x8 pf;
#pragma unroll
            for (int rg = 0; rg < 4; ++rg) { pf[rg] = (h16)sc[ta][rg]; pf[4 + rg] = (tb <= 8) ? (h16)sc[tb < 9 ? tb : 8][rg] : (h16)0.f; }
            const int ja = (w + ta) < 15 ? (w + ta) : 15, jb = (w + tb) < 15 ? (w + tb) : 15;
#pragma unroll
            for (int dt = 0; dt < 4; ++dt) {
                const h16x4 va = tr_read4(Vb + (16 * ja + 4 * g + (fr >> 2)) * 72 + 16 * dt + 4 * (fr & 3));
                const h16x4 vb = tr_read4(Vb + (16 * jb + 4 * g + (fr >> 2)) * 72 + 16 * dt + 4 * (fr & 3));
                o[dt] = MFMA16(cat8(va, vb), pf, o[dt]);
            }
        }
        {
            const int t = p + r * (128 * nb + iq);
            const unsigned tok = (unsigned)b * SEQ + t;
            const float inv = 1.0f / lsum, lse_p = (mx + __builtin_amdgcn_logf(lsum)) * 0.6931471805599453f;
            float w1 = 0.f, w2 = inv, lse_new = lse_p;
            if (pat > 0) {
                const float lp = lp_pre, m2 = fmaxf(lp, lse_p), e1 = fexp(lp - m2), e2 = fexp(lse_p - m2), den = e1 + e2;
                w1 = e1 / den; w2 = e2 * inv / den; lse_new = m2 + flog(den);
            }
            h16* op = ob + tok * 768 + h * 64 + 4 * g;
#pragma unroll
            for (int dt = 0; dt < 4; ++dt) {
                h16x4 prev = {0, 0, 0, 0};
                if (pat > 0) prev = prev_pre[dt];
                h16x4 res;
#pragma unroll
                for (int rg = 0; rg < 4; ++rg) res[rg] = (h16)(w1 * (float)prev[rg] + w2 * o[dt][rg]);
                gst((h16x4*)(op + 16 * dt), res);
            }
            if (pat < 2 && g == 0) gst(lse + tok * 12 + h, lse_new);
        }
        }
        LDS_BARRIER();
        }
    }
    }
#undef ATT_LOAD
#undef ATT_MAP
}

__device__ __forceinline__ void phase_halo(const h16* Pdn, h16* halo) {
    const int total = 8 * 64 * 3 * 384;
    int tid = threadIdx.x; LAUNDER_V(tid); int bid = blockIdx.x; LAUNDER_S(bid);
    for (int c = bid * 512 + tid; c < total; c += gridDim.x * 512) {
        const int part = c % 384, e = (c / 384) % 3, bn = c / (384 * 3), n = bn & 63, b = bn >> 6;
        if (n == 0) continue;
        *(h16x8*)(halo + ((unsigned)bn * 3 + e) * 3072 + part * 8) = *(const h16x8*)(Pdn + ((unsigned)b * SEQ + 64 * n - 3 + e) * 4096 + part * 8);
    }
}

__device__ __forceinline__ void phase_dnprep(h16* Pdn, const h16* halo, const float* bd, const float* convw, const float* a_log, const float* dt_bias,
                             h16* Tg, h16* qkg, float* gcg, float* betag, float* s2g, LAS unsigned char* ldsl, unsigned char* ldsb) {
    int bid = blockIdx.x; LAUNDER_S(bid);
    const int w = __builtin_amdgcn_readfirstlane((int)threadIdx.x >> 6);
    constexpr int RP = 384;
    constexpr int RAWB = 67 * RP * 2;
    h16* qn = (h16*)(ldsb + 2 * RAWB);
    h16* kn = qn + 64 * 136;
    float* Mm = (float*)(kn + 64 * 136);
    float* cw = Mm + 64 * 68;
    float* gcs = cw + 4 * 384;
    float* bts = gcs + 64;
    float cv[4] = {0.f, 0.f, 0.f, 0.f}, pbr = 0.f, par_ = 0.f;
#define PREP_FETCH(item_, buf_) do { const int b_ = (item_) >> 9, h_ = ((item_) >> 6) & 7, n_ = (item_) & 63; int t_ = threadIdx.x; LAUNDER_V(t_); const int ln_ = t_ & 63; const unsigned tok0_ = (unsigned)b_ * SEQ + 64 * n_; \
        _Pragma("unroll") for (int it = 0; it < 7; ++it) { const int blk = w + 8 * it; if (blk < 51) { const int L = blk * 1024 + ln_ * 16, row = L / 768, q = (L - row * 768) >> 4; \
            const int coff_ = (q >> 4) * 1024 + h_ * 128 + (q & 15) * 8; \
            const h16* src = (row >= 3) ? Pdn + (tok0_ + row - 3) * 4096 + coff_ : halo + ((unsigned)(b_ * 64 + n_) * 3 + row) * 3072 + coff_; \
            if (L < RAWB && (row >= 3 || n_ > 0)) __builtin_amdgcn_global_load_lds((const unsigned*)src, (LAS unsigned*)(ldsl + (buf_) * RAWB + blk * 1024), 16, 0, 0); } } \
        _Pragma("unroll") for (int j = 0; j < 4; ++j) { if (t_ < 384) cv[j] = gld(convw + j * 3072 + (t_ >> 7) * 1024 + h_ * 128 + (t_ & 127)); } \
        if (w == 0) { pbr = gld(bd + (tok0_ + ln_) * 16 + h_); par_ = gld(bd + (tok0_ + ln_) * 16 + 8 + h_); } } while (0)
    if (bid < 4096) PREP_FETCH(bid, 0);
    int cur = 0;
    for (int item = bid; item < 4096; item += gridDim.x, cur ^= 1) {
        const int b = item >> 9, h = (item >> 6) & 7, n = item & 63;
        int tl = threadIdx.x; LAUNDER_V(tl);
        const int lane = tl & 63, fr = lane & 15, g = lane >> 4;
        const unsigned tok0 = (unsigned)b * SEQ + 64 * n;
        const unsigned bh0 = (unsigned)(b * 8 + h) * SEQ + 64 * n;
        h16* raw = (h16*)(ldsb + cur * RAWB);
        float* X = (float*)raw;
        float* Zs = X + 64 * 68;
        asm volatile("s_waitcnt vmcnt(0)" ::: "memory");
        if (n == 0 && tl < 144) { int z0 = 0; LAUNDER_V(z0); const float zf = __int_as_float(z0); *(f32x4*)(raw + tl * 8) = (f32x4){zf, zf, zf, zf}; }
#pragma unroll
        for (int j = 0; j < 4; ++j) if (tl < 384) cw[j * 384 + tl] = cv[j];
        if (w == 0) {
            const float br = pbr, ar = par_;
            const float beta = 1.0f / (1.0f + fexp(-br));
            const float xs = ar + dt_bias[h];
            const float sp = (xs > 20.f) ? xs : flog(1.0f + fexp(xs));
            float gg = -fexp(a_log[h]) * sp;
#pragma unroll
            for (int o = 1; o < 64; o <<= 1) { const float t = __int_as_float(__builtin_amdgcn_ds_bpermute(((lane >= o) ? (lane - o) : lane) << 2, __float_as_int(gg))); if (lane >= o) gg += t; }
            gcs[lane] = gg; bts[lane] = beta;
            {
                const float eg = fexp(gg), glast = __int_as_float(__builtin_amdgcn_readlane(__float_as_int(gg), 63));
                gst(gcg + bh0 + lane, eg); gst(betag + bh0 + lane, beta * eg); gst(s2g + bh0 + lane, fexp(glast - gg));
            }
        }
        LDS_BARRIER();
        if (item + (int)gridDim.x < 4096) PREP_FETCH(item + (int)gridDim.x, cur ^ 1);
        {
            const int rr = lane >> 3, cp = lane & 7, i = 8 * w + rr;
            h16* gp = Pdn + (tok0 + i) * 4096 + h * 128 + 16 * cp;
            const float bt_i = bts[i];
#pragma unroll
            for (int seg = 0; seg < 3; ++seg) {
                float y[16];
#pragma unroll
                for (int e = 0; e < 16; ++e) y[e] = 0.f;
#pragma unroll
                for (int j = 0; j < 4; ++j) {
                    const h16x8 x0 = *(const h16x8*)(raw + (i + j) * RP + seg * 128 + 16 * cp), x1 = *(const h16x8*)(raw + (i + j) * RP + seg * 128 + 16 * cp + 8);
                    const f32x4* cwp = (const f32x4*)(cw + j * 384 + seg * 128 + 16 * cp);
                    const f32x4 c0 = cwp[0], c1 = cwp[1], c2 = cwp[2], c3 = cwp[3];
#pragma unroll
                    for (int e = 0; e < 4; ++e) {
                        y[e] += c0[e] * (float)x0[e]; y[4 + e] += c1[e] * (float)x0[4 + e];
                        y[8 + e] += c2[e] * (float)x1[e]; y[12 + e] += c3[e] * (float)x1[4 + e];
                    }
                }
#pragma unroll
                for (int e = 0; e < 16; ++e) y[e] = silu_f(y[e]);
                float scl = bt_i;
                if (seg < 2) {
                    float ss = 0.f;
#pragma unroll
                    for (int e = 0; e < 16; ++e) ss += y[e] * y[e];
                    ss += shx(ss, 1, lane); ss += shx(ss, 2, lane); ss += shx(ss, 4, lane);
                    scl = rsqrtf(ss + 1e-6f) * (seg == 0 ? 0.08838834764831845f : 1.0f);
                }
                h16x8 o0, o1;
#pragma unroll
                for (int e = 0; e < 8; ++e) { o0[e] = (h16)(y[e] * scl); o1[e] = (h16)(y[8 + e] * scl); }
                if (seg == 0) { *(h16x8*)(qn + i * 136 + 16 * cp) = o0; *(h16x8*)(qn + i * 136 + 16 * cp + 8) = o1; }
                if (seg == 1) { *(h16x8*)(kn + i * 136 + 16 * cp) = o0; *(h16x8*)(kn + i * 136 + 16 * cp + 8) = o1; }
                gst((h16x8*)(gp + seg * 1024), o0); gst((h16x8*)(gp + seg * 1024 + 8), o1);
            }
        }
        LDS_BARRIER();
#pragma unroll
        for (int idx0 = 0; idx0 < 4; ++idx0) {
            const int idx = w + 8 * idx0;
            const int isqk = idx >> 4, ti = (idx >> 2) & 3, tj = idx & 3;
            f32x4 acc = {0.f, 0.f, 0.f, 0.f};
            if (tj <= ti) {
                const h16* As = isqk ? qn : kn;
#pragma unroll
                for (int kk = 0; kk < 4; ++kk) {
                    const h16x8 a = *(const h16x8*)(As + (16 * ti + fr) * 136 + 32 * kk + 8 * g);
                    const h16x8 bb = *(const h16x8*)(kn + (16 * tj + fr) * 136 + 32 * kk + 8 * g);
                    acc = MFMA16(a, bb, acc);
                }
            }
#pragma unroll
            for (int rg = 0; rg < 4; ++rg) {
                const int i = 16 * ti + 4 * g + rg, j = 16 * tj + fr;
                const float dec = fexp(fminf(gcs[i] - gcs[j], 0.f));
                if (!isqk) Mm[i * 68 + j] = (j < i) ? acc[rg] * bts[i] * dec : 0.f;
                else gst(qkg + (bh0 + i) * 64 + j, (h16)((j <= i) ? acc[rg] * dec : 0.f));
            }
        }
        for (int e = tl; e < 4096; e += 512) { const int r = e >> 6, c = e & 63; if ((c >> 4) > (r >> 4)) X[r * 68 + c] = 0.f; }
        LDS_BARRIER();
        if (w < 4 && lane < 16) {
            const int q = w, c = lane;
            float x[16];
#pragma unroll
            for (int i = 0; i < 16; ++i) {
                float mrow[16];
#pragma unroll
                for (int q4 = 0; q4 < 4; ++q4) { const f32x4 t4 = *(const f32x4*)(Mm + (16 * q + i) * 68 + 16 * q + 4 * q4); mrow[4 * q4] = t4[0]; mrow[4 * q4 + 1] = t4[1]; mrow[4 * q4 + 2] = t4[2]; mrow[4 * q4 + 3] = t4[3]; }
                float sacc = (i == c) ? 1.f : 0.f;
#pragma unroll
                for (int j = 0; j < 16; ++j) if (j < i) sacc -= mrow[j] * x[j];
                x[i] = sacc;
            }
#pragma unroll
            for (int i = 0; i < 16; ++i) X[(16 * q + i) * 68 + 16 * q + c] = x[i];
        }
        LDS_BARRIER();
        {
            const int which = tl >> 8, r = (tl >> 4) & 15, c = tl & 15, rb = which ? 48 : 16, cb = which ? 32 : 0;
            float sacc = 0.f;
#pragma unroll
            for (int k = 0; k < 16; ++k) sacc += Mm[(rb + r) * 68 + cb + k] * X[(cb + k) * 68 + cb + c];
            Zs[(which * 16 + r) * 17 + c] = sacc;
        }
        LDS_BARRIER();
        {
            const int which = tl >> 8, r = (tl >> 4) & 15, c = tl & 15, rb = which ? 48 : 16, cb = which ? 32 : 0;
            float sacc = 0.f;
#pragma unroll
            for (int m = 0; m < 16; ++m) sacc += X[(rb + r) * 68 + rb + m] * Zs[(which * 16 + m) * 17 + c];
            X[(rb + r) * 68 + cb + c] = -sacc;
        }
        LDS_BARRIER();
        {
            float zv[2];
#pragma unroll
            for (int it = 0; it < 2; ++it) {
                const int e = tl + 512 * it, r = e >> 5, c = e & 31;
                float sacc = 0.f;
#pragma unroll
                for (int k = 0; k < 32; ++k) sacc += Mm[(32 + r) * 68 + k] * X[k * 68 + c];
                zv[it] = sacc;
            }
#pragma unroll
            for (int it = 0; it < 2; ++it) { const int e = tl + 512 * it, r = e >> 5, c = e & 31; Zs[r * 33 + c] = zv[it]; }
        }
        LDS_BARRIER();
#pragma unroll
        for (int it = 0; it < 2; ++it) {
            const int e = tl + 512 * it, r = e >> 5, c = e & 31;
            float sacc = 0.f;
#pragma unroll
            for (int m = 0; m < 32; ++m) sacc += X[(32 + r) * 68 + 32 + m] * Zs[m * 33 + c];
            X[(32 + r) * 68 + c] = -sacc;
        }
        LDS_BARRIER();
        {
            const int i = tl >> 3, part = tl & 7;
            h16x8 o;
#pragma unroll
            for (int e = 0; e < 8; ++e) o[e] = (h16)X[i * 68 + 8 * part + e];
            gst((h16x8*)(Tg + (bh0 + i) * 64 + 8 * part), o);
        }
        LDS_BARRIER();
    }
#undef PREP_FETCH
}

__device__ __forceinline__ void phase_scan(h16* Pdn, const h16* Tg, const h16* qkg, const float* gcg, const float* betag, const float* s2g, unsigned char* ldsb) {
    int tid = threadIdx.x; LAUNDER_V(tid); int bid = blockIdx.x; LAUNDER_S(bid);
    const int lane = tid & 63, w = __builtin_amdgcn_readfirstlane(tid >> 6), fr = lane & 15, g = lane >> 4;
    constexpr int OQ = 0, OK_ = 64 * 136, OT = 2 * 64 * 136, OQK = OT + 64 * 72, OV = OQK + 64 * 72, OSC = OV + 64 * 64, BUFH = OSC + 384;
    if (bid < 128) {
        const int item = bid;
        const int bh = (item & 7) * 8 + (item >> 4), s = (item >> 3) & 1, b = bh >> 3, h = bh & 7;
        f32x4 S[8];
#pragma unroll
        for (int tk = 0; tk < 8; ++tk) S[tk] = (f32x4){0.f, 0.f, 0.f, 0.f};
#define SCAN_LD(n_, R_) do { const unsigned tok0_ = (unsigned)b * SEQ + 64 * (n_), bh0_ = (unsigned)bh * SEQ + 64 * (n_); int lt = tid - 256; LAUNDER_V(lt); \
            _Pragma("unroll") for (int it = 0; it < 4; ++it) { const int c = lt + 256 * it, i = c >> 4, part = c & 15; const h16* rp = Pdn + (tok0_ + i) * 4096 + h * 128 + part * 8; \
                R_[it] = gld((const h16x8*)rp); R_[4 + it] = gld((const h16x8*)(rp + 1024)); } \
            _Pragma("unroll") for (int it = 0; it < 2; ++it) { const int c = lt + 256 * it, i = c >> 3, part = c & 7; \
                R_[8 + it] = gld((const h16x8*)(Tg + (bh0_ + i) * 64 + part * 8)); R_[10 + it] = gld((const h16x8*)(qkg + (bh0_ + i) * 64 + part * 8)); \
                R_[12 + it] = gld((const h16x8*)(Pdn + (tok0_ + i) * 4096 + 2048 + h * 128 + 64 * s + part * 8)); } \
            if (lt < 48) R_[14] = gld((const h16x8*)(((lt < 16) ? gcg : ((lt < 32) ? betag : s2g)) + bh0_ + 4 * (lt & 15))); } while (0)
#define SCAN_ST(buf_, R_) do { h16* B_ = (h16*)ldsb + (buf_) * BUFH; int lt = tid - 256; LAUNDER_V(lt); \
            _Pragma("unroll") for (int it = 0; it < 4; ++it) { const int c = lt + 256 * it, i = c >> 4, part = c & 15; \
                *(h16x8*)(B_ + OQ + i * 136 + part * 8) = R_[it]; *(h16x8*)(B_ + OK_ + i * 136 + part * 8) = R_[4 + it]; } \
            _Pragma("unroll") for (int it = 0; it < 2; ++it) { const int c = lt + 256 * it, i = c >> 3, part = c & 7; \
                *(h16x8*)(B_ + OT + i * 72 + part * 8) = R_[8 + it]; *(h16x8*)(B_ + OQK + i * 72 + part * 8) = R_[10 + it]; *(h16x8*)(B_ + OV + i * 64 + part * 8) = R_[12 + it]; } \
            if (lt < 48) *(h16x8*)(B_ + OSC + 8 * lt) = R_[14]; } while (0)
        if (w >= 4) {
            h16x8 R0[15], R1[15], R2[15];
            SCAN_LD(0, R0); SCAN_ST(0, R0);
            SCAN_LD(1, R1); SCAN_LD(2, R2); SCAN_LD(3, R0);
            LDS_BARRIER();
#pragma unroll 1
            for (int n = 0; n < 63; n += 3) {
                SCAN_ST((n + 1) & 1, R1); if (n + 4 < 64) SCAN_LD(n + 4, R1);
                LDS_BARRIER();
                SCAN_ST((n + 2) & 1, R2); if (n + 5 < 64) SCAN_LD(n + 5, R2);
                LDS_BARRIER();
                SCAN_ST((n + 3) & 1, R0); if (n + 6 < 64) SCAN_LD(n + 6, R0);
                LDS_BARRIER();
            }
            LDS_BARRIER();
        } else {
        int tc = tid; LAUNDER_V(tc);
        const int lane = tc & 63, fr = lane & 15, g = lane >> 4; (void)lane;
        LDS_BARRIER();
#pragma unroll 1
        for (int n = 0; n < 64; ++n) {
            const unsigned tok0 = (unsigned)b * SEQ + 64 * n;
            const h16* B = (const h16*)ldsb + (n & 1) * BUFH;
            const h16* qn = B + OQ; const h16* kn = B + OK_; const h16* Tm = B + OT; const h16* qkm = B + OQK; const h16* vbs = B + OV;
            const float* gcs = (const float*)(B + OSC); const float* bts = gcs + 64; const float* s2s = gcs + 128;
            {
                GAS h16* ob = (GAS h16*)(Pdn + (tok0 * 4096 + 2048 + h * 128 + 64 * s));
                const float e_last = gcs[63];
                h16x8 Sf[4];
#pragma unroll
                for (int kk = 0; kk < 4; ++kk)
#pragma unroll
                    for (int rg = 0; rg < 4; ++rg) { Sf[kk][rg] = (h16)S[2 * kk][rg]; Sf[kk][4 + rg] = (h16)S[2 * kk + 1][rg]; }
#define LD_A(F, ti_) do { _Pragma("unroll") for (int kk = 0; kk < 4; ++kk) { const h16* kp = kn + (16 * (ti_) + fr) * 136 + 32 * kk + 4 * g; const h16* qp = qn + (16 * (ti_) + fr) * 136 + 32 * kk + 4 * g; \
                    F[2 * kk] = cat8(*(const h16x4*)kp, *(const h16x4*)(kp + 16)); F[2 * kk + 1] = cat8(*(const h16x4*)qp, *(const h16x4*)(qp + 16)); } } while (0)
#define LD_T(F, base_) do { _Pragma("unroll") for (int ti = 0; ti < 4; ++ti) _Pragma("unroll") for (int k2 = 0; k2 < 2; ++k2) { const h16* tp = (base_) + (16 * ti + fr) * 72 + 32 * k2 + 4 * g; \
                    F[2 * ti + k2] = cat8(*(const h16x4*)tp, *(const h16x4*)(tp + 16)); } } while (0)
#define LD_K(F, tk0_) do { _Pragma("unroll") for (int t = 0; t < 4; ++t) _Pragma("unroll") for (int k2 = 0; k2 < 2; ++k2) { const h16* kp = kn + (32 * k2 + 4 * g + (fr >> 2)) * 136 + 16 * ((tk0_) + t) + 4 * (fr & 3); \
                    F[2 * t + k2] = cat8(tr_read4(kp), tr_read4(kp + 16 * 136)); } } while (0)
#define CP_F(D, S_) do { _Pragma("unroll") for (int q = 0; q < 8; ++q) D[q] = S_[q]; } while (0)
#define LD_S(G_, B_, V_, ti_) do { G_ = *(const f32x4*)(gcs + 16 * (ti_) + 4 * g); B_ = *(const f32x4*)(bts + 16 * (ti_) + 4 * g); V_ = tr_read4(vbs + (16 * (ti_) + 4 * g + (fr >> 2)) * 64 + 16 * w + 4 * (fr & 3)); } while (0)
                h16x8 F0[8], F1[8];
                f32x4 gc0, bt0, gc1 = {0.f, 0.f, 0.f, 0.f}, bt1 = {0.f, 0.f, 0.f, 0.f}; h16x4 vb0, vb1 = {0, 0, 0, 0};
                LD_A(F0, 0); LD_S(gc0, bt0, vb0, 0);
                f32x4 R[4], O[4];
#pragma unroll
                for (int ti = 0; ti < 4; ++ti) {
                    if (ti < 3) { LD_A(F1, ti + 1); LD_S(gc1, bt1, vb1, ti + 1); } else LD_T(F1, Tm);
                    __builtin_amdgcn_sched_barrier(0);
                    f32x4 ka = {0.f, 0.f, 0.f, 0.f}, qa = {0.f, 0.f, 0.f, 0.f};
#pragma unroll
                    for (int kk = 0; kk < 4; ++kk) { ka = MFMA16(F0[2 * kk], Sf[kk], ka); qa = MFMA16(F0[2 * kk + 1], Sf[kk], qa); }
#pragma unroll
                    for (int rg = 0; rg < 4; ++rg) { R[ti][rg] = (float)vb0[rg] - bt0[rg] * ka[rg]; O[ti][rg] = gc0[rg] * qa[rg]; }
                    CP_F(F0, F1); gc0 = gc1; bt0 = bt1; vb0 = vb1;
                }
                h16x8 Rf[2];
#pragma unroll
                for (int k2 = 0; k2 < 2; ++k2)
#pragma unroll
                    for (int rg = 0; rg < 4; ++rg) { Rf[k2][rg] = (h16)R[2 * k2][rg]; Rf[k2][4 + rg] = (h16)R[2 * k2 + 1][rg]; }
                LD_T(F1, qkm);
                __builtin_amdgcn_sched_barrier(0);
                f32x4 Vn[4];
#pragma unroll
                for (int ti = 0; ti < 4; ++ti) {
                    f32x4 acc = {0.f, 0.f, 0.f, 0.f};
#pragma unroll
                    for (int k2 = 0; k2 < 2; ++k2) acc = MFMA16(F0[2 * ti + k2], Rf[k2], acc);
                    Vn[ti] = acc;
                }
                CP_F(F0, F1);
                h16x8 Vf[2], V2f[2];
#pragma unroll
                for (int k2 = 0; k2 < 2; ++k2) {
                    const f32x4 gca = *(const f32x4*)(s2s + 32 * k2 + 4 * g), gcb = *(const f32x4*)(s2s + 32 * k2 + 16 + 4 * g);
#pragma unroll
                    for (int rg = 0; rg < 4; ++rg) {
                        Vf[k2][rg] = (h16)Vn[2 * k2][rg]; Vf[k2][4 + rg] = (h16)Vn[2 * k2 + 1][rg];
                        V2f[k2][rg] = (h16)(Vn[2 * k2][rg] * gca[rg]); V2f[k2][4 + rg] = (h16)(Vn[2 * k2 + 1][rg] * gcb[rg]);
                    }
                }
                LD_K(F1, 0);
                __builtin_amdgcn_sched_barrier(0);
#pragma unroll
                for (int ti = 0; ti < 4; ++ti) {
#pragma unroll
                    for (int k2 = 0; k2 < 2; ++k2) O[ti] = MFMA16(F0[2 * ti + k2], Vf[k2], O[ti]);
#pragma unroll
                    for (int rg = 0; rg < 4; ++rg) {
                        const int i = 16 * ti + 4 * g + rg;
                        ob[i * 4096 + 16 * w + fr] = (h16)O[ti][rg];
                    }
                }
                CP_F(F0, F1);
                LD_K(F1, 4);
                __builtin_amdgcn_sched_barrier(0);
#pragma unroll
                for (int t = 0; t < 4; ++t) {
                    f32x4 acc = S[t] * e_last;
#pragma unroll
                    for (int k2 = 0; k2 < 2; ++k2) acc = MFMA16(F0[2 * t + k2], V2f[k2], acc);
                    S[t] = acc;
                }
                __builtin_amdgcn_sched_barrier(0);
#pragma unroll
                for (int t = 0; t < 4; ++t) {
                    f32x4 acc = S[4 + t] * e_last;
#pragma unroll
                    for (int k2 = 0; k2 < 2; ++k2) acc = MFMA16(F1[2 * t + k2], V2f[k2], acc);
                    S[4 + t] = acc;
                }
#undef LD_A
#undef LD_S
#undef LD_T
#undef LD_K
#undef CP_F
            }
            LDS_BARRIER();
        }
        }
#undef SCAN_LD
#undef SCAN_ST
    }
}

__device__ __forceinline__ void phase_gnorm(h16* Pdn, const float* dn_norm) {
    int tid = threadIdx.x; LAUNDER_V(tid); int bid = blockIdx.x; LAUNDER_S(bid);
    const int lane = tid & 63, w = __builtin_amdgcn_readfirstlane(tid >> 6);
    const int hh = lane >> 3, cp = lane & 7;
    const int stride = gridDim.x * 16, half = gridDim.x * 8;
    float gn[16];
#pragma unroll
    for (int q4 = 0; q4 < 4; ++q4) { const f32x4 t4 = *(const f32x4*)(dn_norm + 16 * cp + 4 * q4); gn[4 * q4] = t4[0]; gn[4 * q4 + 1] = t4[1]; gn[4 * q4 + 2] = t4[2]; gn[4 * q4 + 3] = t4[3]; }
    h16x8 oc[2][2], zc[2][2], on[2][2], zn[2][2];
#define GN_LOAD(O_, Z_, r0_) do { _Pragma("unroll") for (int u = 0; u < 2; ++u) { const int row = (r0_) + u * half; if (row < M_TOK) { const h16* rp = Pdn + (unsigned)row * 4096 + 2048 + hh * 128 + 16 * cp; \
        O_[u][0] = gld((const h16x8*)rp); O_[u][1] = gld((const h16x8*)(rp + 8)); Z_[u][0] = gld((const h16x8*)(rp + 1024)); Z_[u][1] = gld((const h16x8*)(rp + 1032)); } } } while (0)
    int row0 = bid * 8 + w;
    if (row0 < M_TOK) GN_LOAD(oc, zc, row0);
    for (; row0 < M_TOK; row0 += stride) {
        if (row0 + stride < M_TOK) GN_LOAD(on, zn, row0 + stride);
#pragma unroll
        for (int u = 0; u < 2; ++u) {
            const int row = row0 + u * half;
            if (row < M_TOK) {
                float ss = 0.f;
#pragma unroll
                for (int e = 0; e < 8; ++e) { const float a0 = (float)oc[u][0][e], a1 = (float)oc[u][1][e]; ss += a0 * a0 + a1 * a1; }
                ss += shx(ss, 1, lane); ss += shx(ss, 2, lane); ss += shx(ss, 4, lane);
                const float rstd = rsqrtf(ss * (1.0f / 128.0f) + 1e-6f);
                h16x8 r0, r1;
#pragma unroll
                for (int e = 0; e < 8; ++e) {
                    r0[e] = (h16)((float)oc[u][0][e] * rstd * gn[e] * silu_f((float)zc[u][0][e]));
                    r1[e] = (h16)((float)oc[u][1][e] * rstd * gn[8 + e] * silu_f((float)zc[u][1][e]));
                }
                h16* wp = Pdn + (unsigned)row * 4096 + 2048 + hh * 128 + 16 * cp;
                gst((h16x8*)wp, r0); gst((h16x8*)(wp + 8), r1);
            }
        }
#pragma unroll
        for (int u = 0; u < 2; ++u) { oc[u][0] = on[u][0]; oc[u][1] = on[u][1]; zc[u][0] = zn[u][0]; zc[u][1] = zn[u][1]; }
    }
#undef GN_LOAD
}

#define XB_TMO      128
#define XB_XCNT(j)  (256  + 64 * (j))
#define XB_XSUB(j)  (1280 + 64 * (j))
#define XB_XGEN(j)  (2304 + 64 * (j))
#define XB_TOP      3328
#define XB_TOPGEN   3392
#define XCD_BAR_WORDS 3456
#define XB_SPIN_CAP (1u << 18)
__device__ __forceinline__ unsigned xb_ld(unsigned* p)              { return __hip_atomic_load(p, __ATOMIC_RELAXED, __HIP_MEMORY_SCOPE_AGENT); }
__device__ __forceinline__ unsigned xb_add(unsigned* p, unsigned v) { return __hip_atomic_fetch_add(p, v, __ATOMIC_RELAXED, __HIP_MEMORY_SCOPE_AGENT); }
__device__ __forceinline__ unsigned xb_xcc_id() { return (unsigned)__builtin_amdgcn_s_getreg((3 << 11) | 20) & 0xFu; }
#define XB_SPIN(cond, bar) do { unsigned _sp = 0; while (cond) { __builtin_amdgcn_s_sleep(1); \
    if ((++_sp & 255u) == 0u) { if (xb_ld(&(bar)[XB_TMO])) break; if (_sp > XB_SPIN_CAP) { atomicAdd(&(bar)[XB_TMO], 1u); break; } } } } while (0)
__device__ __forceinline__ void xcd_barrier_complete(unsigned* bar, unsigned x, unsigned& nloc, unsigned& nx) {
    const unsigned G = gridDim.x * gridDim.y * gridDim.z;
    unsigned sum, cnt, mine, sp = 0u;
    for (;;) {
        sum = 0u; cnt = 0u; mine = 0u;
#pragma unroll
        for (unsigned j = 0; j < 16; ++j) { const unsigned c = xb_ld(&bar[XB_XCNT(j)]); sum += c; cnt += (c > 0u) ? 1u : 0u; mine = (j == x) ? c : mine; }
        if (sum == G) break;
        __builtin_amdgcn_s_sleep(1);
        if ((++sp & 255u) == 0u) { if (xb_ld(&bar[XB_TMO])) break; if (sp > XB_SPIN_CAP) { atomicAdd(&bar[XB_TMO], 1u); break; } }
    }
    nloc = mine > 0u ? mine : 1u; nx = cnt > 0u ? cnt : 1u;
}
__device__ __forceinline__ void xcd_barrier(unsigned* bar, unsigned x, volatile LAS unsigned* st) {
    asm volatile("s_waitcnt vmcnt(0)" ::: "memory");
    __syncthreads();
    if (threadIdx.x == 0) {
        __builtin_amdgcn_s_waitcnt(0);
        unsigned nloc = st[0], nx = st[1];
        if (nloc == 0u) { xcd_barrier_complete(bar, x, nloc, nx); st[0] = nloc; st[1] = nx; }
        const unsigned old = xb_add(&bar[XB_XSUB(x)], 1u);
        const unsigned gen = old / nloc;
        if (old + 1u == (gen + 1u) * nloc) {
            __builtin_amdgcn_fence(__ATOMIC_RELEASE, "agent");
            asm volatile("s_waitcnt vmcnt(0)" ::: "memory");
            const unsigned og = xb_add(&bar[XB_TOP], 1u);
            const unsigned tg = og / nx;
            if (og + 1u == (tg + 1u) * nx) xb_add(&bar[XB_TOPGEN], 1u);
            else XB_SPIN(xb_ld(&bar[XB_TOPGEN]) == tg, bar);
            __builtin_amdgcn_fence(__ATOMIC_ACQUIRE, "agent");
            xb_add(&bar[XB_XGEN(x)], 1u);
            asm volatile("s_waitcnt vmcnt(0)" ::: "memory");
        } else {
            XB_SPIN(xb_ld(&bar[XB_XGEN(x)]) == gen, bar);
            __builtin_amdgcn_fence(__ATOMIC_ACQUIRE, "agent");
            asm volatile("s_waitcnt vmcnt(0)" ::: "memory");
        }
    }
    __syncthreads();
}

#ifndef PROBE_GEMM2
constexpr int NPROG = 15;
__constant__ unsigned char PROG[NPROG] = {0, 1, 2, 4, 5, 6, 7, 8, 10, 11, 13, 14, 15, 17, 18};
#else
constexpr int NPROG = 24;
__constant__ unsigned char PROG[NPROG] = {0, 1, 1, 2, 3, 4, 4, 5, 6, 7, 8, 8, 9, 10, 11, 12, 13, 13, 14, 15, 16, 17, 17, 18};
#endif
__global__ void __launch_bounds__(512, 2) fwd_mega(Params p) {
    extern __shared__ __attribute__((aligned(16))) unsigned char lds[];
    cg::grid_group grid = cg::this_grid();
    LAS unsigned char* ldsl = (LAS unsigned char*)lds;
    volatile LAS unsigned* bst = (volatile LAS unsigned*)(ldsl + 161792);
    if (threadIdx.x == 0) { bst[0] = 0u; bst[1] = 0u; (void)xb_add((unsigned*)(p.ws + R4_BAR) + XB_XCNT(xb_xcc_id()), 1u); }
    __syncthreads();
    { unsigned char* ws0 = p.ws; LAUNDER_S(ws0); phase_mod(p.in[1], p.in[2], p.in[3], (float*)(ws0 + R4_MOD), lds); }
    if (p.ws == nullptr) grid.sync();
    xcd_barrier((unsigned*)(p.ws + R4_BAR), xb_xcc_id(), bst);
#pragma unroll 1
    for (int pc = 0; pc < NPROG * 2; ++pc) {
        const int l = (pc >= NPROG) ? 1 : 0;
        const int sl = PROG[pc - NPROG * l];
        const int step = 19 * l + sl;
        if (l == 1 && sl == 0) continue;
        unsigned char* ws = p.ws; LAUNDER_S(ws);
            const int G = gridDim.x; int bid = blockIdx.x; LAUNDER_S(bid);
        const float* x = p.in[0];
        h16* hbuf = (h16*)p.out;
        h16* XN = (h16*)(ws + R1);
        h16* HID = (h16*)(ws + R0);
        h16* Pda = (h16*)(ws + R0);
        h16* Pdn = (h16*)(ws + R0);
        h16* OB = (h16*)(ws + R2);
        h16* GATE_A = (h16*)(ws + R3 + 64 * MiB); h16* GATE_B = (h16*)(ws + R3);
        h16* Tg = (h16*)(ws + R3_T); h16* QKg = (h16*)(ws + R3_QK); h16* HALO = (h16*)(ws + R3_HALO);
        h16* Wdn = (h16*)(ws + R3_WDN); h16* Wda = (h16*)(ws + R3_WDA);
        const size_t ffoff = (l == 1 && (sl == 1 || sl == 2)) ? 32 * MiB : 0;
        h16* W1t = (h16*)(ws + R3_W1 + ffoff); h16* W2t = (h16*)(ws + R3_W2 + ffoff);
        h16* Wg = (h16*)(ws + R4_WG); h16* Wa = (h16*)(ws + R4_WA); h16* Wb = (h16*)(ws + R4_WB); h16* Wo = (h16*)(ws + R4_WO);
        float* MOD = (float*)(ws + R4_MOD); float* BD = (float*)(ws + R4_BD); float* LSE = (float*)(ws + R4_LSE);
        float* GC = (float*)(ws + R4_GC); float* BETA = (float*)(ws + R4_BETA);


        const float* modl = MOD + (unsigned)l * 8 * 9216;
        const bool first = (step == 0) || (step == 2);
        const float* hin32 = first ? x : (const float*)nullptr;
        if (sl == 0) {
            if (step == 0) phase_norm(hin32, hbuf, p.in[4], modl, 0, 1, XN);
        } else if (sl == 1 || sl == 17) {
            pg8::Gemm gm{XN, W1t, M_TOK, 2 * FF, 1024, 1024}; pg8::StaticOrder S; S.init(M_TOK, 2 * FF, G, bid);
            pg8::EpiSwiglu E{HID}; pg8::gemm_phase(ldsl, gm, S, E);
        } else if (sl == 2 || sl == 18 || sl == 15) {
            const bool wo = (sl == 15);
            pg8::Gemm gm{wo ? XN : HID, wo ? Wo : W2t, M_TOK, 1024, wo ? 1024 : FF, wo ? 1024 : FF}; pg8::StaticOrder S; S.init(M_TOK, 1024, G, bid);
            const bool lastffn = (l == 1 && sl == 18);
            h16* HB2 = (h16*)(ws + R3 + 32 * MiB);
            if (!lastffn) {
                const int nl = (sl == 18) ? 1 : l;
                const float* modn = MOD + (unsigned)nl * 8 * 9216;
                const int nsh = (sl == 2) ? 3 : (sl == 15 ? 6 : 0);
                const float* lnn = ((sl == 2) ? p.in[5] : (sl == 15 ? p.in[6] : p.in[4])) + nl * 1024;
                const unsigned use = (l == 0) ? (sl == 2 ? 1u : (sl == 15 ? 2u : 3u)) : (sl == 2 ? 4u : 5u);
                if (first) {
                    pg8::EpiResidNorm<true> E{x, hbuf, hbuf, modl + 2 * 1024, 0.5f, XN, lnn, modn + nsh * 1024, modn + (nsh + 1) * 1024,
                                              (float*)(ws + R2), (unsigned*)(p.ws + R4_BAR + 16384), 4u * use, (float*)nullptr, ldsl + 131072};
                    pg8::gemm_phase(ldsl, gm, S, E);
                } else {
                    pg8::EpiResidNorm<false> E{nullptr, hbuf, (wo && l == 1) ? HB2 : hbuf, modl + (wo ? 5 : (sl == 2 ? 2 : 8)) * 1024, wo ? 1.0f : 0.5f, XN, lnn, modn + nsh * 1024, modn + (nsh + 1) * 1024,
                                               (float*)(ws + R2), (unsigned*)(p.ws + R4_BAR + 16384), 4u * use, (float*)nullptr, ldsl + 131072};
                    pg8::gemm_phase(ldsl, gm, S, E);
                }
            } else {
                pg8::EpiResidNorm<false, true> E{nullptr, HB2, HB2, modl + 8 * 1024, 0.5f, XN, p.in[21], p.in[21], p.in[21],
                                                 (float*)(ws + R2), (unsigned*)(p.ws + R4_BAR + 16384), 4u * 6u, p.out, ldsl + 131072};
                pg8::gemm_phase(ldsl, gm, S, E);
            }
        } else if (sl == 4 || sl == 8 || sl == 13) {
            if (sl == 13) phase_gnorm(Pdn, p.in[14] + l * 128);
            const int N = (sl == 4) ? 2560 : (sl == 8 ? 4096 : 1024);
            pg8::Gemm gm{XN, sl == 4 ? Wda : (sl == 8 ? Wdn : Wg + 1024 * 1024), M_TOK, N, 1024, 1024}; pg8::StaticOrder S; S.init(M_TOK, N, G, bid);
            pg8::EpiStore E{sl == 4 ? Pda : (sl == 8 ? Pdn : GATE_B), sl == 4 ? 2304 : (sl == 8 ? 4096 : 1024), BD, sl == 4 ? 9 : (sl == 8 ? 16 : 4), sl == 13 ? 1 : 0, sl == 8 ? HALO : (h16*)nullptr};
            pg8::gemm_phase(ldsl, gm, S, E);
        } else if (sl >= 5 && sl <= 7) {
            phase_attn(Pda, OB, LSE, sl - 5, lds);
        } else if (sl == 10) {
            phase_dnprep(Pdn, HALO, BD, p.in[11] + (unsigned)l * 4 * 3072, p.in[12] + l * 8, p.in[13] + l * 8, Tg, QKg, GC, BETA, LSE, ldsl, lds);
        } else if (sl == 11) {
            if (bid < 128) {
                phase_scan(Pdn, Tg, QKg, GC, BETA, LSE, lds);
            } else {
                pg8::Gemm gm{XN, Wg, M_TOK, 1024, 1024, 1024}; pg8::StaticOrder S; S.init(M_TOK, 1024, G - 128, bid - 128);
                pg8::EpiStore E{GATE_A, 1024, BD, 4, 1, (h16*)nullptr}; pg8::gemm_phase(ldsl, gm, S, E);
            }
        } else if (sl == 14) {
#pragma unroll 1
            for (int q = 0; q < 2; ++q) {
                pg8::Gemm gm{q ? OB : Pdn + 2048, q ? Wb : Wa, M_TOK, 1024, q ? 768 : 1024, q ? 768 : 4096}; pg8::StaticOrder S; S.init(M_TOK, 1024, G, bid);
                pg8::EpiMerge E{XN, q ? GATE_B : GATE_A, q}; pg8::gemm_phase(ldsl, gm, S, E);
                __syncthreads();
            }
        }
        {
            const int ck = (sl == 0) ? 0 : (sl == 2 ? 3 : (sl == 15 ? 16 : ((sl == 18 && l == 0) ? 0 : -1)));
            const int cl = (sl == 18) ? 1 : l;
            h16* cW1 = (h16*)(ws + R3_W1 + ((sl == 18) ? 32 * MiB : 0)); h16* cW2 = (h16*)(ws + R3_W2 + ((sl == 18) ? 32 * MiB : 0));
            if (ck >= 0) {
            const int nconv = (ck == 3) ? 7 : 3;
    #pragma unroll 1
                for (int ci = 0; ci < nconv; ++ci) {
                    const float* src; int ldsrc, coloff = 0, nvalid, Ntot, K = 1024, inter = -1; h16* dst;
                    if (ck == 3) {
                        const float* win = p.in[10] + (unsigned)l * 1024 * 8464;
                        if (ci == 0)      { src = win; ldsrc = 8464; coloff = 4112; nvalid = 2304; Ntot = 2304; dst = Wda; }
                        else if (ci == 1) { src = win; ldsrc = 8464; coloff = 0;    nvalid = 4096; Ntot = 4096; dst = Wdn; }
                        else if (ci == 6) { src = win; ldsrc = 8464; coloff = 4096; nvalid = 16;   Ntot = 256;  dst = Wda + 2304 * 1024; }
                        else if (ci == 2) { src = win; ldsrc = 8464; coloff = 6416; nvalid = 2048; Ntot = 2048; dst = Wg; }
                        else if (ci == 3) { src = p.in[15] + (unsigned)l * 1024 * 1024; ldsrc = 1024; nvalid = 1024; Ntot = 1024; dst = Wa; }
                        else if (ci == 4) { src = p.in[16] + (unsigned)l * 768 * 1024;  ldsrc = 1024; nvalid = 1024; Ntot = 1024; K = 768; dst = Wb; }
                        else              { src = p.in[17] + (unsigned)l * 1024 * 1024; ldsrc = 1024; nvalid = 1024; Ntot = 1024; dst = Wo; }
                    } else {
                        const bool f2 = (ck == 16);
                        if (ci == 0)      { src = (f2 ? p.in[18] : p.in[7]) + (unsigned)cl * 1024 * FF; ldsrc = FF; nvalid = FF; Ntot = FF; dst = cW1; inter = 0; }
                        else if (ci == 1) { src = (f2 ? p.in[19] : p.in[8]) + (unsigned)cl * 1024 * FF; ldsrc = FF; nvalid = FF; Ntot = FF; dst = cW1; inter = 1; }
                        else              { src = (f2 ? p.in[20] : p.in[9]) + (unsigned)cl * FF * 1024; ldsrc = 1024; nvalid = 1024; Ntot = 1024; K = FF; dst = cW2; }
                    }
                    conv_w(src, ldsrc, coloff, nvalid, Ntot, K, dst, inter, lds);
                }

            }
        }
        xcd_barrier((unsigned*)(p.ws + R4_BAR), xb_xcc_id(), bst);
    }
}

extern "C" void kernel_launch(void* const* d_in, const int* in_sizes, int n_in, void* d_out, int out_size, void* d_ws, size_t ws_size, hipStream_t stream) {
    static int grid = 0;
    if (grid == 0) {
        if (n_in != 22 || ws_size < WS_NEED) { fprintf(stderr, "kernel_launch: unexpected n_in %d or ws_size %zu (< %zu)\n", n_in, ws_size, (size_t)WS_NEED); grid = -1; return; }
        int dev = 0, cus = 0, per_cu = 0;
        hipGetDevice(&dev);
        hipDeviceGetAttribute(&cus, hipDeviceAttributeMultiprocessorCount, dev);
        hipFuncSetAttribute((const void*)fwd_mega, hipFuncAttributeMaxDynamicSharedMemorySize, LDS_BYTES);
        hipOccupancyMaxActiveBlocksPerMultiprocessor(&per_cu, (const void*)fwd_mega, 512, LDS_BYTES);
        if (per_cu < 1) per_cu = 1;
        if (per_cu > 1) per_cu = 1;
        grid = cus * per_cu;
        (void)hipGetLastError();
    }
    if (grid < 0) return;
    Params p{};
    for (int i = 0; i < 22; ++i) p.in[i] = (const float*)d_in[i];
    p.out = (float*)d_out; p.ws = (unsigned char*)d_ws;
    (void)hipMemsetAsync((unsigned char*)d_ws + R4_BAR, 0, 32768, stream);
    void* args[] = {&p};
    hipError_t e = hipLaunchCooperativeKernel((const void*)fwd_mega, dim3(grid), dim3(512), args, LDS_BYTES, stream);
    if (e != hipSuccess) fprintf(stderr, "cooperative launch failed: %s (grid %d)\n", hipGetErrorString(e), grid);
}
```

```cpp
#include <hip/hip_runtime.h>
#include <hip/hip_cooperative_groups.h>
#include <cstdio>
namespace cg = cooperative_groups;

typedef _Float16 h16;
typedef _Float16 h16x2 __attribute__((ext_vector_type(2)));
typedef _Float16 h16x4 __attribute__((ext_vector_type(4)));
typedef _Float16 h16x8 __attribute__((ext_vector_type(8)));
typedef float f32x4 __attribute__((ext_vector_type(4)));
#define LAS __attribute__((address_space(3)))
#define GAS __attribute__((address_space(1)))
template <class T> __device__ __forceinline__ T gld(const T* p) { return *(const GAS T*)p; }
template <class T> __device__ __forceinline__ void gst(T* p, T v) { *(GAS T*)p = v; }

constexpr int M_TOK = 32768, DM = 1024, FF = 2816, SEQ = 4096;
constexpr size_t MiB = 1024ull * 1024ull;
constexpr size_t R0 = 0;
constexpr size_t R1 = 256 * MiB;
constexpr size_t R2 = 320 * MiB;
constexpr size_t R3 = 368 * MiB;
constexpr size_t R4 = 496 * MiB;
constexpr size_t R3_T = R3, R3_QK = R3 + 32 * MiB, R3_HALO = R3 + 64 * MiB, R3_WDN = R3 + 74 * MiB, R3_WDA = R3 + 83 * MiB;
constexpr size_t R3_W1 = R3, R3_W2 = R3 + 12 * MiB;
constexpr size_t KiB = 1024ull;
constexpr size_t R4_WG = R4, R4_WA = R4 + 4096 * KiB, R4_WB = R4 + 6144 * KiB, R4_WO = R4 + 7680 * KiB, R4_MOD = R4 + 9728 * KiB,
                 R4_BD = R4 + 10496 * KiB, R4_LSE = R4 + 12544 * KiB, R4_GC = R4 + 14080 * KiB, R4_BETA = R4 + 15104 * KiB, R4_BAR = R4 + 16256 * KiB;
constexpr size_t WS_NEED = 512 * MiB;
constexpr int LDS_BYTES = 161792 + 64;

__device__ __forceinline__ float shx(float v, int m, int lane) { return __int_as_float(__builtin_amdgcn_ds_bpermute((lane ^ m) << 2, __float_as_int(v))); }
__device__ __forceinline__ float wave_sum(float v, int lane) {
#pragma unroll
    for (int o = 32; o > 0; o >>= 1) v += shx(v, o, lane);
    return v;
}
__device__ __forceinline__ float fexp(float x) { return __builtin_amdgcn_exp2f(x * 1.4426950408889634f); }
__device__ __forceinline__ float flog(float x) { return __builtin_amdgcn_logf(x) * 0.6931471805599453f; }
__device__ __forceinline__ float silu_f(float x) { return x * __builtin_amdgcn_rcpf(1.0f + fexp(-x)); }
__device__ __forceinline__ float sigm_f(float x) { return __builtin_amdgcn_rcpf(1.0f + fexp(-x)); }
__device__ __forceinline__ h16x8 cat8(h16x4 a, h16x4 b) { return __builtin_shufflevector(a, b, 0, 1, 2, 3, 4, 5, 6, 7); }
typedef short s16x4v __attribute__((__vector_size__(8)));
__device__ __forceinline__ h16x4 tr_read4(const h16* p) { return __builtin_bit_cast(h16x4, __builtin_amdgcn_ds_read_tr16_b64_v4i16((LAS s16x4v*)p)); }
#define LDS_BARRIER() do { asm volatile("s_waitcnt lgkmcnt(0)" ::: "memory"); __builtin_amdgcn_s_barrier(); asm volatile("" ::: "memory"); } while (0)
#define LAUNDER_V(x) asm volatile("" : "+v"(x))
#define LAUNDER_S(x) asm volatile("" : "+s"(x))
#define MFMA16(a, b, c) __builtin_amdgcn_mfma_f32_16x16x32_f16((a), (b), (c), 0, 0, 0)

namespace pg8 {
constexpr int BM = 256, BK = 64, HALF = 128, HTB = HALF * BK * 2, NXCD = 8, WGM = 8;
__device__ __forceinline__ int lds_byte(int r, int c) { const int st = (r >> 4) * 2 + (c >> 5), rr = r & 15, cc = c & 31, ob = rr * 64 + cc * 2; return st * 1024 + (ob ^ (((ob >> 9) & 1) << 5)); }
__device__ __forceinline__ void stage_rc(int b, int& R, int& C) { const int st = b / 1024, sb = b % 1024, swz = sb ^ (((sb >> 9) & 1) << 5); R = (st >> 1) * 16 + swz / 64; C = (st & 1) * 32 + (swz % 64) / 2; }
__device__ __forceinline__ int perm32(int rho) { const int n = rho >> 4, i = rho & 15; return 8 * (i >> 2) + 4 * n + (i & 3); }
struct Unit { int pm, pn; };
struct Gemm { const h16* A; const h16* Bt; int M, N, K, lda; };
struct StaticOrder {
    int nM, nN, nwg, G, c;
    __device__ void init(int M, int N, int G_, int c_) { nM = M / BM; nN = N / BM; nwg = nM * nN; G = G_; c = c_; }
    __device__ bool next(int i, Unit& u) const {
        const long L = (long)i * G + c; if (L >= nwg) return false;
        int wgid = (int)L; { const int q = nwg / NXCD, r = nwg % NXCD, xcd = wgid % NXCD, off = wgid / NXCD; wgid = (xcd < r ? xcd * (q + 1) : r * (q + 1) + (xcd - r) * q) + off; }
        const int nig = WGM * nN, gid = wgid / nig, fm = gid * WGM, gsz = (nM - fm) < WGM ? (nM - fm) : WGM;
        u.pm = fm + ((wgid % nig) % gsz); u.pn = (wgid % nig) / gsz; return true;
    }
};

struct EpiSwiglu {
    static constexpr bool PERM = true;
    h16* O;
    __device__ __forceinline__ void operator()(const f32x4 (&acc)[2][2][4][2], const Unit& u, int wr, int wc, int fr, int fq) const {
        const int row0 = u.pm * BM + wr * 64 + fr, col0 = u.pn * 128 + wc * 32 + 8 * fq;
#pragma unroll
        for (int ai = 0; ai < 2; ++ai)
#pragma unroll
            for (int m = 0; m < 4; ++m) {
                h16x8 o;
#pragma unroll
                for (int n = 0; n < 2; ++n)
#pragma unroll
                    for (int j = 0; j < 4; ++j) o[4 * n + j] = (h16)(silu_f(acc[ai][0][m][n][j]) * acc[ai][1][m][n][j]);
                *(h16x8*)(O + (unsigned)(row0 + ai * HALF + m * 16) * FF + col0) = o;
            }
    }
};
struct EpiStore {
    static constexpr bool PERM = true;
    h16* O; int ldc; float* bd; int nmain; int act; h16* halo;
    __device__ __forceinline__ void operator()(const f32x4 (&acc)[2][2][4][2], const Unit& u, int wr, int wc, int fr, int fq) const {
        const int row0 = u.pm * BM + wr * 64 + fr;
        if (u.pn < nmain) {
            const int col0 = u.pn * BM + wc * 32 + 8 * fq;
#pragma unroll
            for (int ai = 0; ai < 2; ++ai)
#pragma unroll
                for (int m = 0; m < 4; ++m)
#pragma unroll
                    for (int bj = 0; bj < 2; ++bj) {
                        h16x8 o;
#pragma unroll
                        for (int n = 0; n < 2; ++n)
#pragma unroll
                            for (int j = 0; j < 4; ++j) { float v = acc[ai][bj][m][n][j]; if (act) v = sigm_f(v); o[4 * n + j] = (h16)v; }
                        *(h16x8*)(O + (unsigned)(row0 + ai * HALF + m * 16) * ldc + col0 + bj * HALF) = o;
                        if (halo && m == 3 && fr >= 13 && u.pn < 12) {
                            const int row = row0 + ai * HALF + 48, nc = ((row & 4095) >> 6) + 1;
                            if (nc < 64) *(h16x8*)(halo + ((unsigned)((row >> 12) * 64 + nc) * 3 + (fr - 13)) * 3072 + col0 + bj * HALF) = o;
                        }
                    }
        } else if (wc == 0 && fq < 2) {
#pragma unroll
            for (int ai = 0; ai < 2; ++ai)
#pragma unroll
                for (int m = 0; m < 4; ++m)
#pragma unroll
                    for (int n = 0; n < 2; ++n) *(f32x4*)(bd + (unsigned)(row0 + ai * HALF + m * 16) * 16 + 8 * fq + 4 * n) = acc[ai][0][m][n];
        }
    }
};
struct EpiResid {
    static constexpr bool PERM = true;
    const float* in32; const h16* in16; h16* out; const float* gate; float coef;
    __device__ __forceinline__ void operator()(const f32x4 (&acc)[2][2][4][2], const Unit& u, int wr, int wc, int fr, int fq) const {
        const int row0 = u.pm * BM + wr * 64 + fr, col0 = u.pn * BM + wc * 32 + 8 * fq;
        const int b = (u.pm * BM) >> 12;
        f32x4 gv[2][2];
#pragma unroll
        for (int bj = 0; bj < 2; ++bj)
#pragma unroll
            for (int n = 0; n < 2; ++n) gv[bj][n] = *(const f32x4*)(gate + b * 9216 + col0 + bj * HALF + 4 * n) * coef;
        if (in32) {
#pragma unroll
            for (int ai = 0; ai < 2; ++ai)
#pragma unroll
                for (int m = 0; m < 4; ++m)
#pragma unroll
                    for (int bj = 0; bj < 2; ++bj) {
                        const unsigned off = (unsigned)(row0 + ai * HALF + m * 16) * DM + col0 + bj * HALF;
                        const f32x4 x0 = *(const f32x4*)(in32 + off), x1 = *(const f32x4*)(in32 + off + 4);
                        h16x8 o;
#pragma unroll
                        for (int j = 0; j < 4; ++j) { o[j] = (h16)(x0[j] + gv[bj][0][j] * acc[ai][bj][m][0][j]); o[4 + j] = (h16)(x1[j] + gv[bj][1][j] * acc[ai][bj][m][1][j]); }
                        *(h16x8*)(out + off) = o;
                    }
        } else {
#pragma unroll
            for (int ai = 0; ai < 2; ++ai)
#pragma unroll
                for (int m = 0; m < 4; ++m)
#pragma unroll
                    for (int bj = 0; bj < 2; ++bj) {
                        const unsigned off = (unsigned)(row0 + ai * HALF + m * 16) * DM + col0 + bj * HALF;
                        const h16x8 xv = *(const h16x8*)(in16 + off);
                        h16x8 o;
#pragma unroll
                        for (int j = 0; j < 4; ++j) { o[j] = (h16)((float)xv[j] + gv[bj][0][j] * acc[ai][bj][m][0][j]); o[4 + j] = (h16)((float)xv[4 + j] + gv[bj][1][j] * acc[ai][bj][m][1][j]); }
                        *(h16x8*)(out + off) = o;
                    }
        }
    }
};
template <bool F32IN, bool FINAL = false> struct EpiResidNorm {
    static constexpr bool PERM = true;
    const float* in32; const h16* in16; h16* out; const float* gate; float coef;
    h16* xn; const float* ln; const float* shp; const float* scp;
    float* ss; unsigned* cnt; unsigned target;
    float* fout;
    LAS unsigned char* sm;
    __device__ __forceinline__ void operator()(const f32x4 (&acc)[2][2][4][2], const Unit& u, int wr, int wc, int fr, int fq) const {
        const int lane = fq * 16 + fr, wid = wr * 4 + wc, tid = wid * 64 + lane;
        const int row0 = u.pm * BM + wr * 64 + fr, col0 = u.pn * BM + wc * 32 + 8 * fq;
        const int b = (u.pm * BM) >> 12;
        LAS float* red = (LAS float*)sm; LAS float* rs = red + 1024;
        f32x4 gv[2][2];
#pragma unroll
        for (int bj = 0; bj < 2; ++bj)
#pragma unroll
            for (int n = 0; n < 2; ++n) gv[bj][n] = *(const f32x4*)(gate + b * 9216 + col0 + bj * HALF + 4 * n) * coef;
        h16x8 ov[2][4][2];
#pragma unroll
        for (int ai = 0; ai < 2; ++ai)
#pragma unroll
            for (int m = 0; m < 4; ++m) {
                float sq = 0.f;
#pragma unroll
                for (int bj = 0; bj < 2; ++bj) {
                    const unsigned off = (unsigned)(row0 + ai * HALF + m * 16) * DM + col0 + bj * HALF;
                    f32x4 xa, xb;
                    if (F32IN) { xa = *(const f32x4*)(in32 + off); xb = *(const f32x4*)(in32 + off + 4); }
                    else { const h16x8 xv = *(const h16x8*)(in16 + off); xa = (f32x4){(float)xv[0], (float)xv[1], (float)xv[2], (float)xv[3]}; xb = (f32x4){(float)xv[4], (float)xv[5], (float)xv[6], (float)xv[7]}; }
                    h16x8 o;
#pragma unroll
                    for (int j = 0; j < 4; ++j) { o[j] = (h16)(xa[j] + gv[bj][0][j] * acc[ai][bj][m][0][j]); o[4 + j] = (h16)(xb[j] + gv[bj][1][j] * acc[ai][bj][m][1][j]); }
                    if (!FINAL) *(h16x8*)(out + off) = o;
                    ov[ai][m][bj] = o;
#pragma unroll
                    for (int j = 0; j < 8; ++j) sq += (float)o[j] * (float)o[j];
                }
                sq += shx(sq, 16, lane); sq += shx(sq, 32, lane);
                if (fq == 0) red[(ai * HALF + wr * 64 + m * 16 + fr) * 4 + wc] = sq;
            }
        asm volatile("s_waitcnt lgkmcnt(0)" ::: "memory"); __builtin_amdgcn_s_barrier(); asm volatile("" ::: "memory");
        if (tid < 256) {
            const float part = (red[tid * 4 + 0] + red[tid * 4 + 1]) + (red[tid * 4 + 2] + red[tid * 4 + 3]);
            __hip_atomic_store(ss + (unsigned)(u.pm * 4 + u.pn) * 256 + tid, part, __ATOMIC_RELAXED, __HIP_MEMORY_SCOPE_AGENT);
        }
        asm volatile("s_waitcnt vmcnt(0)" ::: "memory");
        __builtin_amdgcn_s_barrier(); asm volatile("" ::: "memory");
        if (tid == 0) {
            (void)__hip_atomic_fetch_add(cnt + 16 * u.pm, 1u, __ATOMIC_RELAXED, __HIP_MEMORY_SCOPE_AGENT);
            unsigned spins = 0;
            while (__hip_atomic_load(cnt + 16 * u.pm, __ATOMIC_RELAXED, __HIP_MEMORY_SCOPE_AGENT) < target) { __builtin_amdgcn_s_sleep(1); if (++spins > (1u << 20)) break; }
        }
        __builtin_amdgcn_s_barrier(); asm volatile("" ::: "memory");
        if (tid < 256) {
            float tot = 0.f;
#pragma unroll
            for (int q = 0; q < 4; ++q) tot += __hip_atomic_load(ss + (unsigned)(u.pm * 4 + q) * 256 + tid, __ATOMIC_RELAXED, __HIP_MEMORY_SCOPE_AGENT);
            rs[tid] = rsqrtf(tot * (1.0f / 1024.0f) + 1e-6f);
        }
        asm volatile("s_waitcnt lgkmcnt(0)" ::: "memory"); __builtin_amdgcn_s_barrier(); asm volatile("" ::: "memory");
        const float* sh = FINAL ? ln : shp + b * 9216; const float* sc = FINAL ? ln : scp + b * 9216;
#pragma unroll
        for (int bj = 0; bj < 2; ++bj) {
            const int col = col0 + bj * HALF;
            const f32x4 l0 = *(const f32x4*)(ln + col), l1 = *(const f32x4*)(ln + col + 4), s0 = *(const f32x4*)(sh + col), s1 = *(const f32x4*)(sh + col + 4),
                        c0 = *(const f32x4*)(sc + col), c1 = *(const f32x4*)(sc + col + 4);
#pragma unroll
            for (int ai = 0; ai < 2; ++ai)
#pragma unroll
                for (int m = 0; m < 4; ++m) {
                    const float rstd = rs[ai * HALF + wr * 64 + m * 16 + fr];
                    const h16x8 o = ov[ai][m][bj];
                    if (FINAL) {
                        f32x4 y0, y1;
#pragma unroll
                        for (int j = 0; j < 4; ++j) { y0[j] = (float)o[j] * rstd * l0[j]; y1[j] = (float)o[4 + j] * rstd * l1[j]; }
                        float* yp = fout + (unsigned)(row0 + ai * HALF + m * 16) * DM + col;
                        *(f32x4*)yp = y0; *(f32x4*)(yp + 4) = y1;
                    } else {
                        h16x8 y;
#pragma unroll
                        for (int j = 0; j < 4; ++j) { y[j] = (h16)((float)o[j] * rstd * l0[j] * (1.0f + c0[j]) + s0[j]); y[4 + j] = (h16)((float)o[4 + j] * rstd * l1[j] * (1.0f + c1[j]) + s1[j]); }
                        *(h16x8*)(xn + (unsigned)(row0 + ai * HALF + m * 16) * DM + col) = y;
                    }
                }
        }
    }
};
struct EpiMerge {
    static constexpr bool PERM = true;
    h16* Mg; const h16* gates; int add;
    __device__ __forceinline__ void operator()(const f32x4 (&acc)[2][2][4][2], const Unit& u, int wr, int wc, int fr, int fq) const {
        const int row0 = u.pm * BM + wr * 64 + fr, col0 = u.pn * BM + wc * 32 + 8 * fq;
#pragma unroll
        for (int ai = 0; ai < 2; ++ai)
#pragma unroll
            for (int m = 0; m < 4; ++m)
#pragma unroll
                for (int bj = 0; bj < 2; ++bj) {
                    const unsigned row = (unsigned)(row0 + ai * HALF + m * 16);
                    const int col = col0 + bj * HALF;
                    const h16x8 gv = *(const h16x8*)(gates + row * DM + col);
                    h16x8 pv = {0, 0, 0, 0, 0, 0, 0, 0};
                    if (add) pv = *(const h16x8*)(Mg + row * DM + col);
                    h16x8 o;
#pragma unroll
                    for (int n = 0; n < 2; ++n)
#pragma unroll
                        for (int j = 0; j < 4; ++j) o[4 * n + j] = (h16)((float)pv[4 * n + j] + (float)gv[4 * n + j] * acc[ai][bj][m][n][j]);
                    *(h16x8*)(Mg + row * DM + col) = o;
                }
    }
};

template <class Epi>
__device__ __forceinline__ void gemm_phase(LAS unsigned char* lds, const Gemm g, const StaticOrder& S, const Epi& E) {
    int tid = threadIdx.x; LAUNDER_V(tid);
    const int wid = __builtin_amdgcn_readfirstlane(tid >> 6), lane = tid & 63, wr = wid >> 2, wc = wid & 3, fr = lane & 15, fq = lane >> 4;
    const int K = g.K, nt = K / BK;
    unsigned voffA[2], voffB[2];
#pragma unroll
    for (int i = 0; i < 2; ++i) { int R, C; stage_rc(tid * 16 + i * 8192, R, C); const int Rb = Epi::PERM ? ((R & ~31) + perm32(R & 31)) : R;
        voffA[i] = (unsigned)(R * g.lda + C) * 2u; voffB[i] = (unsigned)(Rb * K + C) * 2u; }
    const size_t kstep = (size_t)(BK * 2);
    const size_t hstepA = (size_t)HALF * g.lda * 2, hstepB = (size_t)HALF * K * 2;
    const size_t tstepA = 2 * hstepA, tstepB = 2 * hstepB;
    const unsigned ldsw = (unsigned)wid * 1024u;
    const int aoff = lds_byte(wr * 64 + fr, fq * 8), boff = lds_byte(wc * 32 + fr, fq * 8);
#define PG8_SA(b, h) (((b) * 2 + (h)) * HTB)
#define PG8_SB(b, h) ((4 + (b) * 2 + (h)) * HTB)
#define PG8_STAGE(bufoff, gbase, voff) do { _Pragma("unroll") for (int _i = 0; _i < 2; ++_i) \
        __builtin_amdgcn_global_load_lds((const unsigned*)((const char*)(gbase) + (voff)[_i]), (LAS unsigned*)(lds + (bufoff) + ldsw + _i * 8192), 16, 0, 0); } while (0)
#define PG8_LDA(dst, b, h) do { _Pragma("unroll") for (int m = 0; m < 4; ++m) _Pragma("unroll") for (int k = 0; k < 2; ++k) dst[m][k] = *(const LAS h16x8*)(lds + PG8_SA(b, h) + aoff + m * 2048 + k * 1024); } while (0)
#define PG8_LDB(dst, b, h) do { _Pragma("unroll") for (int n = 0; n < 2; ++n) _Pragma("unroll") for (int k = 0; k < 2; ++k) dst[n][k] = *(const LAS h16x8*)(lds + PG8_SB(b, h) + boff + n * 2048 + k * 1024); } while (0)
#define PG8_MMA(ai, bj, At, Bt) do { __builtin_amdgcn_s_setprio(1); _Pragma("unroll") for (int m = 0; m < 4; ++m) _Pragma("unroll") for (int n = 0; n < 2; ++n) _Pragma("unroll") for (int k = 0; k < 2; ++k) \
        acc[ai][bj][m][n] = __builtin_amdgcn_mfma_f32_16x16x32_f16(Bt[n][k], At[m][k], acc[ai][bj][m][n], 0, 0, 0); __builtin_amdgcn_s_setprio(0); } while (0)
#define PG8_WAIT_V(n) asm volatile("s_waitcnt vmcnt(" #n ")" ::: "memory")
#define PG8_WAIT_L(n) asm volatile("s_waitcnt lgkmcnt(" #n ")" ::: "memory")
#define PG8_BAR __builtin_amdgcn_s_barrier()
#define PG8_SCHED __builtin_amdgcn_sched_barrier(0)
    Unit cur, nxt; int ui = 0;
    if (!S.next(0, cur)) return;
    f32x4 acc[2][2][4][2];
#pragma unroll
    for (int a = 0; a < 2; ++a)
#pragma unroll
        for (int b = 0; b < 2; ++b)
#pragma unroll
            for (int m = 0; m < 4; ++m)
#pragma unroll
                for (int n = 0; n < 2; ++n) acc[a][b][m][n] = (f32x4){0.f, 0.f, 0.f, 0.f};
    h16x8 At[4][2], B0[2][2], B1[2][2];
    const char* cA = (const char*)g.A + (size_t)cur.pm * tstepA; const char* cB = (const char*)g.Bt + (size_t)cur.pn * tstepB;
    PG8_STAGE(PG8_SB(0, 0), cB, voffB); PG8_STAGE(PG8_SB(0, 1), cB + hstepB, voffB); PG8_STAGE(PG8_SA(0, 0), cA, voffA); PG8_STAGE(PG8_SA(0, 1), cA + hstepA, voffA);
    if (wr == 1) PG8_BAR;
    PG8_WAIT_V(2); PG8_BAR;
    PG8_STAGE(PG8_SB(1, 0), cB + kstep, voffB); PG8_STAGE(PG8_SA(1, 0), cA + kstep, voffA); PG8_STAGE(PG8_SB(1, 1), cB + hstepB + kstep, voffB);
    PG8_WAIT_V(6); PG8_BAR;
    for (;;) {
        const bool has_next = S.next(ui + 1, nxt);
        const char* nA = has_next ? (const char*)g.A + (size_t)nxt.pm * tstepA : cA; const char* nB = has_next ? (const char*)g.Bt + (size_t)nxt.pn * tstepB : cB;
        for (int t = 0; t < nt; t += 2) {
            const bool last = (t == nt - 2);
            const char* a1 = cA + (size_t)(t + 1) * kstep;
            const char* a2 = last ? nA : cA + (size_t)(t + 2) * kstep; const char* b2 = last ? nB : cB + (size_t)(t + 2) * kstep;
            const char* a3 = a2 + kstep; const char* b3 = b2 + kstep;
            PG8_LDB(B0, 0, 0); PG8_LDB(B1, 0, 1); PG8_SCHED; PG8_LDA(At, 0, 0); PG8_STAGE(PG8_SA(1, 1), a1 + hstepA, voffA);
            PG8_WAIT_V(8); PG8_WAIT_L(0); PG8_BAR; PG8_MMA(0, 0, At, B0); PG8_MMA(0, 1, At, B1); PG8_BAR; PG8_SCHED;
            PG8_LDA(At, 0, 1); PG8_STAGE(PG8_SB(0, 0), b2, voffB); PG8_STAGE(PG8_SB(0, 1), b2 + hstepB, voffB); PG8_STAGE(PG8_SA(0, 0), a2, voffA);
            PG8_WAIT_V(8); PG8_WAIT_L(0); PG8_BAR; PG8_MMA(1, 0, At, B0); PG8_MMA(1, 1, At, B1); PG8_BAR; PG8_SCHED;
            PG8_LDB(B0, 1, 0); PG8_LDB(B1, 1, 1); PG8_SCHED; PG8_LDA(At, 1, 0); PG8_STAGE(PG8_SA(0, 1), a2 + hstepA, voffA);
            PG8_WAIT_V(8); PG8_WAIT_L(0); PG8_BAR; PG8_MMA(0, 0, At, B0); PG8_MMA(0, 1, At, B1); PG8_BAR; PG8_SCHED;
            PG8_LDA(At, 1, 1); PG8_STAGE(PG8_SB(1, 0), b3, voffB); PG8_STAGE(PG8_SB(1, 1), b3 + hstepB, voffB); PG8_STAGE(PG8_SA(1, 0), a3, voffA);
            PG8_WAIT_V(8); PG8_WAIT_L(0); PG8_BAR; PG8_MMA(1, 0, At, B0); PG8_MMA(1, 1, At, B1); PG8_BAR; PG8_SCHED;
        }
        if (wr == 0) PG8_BAR;
        E(acc, cur, wr, wc, fr, fq);
        if (!has_next) break;
#pragma unroll
        for (int a = 0; a < 2; ++a)
#pragma unroll
            for (int b = 0; b < 2; ++b)
#pragma unroll
                for (int m = 0; m < 4; ++m)
#pragma unroll
                    for (int n = 0; n < 2; ++n) acc[a][b][m][n] = (f32x4){0.f, 0.f, 0.f, 0.f};
        cur = nxt; cA = nA; cB = nB; ++ui;
        if (wr == 1) PG8_BAR;
    }
    PG8_WAIT_V(0);
    PG8_BAR;
#undef PG8_SA
#undef PG8_SB
#undef PG8_STAGE
#undef PG8_LDA
#undef PG8_LDB
#undef PG8_MMA
#undef PG8_WAIT_V
#undef PG8_WAIT_L
#undef PG8_BAR
#undef PG8_SCHED
}
}

struct Params {
    const float* in[22];
    float* out;
    unsigned char* ws;
};

__device__ __forceinline__ void phase_mod(const float* c, const float* ada_w, const float* ada_b, float* mod, unsigned char* ldsb) {
    float* cact = (float*)ldsb;
    float* red = cact + 8192;
    int tid = threadIdx.x; LAUNDER_V(tid); int bid = blockIdx.x; LAUNDER_S(bid);
    const int lane = tid & 63, w = __builtin_amdgcn_readfirstlane(tid >> 6);
    for (int i = tid; i < 8192; i += 512) cact[i] = silu_f(c[i]);
    LDS_BARRIER();
    for (int item = bid; item < 288; item += gridDim.x) {
        const int l = item / 144, n0 = (item % 144) * 64;
        const float* W = ada_w + (unsigned)l * 1024 * 9216 + n0 + lane;
        float acc[8];
#pragma unroll
        for (int b = 0; b < 8; ++b) acc[b] = 0.f;
        const int k0 = w * 128;
#pragma unroll 16
        for (int k = k0; k < k0 + 128; ++k) {
            const float wv = W[(unsigned)k * 9216];
#pragma unroll
            for (int b = 0; b < 8; ++b) acc[b] += cact[b * 1024 + k] * wv;
        }
#pragma unroll
        for (int b = 0; b < 8; ++b) red[(w * 8 + b) * 64 + lane] = acc[b];
        LDS_BARRIER();
        {
            const int b = w;
            float s = ada_b[l * 9216 + n0 + lane];
#pragma unroll
            for (int ww = 0; ww < 8; ++ww) s += red[(ww * 8 + b) * 64 + lane];
            mod[(unsigned)(l * 8 + b) * 9216 + n0 + lane] = s;
        }
        LDS_BARRIER();
    }
}

__device__ __forceinline__ void conv_w(const float* src, int ldsrc, int coloff, int nvalid, int Ntot, int K, h16* dst, int inter, unsigned char* ldsb, int wg0 = 0, int nwg = 0) {
    float* tile = (float*)ldsb;
    int tid = threadIdx.x; LAUNDER_V(tid); int bid = blockIdx.x; LAUNDER_S(bid);
    const int nkt = K / 64, ntiles = (Ntot / 128) * nkt;
    float v[16];
#define CONVW_LOAD(t_) do { const int n0_ = ((t_) / nkt) * 128, k0_ = ((t_) % nkt) * 64; \
        _Pragma("unroll") for (int it = 0; it < 16; ++it) { const int e = tid + 512 * it, kk = e >> 7, nn = e & 127, n = n0_ + nn; \
            const int nc_ = (n < nvalid) ? n : (nvalid - 1); const float x_ = gld(src + (unsigned)(k0_ + kk) * ldsrc + nc_ + coloff); v[it] = (n < nvalid) ? x_ : 0.f; } } while (0)
    const int cstride = nwg ? nwg : (int)gridDim.x; bid -= wg0;
    if (bid < 0) return;
    if (bid < ntiles) CONVW_LOAD(bid);
    for (int t = bid; t < ntiles; t += cstride) {
        const int n0 = (t / nkt) * 128, k0 = (t % nkt) * 64;
#pragma unroll
        for (int it = 0; it < 16; ++it) { const int e = tid + 512 * it, kk = e >> 7, nn = e & 127; tile[kk * 129 + nn] = v[it]; }
        LDS_BARRIER();
        if (t + cstride < ntiles) CONVW_LOAD(t + cstride);
#pragma unroll
        for (int it = 0; it < 8; ++it) {
            const int e = tid + 512 * it, nn = e >> 5, kp = e & 31, n = n0 + nn;
            const int dr = (inter >= 0) ? ((n >> 7) * 256 + inter * 128 + (n & 127)) : n;
            h16x2 o; o[0] = (h16)tile[(2 * kp) * 129 + nn]; o[1] = (h16)tile[(2 * kp + 1) * 129 + nn];
            gst((h16x2*)(dst + (unsigned)dr * K + k0 + 2 * kp), o);
        }
        LDS_BARRIER();
    }
#undef CONVW_LOAD
}

__device__ __forceinline__ void phase_norm(const float* src32, const h16* src16, const float* ln, const float* modl, int shi, int sci, h16* dst) {
    int tid = threadIdx.x; LAUNDER_V(tid); int bid = blockIdx.x; LAUNDER_S(bid);
    const int lane = tid & 63, w = __builtin_amdgcn_readfirstlane(tid >> 6);
    const int stride = gridDim.x * 16, half = gridDim.x * 8;
    f32x4 vc[2][4], vn[2][4];
#define NORM_LOAD(V, r0_) do { _Pragma("unroll") for (int u = 0; u < 2; ++u) { const int row = (r0_) + u * half; if (row < M_TOK) { \
        if (src32) { _Pragma("unroll") for (int i = 0; i < 4; ++i) V[u][i] = gld((const f32x4*)(src32 + (unsigned)row * DM + 4 * lane + 256 * i)); } \
        else { const h16x8 a_ = gld((const h16x8*)(src16 + (unsigned)row * DM + 16 * lane)), b_ = gld((const h16x8*)(src16 + (unsigned)row * DM + 16 * lane + 8)); \
               _Pragma("unroll") for (int j = 0; j < 4; ++j) { V[u][0][j] = (float)a_[j]; V[u][1][j] = (float)a_[4 + j]; V[u][2][j] = (float)b_[j]; V[u][3][j] = (float)b_[4 + j]; } } } } } while (0)
    int row0 = bid * 8 + w;
    if (row0 < M_TOK) NORM_LOAD(vc, row0);
    for (; row0 < M_TOK; row0 += stride) {
        if (row0 + stride < M_TOK) NORM_LOAD(vn, row0 + stride);
#pragma unroll
        for (int u = 0; u < 2; ++u) {
            const int row = row0 + u * half;
            if (row < M_TOK) {
                float ss = 0.f;
#pragma unroll
                for (int i = 0; i < 4; ++i) ss += vc[u][i][0] * vc[u][i][0] + vc[u][i][1] * vc[u][i][1] + vc[u][i][2] * vc[u][i][2] + vc[u][i][3] * vc[u][i][3];
                ss = wave_sum(ss, lane);
                const float rstd = rsqrtf(ss * (1.0f / 1024.0f) + 1e-6f);
                const int b = row >> 12;
                const float* sh = modl + b * 9216 + shi * 1024; const float* sc = modl + b * 9216 + sci * 1024;
#pragma unroll
                for (int i = 0; i < 4; ++i) {
                    const int col = src32 ? (4 * lane + 256 * i) : (16 * lane + 4 * i);
                    const f32x4 gv = *(const f32x4*)(ln + col), sv = *(const f32x4*)(sh + col), cv = *(const f32x4*)(sc + col);
                    h16x4 o;
#pragma unroll
                    for (int j = 0; j < 4; ++j) o[j] = (h16)(vc[u][i][j] * rstd * gv[j] * (1.0f + cv[j]) + sv[j]);
                    gst((h16x4*)(dst + (unsigned)row * DM + col), o);
                }
            }
        }
#pragma unroll
        for (int u = 0; u < 2; ++u)
#pragma unroll
            for (int i = 0; i < 4; ++i) vc[u][i] = vn[u][i];
    }
#undef NORM_LOAD
}
__device__ __forceinline__ void phase_final(const h16* src, float* outp, const float* ln) {
    int tid = threadIdx.x; LAUNDER_V(tid); int bid = blockIdx.x; LAUNDER_S(bid);
    const int lane = tid & 63, w = __builtin_amdgcn_readfirstlane(tid >> 6);
    const int stride = gridDim.x * 16, half = gridDim.x * 8;
    h16x8 vc[2][2], vn[2][2];
#define FIN_LOAD(V, r0_) do { _Pragma("unroll") for (int u = 0; u < 2; ++u) { const int row = (r0_) + u * half; if (row < M_TOK) { \
        V[u][0] = gld((const h16x8*)(src + (unsigned)row * DM + 16 * lane)); V[u][1] = gld((const h16x8*)(src + (unsigned)row * DM + 16 * lane + 8)); } } } while (0)
    f32x4 gv[4];
#pragma unroll
    for (int i = 0; i < 4; ++i) gv[i] = *(const f32x4*)(ln + 16 * lane + 4 * i);
    int row0 = bid * 8 + w;
    if (row0 < M_TOK) FIN_LOAD(vc, row0);
    for (; row0 < M_TOK; row0 += stride) {
        if (row0 + stride < M_TOK) FIN_LOAD(vn, row0 + stride);
#pragma unroll
        for (int u = 0; u < 2; ++u) {
            const int row = row0 + u * half;
            if (row < M_TOK) {
                float x[16]; float ss = 0.f;
#pragma unroll
                for (int e = 0; e < 8; ++e) { x[e] = (float)vc[u][0][e]; x[8 + e] = (float)vc[u][1][e]; }
#pragma unroll
                for (int e = 0; e < 16; ++e) ss += x[e] * x[e];
                ss = wave_sum(ss, lane);
                const float rstd = rsqrtf(ss * (1.0f / 1024.0f) + 1e-6f);
#pragma unroll
                for (int i = 0; i < 4; ++i) {
                    f32x4 o;
#pragma unroll
                    for (int j = 0; j < 4; ++j) o[j] = x[4 * i + j] * rstd * gv[i][j];
                    gst((f32x4*)(outp + (unsigned)row * DM + 16 * lane + 4 * i), o);
                }
            }
        }
#pragma unroll
        for (int u = 0; u < 2; ++u) { vc[u][0] = vn[u][0]; vc[u][1] = vn[u][1]; }
    }
#undef FIN_LOAD
}

__device__ __forceinline__ void phase_attn(const h16* Pda, h16* ob, float* lse, int pat, unsigned char* ldsb) {
    int tid = threadIdx.x; LAUNDER_V(tid); int bid = blockIdx.x; LAUNDER_S(bid);
    const int lane = tid & 63, w = __builtin_amdgcn_readfirstlane(tid >> 6), fr = lane & 15, g = lane >> 4;
    const int r = (pat == 0) ? 1 : (pat == 1 ? 4 : 16);
    const int nbk2 = 16 / r;
    h16* Ks = (h16*)ldsb;
    h16* Vs = Ks + 384 * 72;
    h16* Qs = Vs + 384 * 72;
    h16x8 pk[6], pv[6], pq[4];
#define ATT_MAP(v_) ((((v_) & 7) * 192) + ((v_) >> 3))
#define ATT_LOAD(vitem_) do { const int item_ = ATT_MAP(vitem_); const int b_ = (item_) / 192, rem_ = (item_) % 192, h_ = rem_ / 16, rest_ = rem_ % 16, p_ = rest_ / nbk2, nbA_ = 2 * (rest_ % nbk2); \
        int tl_ = tid; LAUNDER_V(tl_); const h16* base_ = Pda + (unsigned)b_ * SEQ * 2304 + h_ * 64; \
        _Pragma("unroll") for (int it = 0; it < 6; ++it) { const int c = tl_ + 512 * it, j = c >> 3, part = c & 7, s = 128 * (nbA_ - 1) + j; \
            pk[it] = (h16x8){0, 0, 0, 0, 0, 0, 0, 0}; pv[it] = pk[it]; \
            if (s >= 0) { const h16* rowp = base_ + (unsigned)(p_ + r * s) * 2304 + part * 8; pk[it] = gld((const h16x8*)(rowp + 768)); pv[it] = gld((const h16x8*)(rowp + 1536)); } } \
        _Pragma("unroll") for (int it = 0; it < 4; ++it) { const int c = tl_ + 512 * it, i = c >> 3, part = c & 7, s = 128 * nbA_ + i; \
            pq[it] = gld((const h16x8*)(base_ + (unsigned)(p_ + r * s) * 2304 + part * 8)); } } while (0)
    const int G_ = (int)gridDim.x;
    if (bid < 1536) ATT_LOAD(bid);
    for (int item = bid; item < 1536; item += G_) {
        {
        {
        const int mitem = ATT_MAP(item);
        const int b = mitem / 192, rem = mitem % 192, h = rem / 16, rest = rem % 16;
        const int p = rest / nbk2, nbA = 2 * (rest % nbk2);
#pragma unroll
        for (int it = 0; it < 6; ++it) {
            const int c = tid + 512 * it, j = c >> 3, part = c & 7;
            *(h16x8*)(Ks + j * 72 + part * 8) = pk[it];
            *(h16x8*)(Vs + j * 72 + part * 8) = pv[it];
        }
#pragma unroll
        for (int it = 0; it < 4; ++it) {
            const int c = tid + 512 * it, i = c >> 3, part = c & 7;
            *(h16x8*)(Qs + i * 72 + part * 8) = pq[it] * (h16)0.18033688f;
        }
        LDS_BARRIER();
        if (item + G_ < 1536) ATT_LOAD(item + G_);
#pragma unroll
        for (int qb = 0; qb < 2; ++qb) {
        const int nb = nbA + qb;
        const h16* Kb = Ks + 128 * qb * 72; const h16* Vb = Vs + 128 * qb * 72; const h16* Qb = Qs + 128 * qb * 72;
        float lp_pre = 0.f; h16x4 prev_pre[4];
#pragma unroll
        for (int dt = 0; dt < 4; ++dt) prev_pre[dt] = (h16x4){0, 0, 0, 0};
        if (pat > 0) {
            const unsigned tok_ = (unsigned)b * SEQ + p + r * (128 * nb + 16 * w + fr);
            lp_pre = gld(lse + tok_ * 12 + h);
#pragma unroll
            for (int dt = 0; dt < 4; ++dt) prev_pre[dt] = gld((const h16x4*)(ob + tok_ * 768 + h * 64 + 4 * g + 16 * dt));
        }
        const float slope = __builtin_amdgcn_exp2f(-8.0f * (float)(h + 1) / 12.0f);
        const float sr = slope * (float)r * 1.4426950408889634f;
        h16x8 qf[2];
#pragma unroll
        for (int kk = 0; kk < 2; ++kk) qf[kk] = *(const h16x8*)(Qb + (16 * w + fr) * 72 + 32 * kk + 8 * g);
        float sc[9][4];
        float mx = -1e30f;
        const int iq = 16 * w + fr;
        float brg[4];
#pragma unroll
        for (int rg = 0; rg < 4; ++rg) brg[rg] = -sr * (float)(fr + 128 - 4 * g - rg);
#pragma unroll
        for (int tt = 0; tt < 9; ++tt) {
            const int jt = w + tt;
            const bool tile_ok = (jt <= 15) && (nb > 0 || jt >= 8);
            if (tile_ok) {
                f32x4 acc = {0.f, 0.f, 0.f, 0.f};
#pragma unroll
                for (int kk = 0; kk < 2; ++kk) { const h16x8 kf = *(const h16x8*)(Kb + (16 * jt + fr) * 72 + 32 * kk + 8 * g); acc = MFMA16(kf, qf[kk], acc); }
                const float bt = sr * (float)(16 * tt);
#pragma unroll
                for (int rg = 0; rg < 4; ++rg) {
                    float sv = acc[rg] + (brg[rg] + bt);
                    if (tt == 0) sv = (4 * g + rg >= fr) ? sv : -1e30f;
                    if (tt == 8) sv = (4 * g + rg <= fr) ? sv : -1e30f;
                    sc[tt][rg] = sv; mx = fmaxf(mx, sv);
                }
            } else {
#pragma unroll
                for (int rg = 0; rg < 4; ++rg) sc[tt][rg] = -1e30f;
            }
        }
        mx = fmaxf(mx, shx(mx, 16, lane)); mx = fmaxf(mx, shx(mx, 32, lane));
        float lsum = 0.f;
#pragma unroll
        for (int tt = 0; tt < 9; ++tt)
#pragma unroll
            for (int rg = 0; rg < 4; ++rg) { const float pv = __builtin_amdgcn_exp2f(sc[tt][rg] - mx); sc[tt][rg] = pv; lsum += pv; }
        lsum += shx(lsum, 16, lane); lsum += shx(lsum, 32, lane);
        f32x4 o[4];
#pragma unroll
        for (int dt = 0; dt < 4; ++dt) o[dt] = (f32x4){0.f, 0.f, 0.f, 0.f};
#pragma unroll
        for (int kk2 = 0; kk2 < 5; ++kk2) {
            const int ta = 2 * kk2, tb = 2 * kk2 + 1;
            h16x8 pf;
#pragma unroll
            for (int rg = 0; rg < 4; ++rg) { pf[rg] = (h16)sc[ta][rg]; pf[4 + rg] = (tb <= 8) ? (h16)sc[tb < 9 ? tb : 8][rg] : (h16)0.f; }
            const int ja = (w + ta) < 15 ? (w + ta) : 15, jb = (w + tb) < 15 ? (w + tb) : 15;
#pragma unroll
            for (int dt = 0; dt < 4; ++dt) {
                const h16x4 va = tr_read4(Vb + (16 * ja + 4 * g + (fr >> 2)) * 72 + 16 * dt + 4 * (fr & 3));
                const h16x4 vb = tr_read4(Vb + (16 * jb + 4 * g + (fr >> 2)) * 72 + 16 * dt + 4 * (fr & 3));
                o[dt] = MFMA16(cat8(va, vb), pf, o[dt]);
            }
        }
        {
            const int t = p + r * (128 * nb + iq);
            const unsigned tok = (unsigned)b * SEQ + t;
            const float inv = 1.0f / lsum, lse_p = (mx + __builtin_amdgcn_logf(lsum)) * 0.6931471805599453f;
            float w1 = 0.f, w2 = inv, lse_new = lse_p;
            if (pat > 0) {
                const float lp = lp_pre, m2 = fmaxf(lp, lse_p), e1 = fexp(lp - m2), e2 = fexp(lse_p - m2), den = e1 + e2;
                w1 = e1 / den; w2 = e2 * inv / den; lse_new = m2 + flog(den);
            }
            h16* op = ob + tok * 768 + h * 64 + 4 * g;
#pragma unroll
            for (int dt = 0; dt < 4; ++dt) {
                h16x4 prev = {0, 0, 0, 0};
                if (pat > 0) prev = prev_pre[dt];
                h16x4 res;
#pragma unroll
                for (int rg = 0; rg < 4; ++rg) res[rg] = (h16)(w1 * (float)prev[rg] + w2 * o[dt][rg]);
                gst((h16x4*)(op + 16 * dt), res);
            }
            if (pat < 2 && g == 0) gst(lse + tok * 12 + h, lse_new);
        }
        }
        LDS_BARRIER();
        }
    }
    }
#undef ATT_LOAD
#undef ATT_MAP
}

__device__ __forceinline__ void phase_halo(const h16* Pdn, h16* halo) {
    const int total = 8 * 64 * 3 * 384;
    int tid = threadIdx.x; LAUNDER_V(tid); int bid = blockIdx.x; LAUNDER_S(bid);
    for (int c = bid * 512 + tid; c < total; c += gridDim.x * 512) {
        const int part = c % 384, e = (c / 384) % 3, bn = c / (384 * 3), n = bn & 63, b = bn >> 6;
        if (n == 0) continue;
        *(h16x8*)(halo + ((unsigned)bn * 3 + e) * 3072 + part * 8) = *(const h16x8*)(Pdn + ((unsigned)b * SEQ + 64 * n - 3 + e) * 4096 + part * 8);
    }
}

__device__ __forceinline__ void phase_dnprep(h16* Pdn, const h16* halo, const float* bd, const float* convw, const float* a_log, const float* dt_bias,
                             h16* Tg, h16* qkg, float* gcg, float* betag, float* s2g, LAS unsigned char* ldsl, unsigned char* ldsb) {
    int bid = blockIdx.x; LAUNDER_S(bid);
    const int w = __builtin_amdgcn_readfirstlane((int)threadIdx.x >> 6);
    constexpr int RP = 384;
    constexpr int RAWB = 67 * RP * 2;
    h16* qn = (h16*)(ldsb + 2 * RAWB);
    h16* kn = qn + 64 * 136;
    float* Mm = (float*)(kn + 64 * 136);
    float* cw = Mm + 64 * 68;
    float* gcs = cw + 4 * 384;
    float* bts = gcs + 64;
    float cv[4] = {0.f, 0.f, 0.f, 0.f}, pbr = 0.f, par_ = 0.f;
#define PREP_FETCH(item_, buf_) do { const int b_ = (item_) >> 9, h_ = ((item_) >> 6) & 7, n_ = (item_) & 63; int t_ = threadIdx.x; LAUNDER_V(t_); const int ln_ = t_ & 63; const unsigned tok0_ = (unsigned)b_ * SEQ + 64 * n_; \
        _Pragma("unroll") for (int it = 0; it < 7; ++it) { const int blk = w + 8 * it; if (blk < 51) { const int L = blk * 1024 + ln_ * 16, row = L / 768, q = (L - row * 768) >> 4; \
            const int coff_ = (q >> 4) * 1024 + h_ * 128 + (q & 15) * 8; \
            const h16* src = (row >= 3) ? Pdn + (tok0_ + row - 3) * 4096 + coff_ : halo + ((unsigned)(b_ * 64 + n_) * 3 + row) * 3072 + coff_; \
            if (L < RAWB && (row >= 3 || n_ > 0)) __builtin_amdgcn_global_load_lds((const unsigned*)src, (LAS unsigned*)(ldsl + (buf_) * RAWB + blk * 1024), 16, 0, 0); } } \
        _Pragma("unroll") for (int j = 0; j < 4; ++j) { if (t_ < 384) cv[j] = gld(convw + j * 3072 + (t_ >> 7) * 1024 + h_ * 128 + (t_ & 127)); } \
        if (w == 0) { pbr = gld(bd + (tok0_ + ln_) * 16 + h_); par_ = gld(bd + (tok0_ + ln_) * 16 + 8 + h_); } } while (0)
    if (bid < 4096) PREP_FETCH(bid, 0);
    int cur = 0;
    for (int item = bid; item < 4096; item += gridDim.x, cur ^= 1) {
        const int b = item >> 9, h = (item >> 6) & 7, n = item & 63;
        int tl = threadIdx.x; LAUNDER_V(tl);
        const int lane = tl & 63, fr = lane & 15, g = lane >> 4;
        const unsigned tok0 = (unsigned)b * SEQ + 64 * n;
        const unsigned bh0 = (unsigned)(b * 8 + h) * SEQ + 64 * n;
        h16* raw = (h16*)(ldsb + cur * RAWB);
        float* X = (float*)raw;
        float* Zs = X + 64 * 68;
        asm volatile("s_waitcnt vmcnt(0)" ::: "memory");
        if (n == 0 && tl < 144) { int z0 = 0; LAUNDER_V(z0); const float zf = __int_as_float(z0); *(f32x4*)(raw + tl * 8) = (f32x4){zf, zf, zf, zf}; }
#pragma unroll
        for (int j = 0; j < 4; ++j) if (tl < 384) cw[j * 384 + tl] = cv[j];
        if (w == 0) {
            const float br = pbr, ar = par_;
            const float beta = 1.0f / (1.0f + fexp(-br));
            const float xs = ar + dt_bias[h];
            const float sp = (xs > 20.f) ? xs : flog(1.0f + fexp(xs));
            float gg = -fexp(a_log[h]) * sp;
#pragma unroll
            for (int o = 1; o < 64; o <<= 1) { const float t = __int_as_float(__builtin_amdgcn_ds_bpermute(((lane >= o) ? (lane - o) : lane) << 2, __float_as_int(gg))); if (lane >= o) gg += t; }
            gcs[lane] = gg; bts[lane] = beta;
            {
                const float eg = fexp(gg), glast = __int_as_float(__builtin_amdgcn_readlane(__float_as_int(gg), 63));
                gst(gcg + bh0 + lane, eg); gst(betag + bh0 + lane, beta * eg); gst(s2g + bh0 + lane, fexp(glast - gg));
            }
        }
        LDS_BARRIER();
        if (item + (int)gridDim.x < 4096) PREP_FETCH(item + (int)gridDim.x, cur ^ 1);
        {
            const int rr = lane >> 3, cp = lane & 7, i = 8 * w + rr;
            h16* gp = Pdn + (tok0 + i) * 4096 + h * 128 + 16 * cp;
            const float bt_i = bts[i];
#pragma unroll
            for (int seg = 0; seg < 3; ++seg) {
                float y[16];
#pragma unroll
                for (int e = 0; e < 16; ++e) y[e] = 0.f;
#pragma unroll
                for (int j = 0; j < 4; ++j) {
                    const h16x8 x0 = *(const h16x8*)(raw + (i + j) * RP + seg * 128 + 16 * cp), x1 = *(const h16x8*)(raw + (i + j) * RP + seg * 128 + 16 * cp + 8);
                    const f32x4* cwp = (const f32x4*)(cw + j * 384 + seg * 128 + 16 * cp);
                    const f32x4 c0 = cwp[0], c1 = cwp[1], c2 = cwp[2], c3 = cwp[3];
#pragma unroll
                    for (int e = 0; e < 4; ++e) {
                        y[e] += c0[e] * (float)x0[e]; y[4 + e] += c1[e] * (float)x0[4 + e];
                        y[8 + e] += c2[e] * (float)x1[e]; y[12 + e] += c3[e] * (float)x1[4 + e];
                    }
                }
#pragma unroll
                for (int e = 0; e < 16; ++e) y[e] = silu_f(y[e]);
                float scl = bt_i;
                if (seg < 2) {
                    float ss = 0.f;
#pragma unroll
                    for (int e = 0; e < 16; ++e) ss += y[e] * y[e];
                    ss += shx(ss, 1, lane); ss += shx(ss, 2, lane); ss += shx(ss, 4, lane);
                    scl = rsqrtf(ss + 1e-6f) * (seg == 0 ? 0.08838834764831845f : 1.0f);
                }
                h16x8 o0, o1;
#pragma unroll
                for (int e = 0; e < 8; ++e) { o0[e] = (h16)(y[e] * scl); o1[e] = (h16)(y[8 + e] * scl); }
                if (seg == 0) { *(h16x8*)(qn + i * 136 + 16 * cp) = o0; *(h16x8*)(qn + i * 136 + 16 * cp + 8) = o1; }
                if (seg == 1) { *(h16x8*)(kn + i * 136 + 16 * cp) = o0; *(h16x8*)(kn + i * 136 + 16 * cp + 8) = o1; }
                gst((h16x8*)(gp + seg * 1024), o0); gst((h16x8*)(gp + seg * 1024 + 8), o1);
            }
        }
        LDS_BARRIER();
#pragma unroll
        for (int idx0 = 0; idx0 < 4; ++idx0) {
            const int idx = w + 8 * idx0;
            const int isqk = idx >> 4, ti = (idx >> 2) & 3, tj = idx & 3;
            f32x4 acc = {0.f, 0.f, 0.f, 0.f};
            if (tj <= ti) {
                const h16* As = isqk ? qn : kn;
#pragma unroll
                for (int kk = 0; kk < 4; ++kk) {
                    const h16x8 a = *(const h16x8*)(As + (16 * ti + fr) * 136 + 32 * kk + 8 * g);
                    const h16x8 bb = *(const h16x8*)(kn + (16 * tj + fr) * 136 + 32 * kk + 8 * g);
                    acc = MFMA16(a, bb, acc);
                }
            }
#pragma unroll
            for (int rg = 0; rg < 4; ++rg) {
                const int i = 16 * ti + 4 * g + rg, j = 16 * tj + fr;
                const float dec = fexp(fminf(gcs[i] - gcs[j], 0.f));
                if (!isqk) Mm[i * 68 + j] = (j < i) ? acc[rg] * bts[i] * dec : 0.f;
                else gst(qkg + (bh0 + i) * 64 + j, (h16)((j <= i) ? acc[rg] * dec : 0.f));
            }
        }
        for (int e = tl; e < 4096; e += 512) { const int r = e >> 6, c = e & 63; if ((c >> 4) > (r >> 4)) X[r * 68 + c] = 0.f; }
        LDS_BARRIER();
        if (w < 4 && lane < 16) {
            const int q = w, c = lane;
            float x[16];
#pragma unroll
            for (int i = 0; i < 16; ++i) {
                float mrow[16];
#pragma unroll
                for (int q4 = 0; q4 < 4; ++q4) { const f32x4 t4 = *(const f32x4*)(Mm + (16 * q + i) * 68 + 16 * q + 4 * q4); mrow[4 * q4] = t4[0]; mrow[4 * q4 + 1] = t4[1]; mrow[4 * q4 + 2] = t4[2]; mrow[4 * q4 + 3] = t4[3]; }
                float sacc = (i == c) ? 1.f : 0.f;
#pragma unroll
                for (int j = 0; j < 16; ++j) if (j < i) sacc -= mrow[j] * x[j];
                x[i] = sacc;
            }
#pragma unroll
            for (int i = 0; i < 16; ++i) X[(16 * q + i) * 68 + 16 * q + c] = x[i];
        }
        LDS_BARRIER();
        {
            const int which = tl >> 8, r = (tl >> 4) & 15, c = tl & 15, rb = which ? 48 : 16, cb = which ? 32 : 0;
            float sacc = 0.f;
#pragma unroll
            for (int k = 0; k < 16; ++k) sacc += Mm[(rb + r) * 68 + cb + k] * X[(cb + k) * 68 + cb + c];
            Zs[(which * 16 + r) * 17 + c] = sacc;
        }
        LDS_BARRIER();
        {
            const int which = tl >> 8, r = (tl >> 4) & 15, c = tl & 15, rb = which ? 48 : 16, cb = which ? 32 : 0;
            float sacc = 0.f;
#pragma unroll
            for (int m = 0; m < 16; ++m) sacc += X[(rb + r) * 68 + rb + m] * Zs[(which * 16 + m) * 17 + c];
            X[(rb + r) * 68 + cb + c] = -sacc;
        }
        LDS_BARRIER();
        {
            float zv[2];
#pragma unroll
            for (int it = 0; it < 2; ++it) {
                const int e = tl + 512 * it, r = e >> 5, c = e & 31;
                float sacc = 0.f;
#pragma unroll
                for (int k = 0; k < 32; ++k) sacc += Mm[(32 + r) * 68 + k] * X[k * 68 + c];
                zv[it] = sacc;
            }
#pragma unroll
            for (int it = 0; it < 2; ++it) { const int e = tl + 512 * it, r = e >> 5, c = e & 31; Zs[r * 33 + c] = zv[it]; }
        }
        LDS_BARRIER();
#pragma unroll
        for (int it = 0; it < 2; ++it) {
            const int e = tl + 512 * it, r = e >> 5, c = e & 31;
            float sacc = 0.f;
#pragma unroll
            for (int m = 0; m < 32; ++m) sacc += X[(32 + r) * 68 + 32 + m] * Zs[m * 33 + c];
            X[(32 + r) * 68 + c] = -sacc;
        }
        LDS_BARRIER();
        {
            const int i = tl >> 3, part = tl & 7;
            h16x8 o;
#pragma unroll
            for (int e = 0; e < 8; ++e) o[e] = (h16)X[i * 68 + 8 * part + e];
            gst((h16x8*)(Tg + (bh0 + i) * 64 + 8 * part), o);
        }
        LDS_BARRIER();
    }
#undef PREP_FETCH
}

__device__ __forceinline__ void phase_scan(h16* Pdn, const h16* Tg, const h16* qkg, const float* gcg, const float* betag, const float* s2g, unsigned char* ldsb) {
    int tid = threadIdx.x; LAUNDER_V(tid); int bid = blockIdx.x; LAUNDER_S(bid);
    const int lane = tid & 63, w = __builtin_amdgcn_readfirstlane(tid >> 6), fr = lane & 15, g = lane >> 4;
    constexpr int OQ = 0, OK_ = 64 * 136, OT = 2 * 64 * 136, OQK = OT + 64 * 72, OV = OQK + 64 * 72, OSC = OV + 64 * 64, BUFH = OSC + 384;
    if (bid < 128) {
        const int item = bid;
        const int bh = (item & 7) * 8 + (item >> 4), s = (item >> 3) & 1, b = bh >> 3, h = bh & 7;
        f32x4 S[8];
#pragma unroll
        for (int tk = 0; tk < 8; ++tk) S[tk] = (f32x4){0.f, 0.f, 0.f, 0.f};
#define SCAN_LD(n_, R_) do { const unsigned tok0_ = (unsigned)b * SEQ + 64 * (n_), bh0_ = (unsigned)bh * SEQ + 64 * (n_); int lt = tid - 256; LAUNDER_V(lt); \
            _Pragma("unroll") for (int it = 0; it < 4; ++it) { const int c = lt + 256 * it, i = c >> 4, part = c & 15; const h16* rp = Pdn + (tok0_ + i) * 4096 + h * 128 + part * 8; \
                R_[it] = gld((const h16x8*)rp); R_[4 + it] = gld((const h16x8*)(rp + 1024)); } \
            _Pragma("unroll") for (int it = 0; it < 2; ++it) { const int c = lt + 256 * it, i = c >> 3, part = c & 7; \
                R_[8 + it] = gld((const h16x8*)(Tg + (bh0_ + i) * 64 + part * 8)); R_[10 + it] = gld((const h16x8*)(qkg + (bh0_ + i) * 64 + part * 8)); \
                R_[12 + it] = gld((const h16x8*)(Pdn + (tok0_ + i) * 4096 + 2048 + h * 128 + 64 * s + part * 8)); } \
            if (lt < 48) R_[14] = gld((const h16x8*)(((lt < 16) ? gcg : ((lt < 32) ? betag : s2g)) + bh0_ + 4 * (lt & 15))); } while (0)
#define SCAN_ST(buf_, R_) do { h16* B_ = (h16*)ldsb + (buf_) * BUFH; int lt = tid - 256; LAUNDER_V(lt); \
            _Pragma("unroll") for (int it = 0; it < 4; ++it) { const int c = lt + 256 * it, i = c >> 4, part = c & 15; \
                *(h16x8*)(B_ + OQ + i * 136 + part * 8) = R_[it]; *(h16x8*)(B_ + OK_ + i * 136 + part * 8) = R_[4 + it]; } \
            _Pragma("unroll") for (int it = 0; it < 2; ++it) { const int c = lt + 256 * it, i = c >> 3, part = c & 7; \
                *(h16x8*)(B_ + OT + i * 72 + part * 8) = R_[8 + it]; *(h16x8*)(B_ + OQK + i * 72 + part * 8) = R_[10 + it]; *(h16x8*)(B_ + OV + i * 64 + part * 8) = R_[12 + it]; } \
            if (lt < 48) *(h16x8*)(B_ + OSC + 8 * lt) = R_[14]; } while (0)
        if (w >= 4) {
            h16x8 R0[15], R1[15], R2[15];
            SCAN_LD(0, R0); SCAN_ST(0, R0);
            SCAN_LD(1, R1); SCAN_LD(2, R2); SCAN_LD(3, R0);
            LDS_BARRIER();
#pragma unroll 1
            for (int n = 0; n < 63; n += 3) {
                SCAN_ST((n + 1) & 1, R1); if (n + 4 < 64) SCAN_LD(n + 4, R1);
                LDS_BARRIER();
                SCAN_ST((n + 2) & 1, R2); if (n + 5 < 64) SCAN_LD(n + 5, R2);
                LDS_BARRIER();
                SCAN_ST((n + 3) & 1, R0); if (n + 6 < 64) SCAN_LD(n + 6, R0);
                LDS_BARRIER();
            }
            LDS_BARRIER();
        } else {
        int tc = tid; LAUNDER_V(tc);
        const int lane = tc & 63, fr = lane & 15, g = lane >> 4; (void)lane;
        LDS_BARRIER();
#pragma unroll 1
        for (int n = 0; n < 64; ++n) {
            const unsigned tok0 = (unsigned)b * SEQ + 64 * n;
            const h16* B = (const h16*)ldsb + (n & 1) * BUFH;
            const h16* qn = B + OQ; const h16* kn = B + OK_; const h16* Tm = B + OT; const h16* qkm = B + OQK; const h16* vbs = B + OV;
            const float* gcs = (const float*)(B + OSC); const float* bts = gcs + 64; const float* s2s = gcs + 128;
            {
                GAS h16* ob = (GAS h16*)(Pdn + (tok0 * 4096 + 2048 + h * 128 + 64 * s));
                const float e_last = gcs[63];
                h16x8 Sf[4];
#pragma unroll
                for (int kk = 0; kk < 4; ++kk)
#pragma unroll
                    for (int rg = 0; rg < 4; ++rg) { Sf[kk][rg] = (h16)S[2 * kk][rg]; Sf[kk][4 + rg] = (h16)S[2 * kk + 1][rg]; }
#define LD_A(F, ti_) do { _Pragma("unroll") for (int kk = 0; kk < 4; ++kk) { const h16* kp = kn + (16 * (ti_) + fr) * 136 + 32 * kk + 4 * g; const h16* qp = qn + (16 * (ti_) + fr) * 136 + 32 * kk + 4 * g; \
                    F[2 * kk] = cat8(*(const h16x4*)kp, *(const h16x4*)(kp + 16)); F[2 * kk + 1] = cat8(*(const h16x4*)qp, *(const h16x4*)(qp + 16)); } } while (0)
#define LD_T(F, base_) do { _Pragma("unroll") for (int ti = 0; ti < 4; ++ti) _Pragma("unroll") for (int k2 = 0; k2 < 2; ++k2) { const h16* tp = (base_) + (16 * ti + fr) * 72 + 32 * k2 + 4 * g; \
                    F[2 * ti + k2] = cat8(*(const h16x4*)tp, *(const h16x4*)(tp + 16)); } } while (0)
#define LD_K(F, tk0_) do { _Pragma("unroll") for (int t = 0; t < 4; ++t) _Pragma("unroll") for (int k2 = 0; k2 < 2; ++k2) { const h16* kp = kn + (32 * k2 + 4 * g + (fr >> 2)) * 136 + 16 * ((tk0_) + t) + 4 * (fr & 3); \
                    F[2 * t + k2] = cat8(tr_read4(kp), tr_read4(kp + 16 * 136)); } } while (0)
#define CP_F(D, S_) do { _Pragma("unroll") for (int q = 0; q < 8; ++q) D[q] = S_[q]; } while (0)
#define LD_S(G_, B_, V_, ti_) do { G_ = *(const f32x4*)(gcs + 16 * (ti_) + 4 * g); B_ = *(const f32x4*)(bts + 16 * (ti_) + 4 * g); V_ = tr_read4(vbs + (16 * (ti_) + 4 * g + (fr >> 2)) * 64 + 16 * w + 4 * (fr & 3)); } while (0)
                h16x8 F0[8], F1[8];
                f32x4 gc0, bt0, gc1 = {0.f, 0.f, 0.f, 0.f}, bt1 = {0.f, 0.f, 0.f, 0.f}; h16x4 vb0, vb1 = {0, 0, 0, 0};
                LD_A(F0, 0); LD_S(gc0, bt0, vb0, 0);
                f32x4 R[4], O[4];
#pragma unroll
                for (int ti = 0; ti < 4; ++ti) {
                    if (ti < 3) { LD_A(F1, ti + 1); LD_S(gc1, bt1, vb1, ti + 1); } else LD_T(F1, Tm);
                    __builtin_amdgcn_sched_barrier(0);
                    f32x4 ka = {0.f, 0.f, 0.f, 0.f}, qa = {0.f, 0.f, 0.f, 0.f};
#pragma unroll
                    for (int kk = 0; kk < 4; ++kk) { ka = MFMA16(F0[2 * kk], Sf[kk], ka); qa = MFMA16(F0[2 * kk + 1], Sf[kk], qa); }
#pragma unroll
                    for (int rg = 0; rg < 4; ++rg) { R[ti][rg] = (float)vb0[rg] - bt0[rg] * ka[rg]; O[ti][rg] = gc0[rg] * qa[rg]; }
                    CP_F(F0, F1); gc0 = gc1; bt0 = bt1; vb0 = vb1;
                }
                h16x8 Rf[2];
#pragma unroll
                for (int k2 = 0; k2 < 2; ++k2)
#pragma unroll
                    for (int rg = 0; rg < 4; ++rg) { Rf[k2][rg] = (h16)R[2 * k2][rg]; Rf[k2][4 + rg] = (h16)R[2 * k2 + 1][rg]; }
                LD_T(F1, qkm);
                __builtin_amdgcn_sched_barrier(0);
                f32x4 Vn[4];
#pragma unroll
                for (int ti = 0; ti < 4; ++ti) {
                    f32x4 acc = {0.f, 0.f, 0.f, 0.f};
#pragma unroll
                    for (int k2 = 0; k2 < 2; ++k2) acc = MFMA16(F0[2 * ti + k2], Rf[k2], acc);
                    Vn[ti] = acc;
                }
                CP_F(F0, F1);
                h16x8 Vf[2], V2f[2];
#pragma unroll
                for (int k2 = 0; k2 < 2; ++k2) {
                    const f32x4 gca = *(const f32x4*)(s2s + 32 * k2 + 4 * g), gcb = *(const f32x4*)(s2s + 32 * k2 + 16 + 4 * g);
#pragma unroll
                    for (int rg = 0; rg < 4; ++rg) {
                        Vf[k2][rg] = (h16)Vn[2 * k2][rg]; Vf[k2][4 + rg] = (h16)Vn[2 * k2 + 1][rg];
                        V2f[k2][rg] = (h16)(Vn[2 * k2][rg] * gca[rg]); V2f[k2][4 + rg] = (h16)(Vn[2 * k2 + 1][rg] * gcb[rg]);
                    }
                }
                LD_K(F1, 0);
                __builtin_amdgcn_sched_barrier(0);
#pragma unroll
                for (int ti = 0; ti < 4; ++ti) {
#pragma unroll
                    for (int k2 = 0; k2 < 2; ++k2) O[ti] = MFMA16(F0[2 * ti + k2], Vf[k2], O[ti]);
#pragma unroll
                    for (int rg = 0; rg < 4; ++rg) {
                        const int i = 16 * ti + 4 * g + rg;
                        ob[i * 4096 + 16 * w + fr] = (h16)O[ti][rg];
                    }
                }
                CP_F(F0, F1);
                LD_K(F1, 4);
                __builtin_amdgcn_sched_barrier(0);
#pragma unroll
                for (int t = 0; t < 4; ++t) {
                    f32x4 acc = S[t] * e_last;
#pragma unroll
                    for (int k2 = 0; k2 < 2; ++k2) acc = MFMA16(F0[2 * t + k2], V2f[k2], acc);
                    S[t] = acc;
                }
                __builtin_amdgcn_sched_barrier(0);
#pragma unroll
                for (int t = 0; t < 4; ++t) {
                    f32x4 acc = S[4 + t] * e_last;
#pragma unroll
                    for (int k2 = 0; k2 < 2; ++k2) acc = MFMA16(F1[2 * t + k2], V2f[k2], acc);
                    S[4 + t] = acc;
                }
#undef LD_A
#undef LD_S
#undef LD_T
#undef LD_K
#undef CP_F
            }
            LDS_BARRIER();
        }
        }
#undef SCAN_LD
#undef SCAN_ST
    }
}

__device__ __forceinline__ void phase_gnorm(h16* Pdn, const float* dn_norm) {
    int tid = threadIdx.x; LAUNDER_V(tid); int bid = blockIdx.x; LAUNDER_S(bid);
    const int lane = tid & 63, w = __builtin_amdgcn_readfirstlane(tid >> 6);
    const int hh = lane >> 3, cp = lane & 7;
    const int stride = gridDim.x * 16, half = gridDim.x * 8;
    float gn[16];
#pragma unroll
    for (int q4 = 0; q4 < 4; ++q4) { const f32x4 t4 = *(const f32x4*)(dn_norm + 16 * cp + 4 * q4); gn[4 * q4] = t4[0]; gn[4 * q4 + 1] = t4[1]; gn[4 * q4 + 2] = t4[2]; gn[4 * q4 + 3] = t4[3]; }
    h16x8 oc[2][2], zc[2][2], on[2][2], zn[2][2];
#define GN_LOAD(O_, Z_, r0_) do { _Pragma("unroll") for (int u = 0; u < 2; ++u) { const int row = (r0_) + u * half; if (row < M_TOK) { const h16* rp = Pdn + (unsigned)row * 4096 + 2048 + hh * 128 + 16 * cp; \
        O_[u][0] = gld((const h16x8*)rp); O_[u][1] = gld((const h16x8*)(rp + 8)); Z_[u][0] = gld((const h16x8*)(rp + 1024)); Z_[u][1] = gld((const h16x8*)(rp + 1032)); } } } while (0)
    int row0 = bid * 8 + w;
    if (row0 < M_TOK) GN_LOAD(oc, zc, row0);
    for (; row0 < M_TOK; row0 += stride) {
        if (row0 + stride < M_TOK) GN_LOAD(on, zn, row0 + stride);
#pragma unroll
        for (int u = 0; u < 2; ++u) {
            const int row = row0 + u * half;
            if (row < M_TOK) {
                float ss = 0.f;
#pragma unroll
                for (int e = 0; e < 8; ++e) { const float a0 = (float)oc[u][0][e], a1 = (float)oc[u][1][e]; ss += a0 * a0 + a1 * a1; }
                ss += shx(ss, 1, lane); ss += shx(ss, 2, lane); ss += shx(ss, 4, lane);
                const float rstd = rsqrtf(ss * (1.0f / 128.0f) + 1e-6f);
                h16x8 r0, r1;
#pragma unroll
                for (int e = 0; e < 8; ++e) {
                    r0[e] = (h16)((float)oc[u][0][e] * rstd * gn[e] * silu_f((float)zc[u][0][e]));
                    r1[e] = (h16)((float)oc[u][1][e] * rstd * gn[8 + e] * silu_f((float)zc[u][1][e]));
                }
                h16* wp = Pdn + (unsigned)row * 4096 + 2048 + hh * 128 + 16 * cp;
                gst((h16x8*)wp, r0); gst((h16x8*)(wp + 8), r1);
            }
        }
#pragma unroll
        for (int u = 0; u < 2; ++u) { oc[u][0] = on[u][0]; oc[u][1] = on[u][1]; zc[u][0] = zn[u][0]; zc[u][1] = zn[u][1]; }
    }
#undef GN_LOAD
}

#define XB_TMO      128
#define XB_XCNT(j)  (256  + 64 * (j))
#define XB_XSUB(j)  (1280 + 64 * (j))
#define XB_XGEN(j)  (2304 + 64 * (j))
#define XB_TOP      3328
#define XB_TOPGEN   3392
#define XCD_BAR_WORDS 3456
#define XB_SPIN_CAP (1u << 18)
__device__ __forceinline__ unsigned xb_ld(unsigned* p)              { return __hip_atomic_load(p, __ATOMIC_RELAXED, __HIP_MEMORY_SCOPE_AGENT); }
__device__ __forceinline__ unsigned xb_add(unsigned* p, unsigned v) { return __hip_atomic_fetch_add(p, v, __ATOMIC_RELAXED, __HIP_MEMORY_SCOPE_AGENT); }
__device__ __forceinline__ unsigned xb_xcc_id() { return (unsigned)__builtin_amdgcn_s_getreg((3 << 11) | 20) & 0xFu; }
#define XB_SPIN(cond, bar) do { unsigned _sp = 0; while (cond) { __builtin_amdgcn_s_sleep(1); \
    if ((++_sp & 255u) == 0u) { if (xb_ld(&(bar)[XB_TMO])) break; if (_sp > XB_SPIN_CAP) { atomicAdd(&(bar)[XB_TMO], 1u); break; } } } } while (0)
__device__ __forceinline__ void xcd_barrier_complete(unsigned* bar, unsigned x, unsigned& nloc, unsigned& nx) {
    const unsigned G = gridDim.x * gridDim.y * gridDim.z;
    unsigned sum, cnt, mine, sp = 0u;
    for (;;) {
        sum = 0u; cnt = 0u; mine = 0u;
#pragma unroll
        for (unsigned j = 0; j < 16; ++j) { const unsigned c = xb_ld(&bar[XB_XCNT(j)]); sum += c; cnt += (c > 0u) ? 1u : 0u; mine = (j == x) ? c : mine; }
        if (sum == G) break;
        __builtin_amdgcn_s_sleep(1);
        if ((++sp & 255u) == 0u) { if (xb_ld(&bar[XB_TMO])) break; if (sp > XB_SPIN_CAP) { atomicAdd(&bar[XB_TMO], 1u); break; } }
    }
    nloc = mine > 0u ? mine : 1u; nx = cnt > 0u ? cnt : 1u;
}
__device__ __forceinline__ void xcd_barrier(unsigned* bar, unsigned x, volatile LAS unsigned* st) {
    asm volatile("s_waitcnt vmcnt(0)" ::: "memory");
    __syncthreads();
    if (threadIdx.x == 0) {
        __builtin_amdgcn_s_waitcnt(0);
        unsigned nloc = st[0], nx = st[1];
        if (nloc == 0u) { xcd_barrier_complete(bar, x, nloc, nx); st[0] = nloc; st[1] = nx; }
        const unsigned old = xb_add(&bar[XB_XSUB(x)], 1u);
        const unsigned gen = old / nloc;
        if (old + 1u == (gen + 1u) * nloc) {
            __builtin_amdgcn_fence(__ATOMIC_RELEASE, "agent");
            asm volatile("s_waitcnt vmcnt(0)" ::: "memory");
            const unsigned og = xb_add(&bar[XB_TOP], 1u);
            const unsigned tg = og / nx;
            if (og + 1u == (tg + 1u) * nx) xb_add(&bar[XB_TOPGEN], 1u);
            else XB_SPIN(xb_ld(&bar[XB_TOPGEN]) == tg, bar);
            __builtin_amdgcn_fence(__ATOMIC_ACQUIRE, "agent");
            xb_add(&bar[XB_XGEN(x)], 1u);
            asm volatile("s_waitcnt vmcnt(0)" ::: "memory");
        } else {
            XB_SPIN(xb_ld(&bar[XB_XGEN(x)]) == gen, bar);
            __builtin_amdgcn_fence(__ATOMIC_ACQUIRE, "agent");
            asm volatile("s_waitcnt vmcnt(0)" ::: "memory");
        }
    }
    __syncthreads();
}

#ifndef PROBE_GEMM2
constexpr int NPROG = 15;
__constant__ unsigned char PROG[NPROG] = {0, 1, 2, 4, 5, 6, 7, 8, 10, 11, 13, 14, 15, 17, 18};
#else
constexpr int NPROG = 24;
__constant__ unsigned char PROG[NPROG] = {0, 1, 1, 2, 3, 4, 4, 5, 6, 7, 8, 8, 9, 10, 11, 12, 13, 13, 14, 15, 16, 17, 17, 18};
#endif
__global__ void __launch_bounds__(512, 2) fwd_mega(Params p) {
    extern __shared__ __attribute__((aligned(16))) unsigned char lds[];
    cg::grid_group grid = cg::this_grid();
    LAS unsigned char* ldsl = (LAS unsigned char*)lds;
    volatile LAS unsigned* bst = (volatile LAS unsigned*)(ldsl + 161792);
    if (threadIdx.x == 0) { bst[0] = 0u; bst[1] = 0u; (void)xb_add((unsigned*)(p.ws + R4_BAR) + XB_XCNT(xb_xcc_id()), 1u); }
    __syncthreads();
    { unsigned char* ws0 = p.ws; LAUNDER_S(ws0); phase_mod(p.in[1], p.in[2], p.in[3], (float*)(ws0 + R4_MOD), lds); }
    {
        unsigned char* ws1 = p.ws; LAUNDER_S(ws1);
        h16* pW1 = (h16*)(ws1 + R3_W1); h16* pW2 = (h16*)(ws1 + R3_W2);
        conv_w(p.in[7], FF, 0, FF, FF, 1024, pW1, 0, lds, 32, (int)gridDim.x - 32);
        conv_w(p.in[8], FF, 0, FF, FF, 1024, pW1, 1, lds, 32, (int)gridDim.x - 32);
        conv_w(p.in[9], 1024, 0, 1024, 1024, FF, pW2, -1, lds, 32, (int)gridDim.x - 32);
    }
    if (p.ws == nullptr) grid.sync();
    xcd_barrier((unsigned*)(p.ws + R4_BAR), xb_xcc_id(), bst);
#pragma unroll 1
    for (int pc = 0; pc < NPROG * 2; ++pc) {
        const int l = (pc >= NPROG) ? 1 : 0;
        const int sl = PROG[pc - NPROG * l];
        const int step = 19 * l + sl;
        if (l == 1 && sl == 0) continue;
        unsigned char* ws = p.ws; LAUNDER_S(ws);
            const int G = gridDim.x; int bid = blockIdx.x; LAUNDER_S(bid);
        const float* x = p.in[0];
        h16* hbuf = (h16*)p.out;
        h16* XN = (h16*)(ws + R1);
        h16* HID = (h16*)(ws + R0);
        h16* Pda = (h16*)(ws + R0);
        h16* Pdn = (h16*)(ws + R0);
        h16* OB = (h16*)(ws + R2);
        h16* GATE_A = (h16*)(ws + R3 + 64 * MiB); h16* GATE_B = (h16*)(ws + R3);
        h16* Tg = (h16*)(ws + R3_T); h16* QKg = (h16*)(ws + R3_QK); h16* HALO = (h16*)(ws + R3_HALO);
        h16* Wdn = (h16*)(ws + R3_WDN); h16* Wda = (h16*)(ws + R3_WDA);
        const size_t ffoff = (l == 1 && (sl == 1 || sl == 2)) ? 32 * MiB : 0;
        h16* W1t = (h16*)(ws + R3_W1 + ffoff); h16* W2t = (h16*)(ws + R3_W2 + ffoff);
        h16* Wg = (h16*)(ws + R4_WG); h16* Wa = (h16*)(ws + R4_WA); h16* Wb = (h16*)(ws + R4_WB); h16* Wo = (h16*)(ws + R4_WO);
        float* MOD = (float*)(ws + R4_MOD); float* BD = (float*)(ws + R4_BD); float* LSE = (float*)(ws + R4_LSE);
        float* GC = (float*)(ws + R4_GC); float* BETA = (float*)(ws + R4_BETA);


        const float* modl = MOD + (unsigned)l * 8 * 9216;
        const bool first = (step == 0) || (step == 2);
        const float* hin32 = first ? x : (const float*)nullptr;
        if (sl == 0) {
            if (step == 0) phase_norm(hin32, hbuf, p.in[4], modl, 0, 1, XN);
        } else if (sl == 1 || sl == 17) {
            pg8::Gemm gm{XN, W1t, M_TOK, 2 * FF, 1024, 1024}; pg8::StaticOrder S; S.init(M_TOK, 2 * FF, G, bid);
            pg8::EpiSwiglu E{HID}; pg8::gemm_phase(ldsl, gm, S, E);
        } else if (sl == 2 || sl == 18 || sl == 15) {
            const bool wo = (sl == 15);
            pg8::Gemm gm{wo ? XN : HID, wo ? Wo : W2t, M_TOK, 1024, wo ? 1024 : FF, wo ? 1024 : FF}; pg8::StaticOrder S; S.init(M_TOK, 1024, G, bid);
            const bool lastffn = (l == 1 && sl == 18);
            h16* HB2 = (h16*)(ws + R3 + 32 * MiB);
            if (!lastffn) {
                const int nl = (sl == 18) ? 1 : l;
                const float* modn = MOD + (unsigned)nl * 8 * 9216;
                const int nsh = (sl == 2) ? 3 : (sl == 15 ? 6 : 0);
                const float* lnn = ((sl == 2) ? p.in[5] : (sl == 15 ? p.in[6] : p.in[4])) + nl * 1024;
                const unsigned use = (l == 0) ? (sl == 2 ? 1u : (sl == 15 ? 2u : 3u)) : (sl == 2 ? 4u : 5u);
                if (first) {
                    pg8::EpiResidNorm<true> E{x, hbuf, hbuf, modl + 2 * 1024, 0.5f, XN, lnn, modn + nsh * 1024, modn + (nsh + 1) * 1024,
                                              (float*)(ws + R2), (unsigned*)(p.ws + R4_BAR + 16384), 4u * use, (float*)nullptr, ldsl + 131072};
                    pg8::gemm_phase(ldsl, gm, S, E);
                } else {
                    pg8::EpiResidNorm<false> E{nullptr, hbuf, (wo && l == 1) ? HB2 : hbuf, modl + (wo ? 5 : (sl == 2 ? 2 : 8)) * 1024, wo ? 1.0f : 0.5f, XN, lnn, modn + nsh * 1024, modn + (nsh + 1) * 1024,
                                               (float*)(ws + R2), (unsigned*)(p.ws + R4_BAR + 16384), 4u * use, (float*)nullptr, ldsl + 131072};
                    pg8::gemm_phase(ldsl, gm, S, E);
                }
            } else {
                pg8::EpiResidNorm<false, true> E{nullptr, HB2, HB2, modl + 8 * 1024, 0.5f, XN, p.in[21], p.in[21], p.in[21],
                                                 (float*)(ws + R2), (unsigned*)(p.ws + R4_BAR + 16384), 4u * 6u, p.out, ldsl + 131072};
                pg8::gemm_phase(ldsl, gm, S, E);
            }
        } else if (sl == 4 || sl == 8 || sl == 13) {
            if (sl == 13) phase_gnorm(Pdn, p.in[14] + l * 128);
            const int N = (sl == 4) ? 2560 : (sl == 8 ? 4096 : 1024);
            pg8::Gemm gm{XN, sl == 4 ? Wda : (sl == 8 ? Wdn : Wg + 1024 * 1024), M_TOK, N, 1024, 1024}; pg8::StaticOrder S; S.init(M_TOK, N, G, bid);
            pg8::EpiStore E{sl == 4 ? Pda : (sl == 8 ? Pdn : GATE_B), sl == 4 ? 2304 : (sl == 8 ? 4096 : 1024), BD, sl == 4 ? 9 : (sl == 8 ? 16 : 4), sl == 13 ? 1 : 0, sl == 8 ? HALO : (h16*)nullptr};
            pg8::gemm_phase(ldsl, gm, S, E);
        } else if (sl >= 5 && sl <= 7) {
            phase_attn(Pda, OB, LSE, sl - 5, lds);
        } else if (sl == 10) {
            phase_dnprep(Pdn, HALO, BD, p.in[11] + (unsigned)l * 4 * 3072, p.in[12] + l * 8, p.in[13] + l * 8, Tg, QKg, GC, BETA, LSE, ldsl, lds);
        } else if (sl == 11) {
            if (bid < 128) {
                phase_scan(Pdn, Tg, QKg, GC, BETA, LSE, lds);
            } else {
                pg8::Gemm gm{XN, Wg, M_TOK, 1024, 1024, 1024}; pg8::StaticOrder S; S.init(M_TOK, 1024, G - 128, bid - 128);
                pg8::EpiStore E{GATE_A, 1024, BD, 4, 1, (h16*)nullptr}; pg8::gemm_phase(ldsl, gm, S, E);
            }
        } else if (sl == 14) {
#pragma unroll 1
            for (int q = 0; q < 2; ++q) {
                pg8::Gemm gm{q ? OB : Pdn + 2048, q ? Wb : Wa, M_TOK, 1024, q ? 768 : 1024, q ? 768 : 4096}; pg8::StaticOrder S; S.init(M_TOK, 1024, G, bid);
                pg8::EpiMerge E{XN, q ? GATE_B : GATE_A, q}; pg8::gemm_phase(ldsl, gm, S, E);
                __syncthreads();
            }
        }
        {
            const int ck = (sl == 2) ? 3 : (sl == 15 ? 16 : ((sl == 18 && l == 0) ? 0 : -1));
            const int cl = (sl == 18) ? 1 : l;
            h16* cW1 = (h16*)(ws + R3_W1 + ((sl == 18) ? 32 * MiB : 0)); h16* cW2 = (h16*)(ws + R3_W2 + ((sl == 18) ? 32 * MiB : 0));
            if (ck >= 0) {
            const int nconv = (ck == 3) ? 7 : 3;
    #pragma unroll 1
                for (int ci = 0; ci < nconv; ++ci) {
                    const float* src; int ldsrc, coloff = 0, nvalid, Ntot, K = 1024, inter = -1; h16* dst;
                    if (ck == 3) {
                        const float* win = p.in[10] + (unsigned)l * 1024 * 8464;
                        if (ci == 0)      { src = win; ldsrc = 8464; coloff = 4112; nvalid = 2304; Ntot = 2304; dst = Wda; }
                        else if (ci == 1) { src = win; ldsrc = 8464; coloff = 0;    nvalid = 4096; Ntot = 4096; dst = Wdn; }
                        else if (ci == 6) { src = win; ldsrc = 8464; coloff = 4096; nvalid = 16;   Ntot = 256;  dst = Wda + 2304 * 1024; }
                        else if (ci == 2) { src = win; ldsrc = 8464; coloff = 6416; nvalid = 2048; Ntot = 2048; dst = Wg; }
                        else if (ci == 3) { src = p.in[15] + (unsigned)l * 1024 * 1024; ldsrc = 1024; nvalid = 1024; Ntot = 1024; dst = Wa; }
                        else if (ci == 4) { src = p.in[16] + (unsigned)l * 768 * 1024;  ldsrc = 1024; nvalid = 1024; Ntot = 1024; K = 768; dst = Wb; }
                        else              { src = p.in[17] + (unsigned)l * 1024 * 1024; ldsrc = 1024; nvalid = 1024; Ntot = 1024; dst = Wo; }
                    } else {
                        const bool f2 = (ck == 16);
                        if (ci == 0)      { src = (f2 ? p.in[18] : p.in[7]) + (unsigned)cl * 1024 * FF; ldsrc = FF; nvalid = FF; Ntot = FF; dst = cW1; inter = 0; }
                        else if (ci == 1) { src = (f2 ? p.in[19] : p.in[8]) + (unsigned)cl * 1024 * FF; ldsrc = FF; nvalid = FF; Ntot = FF; dst = cW1; inter = 1; }
                        else              { src = (f2 ? p.in[20] : p.in[9]) + (unsigned)cl * FF * 1024; ldsrc = 1024; nvalid = 1024; Ntot = 1024; K = FF; dst = cW2; }
                    }
                    conv_w(src, ldsrc, coloff, nvalid, Ntot, K, dst, inter, lds);
                }

            }
        }
        xcd_barrier((unsigned*)(p.ws + R4_BAR), xb_xcc_id(), bst);
    }
}

extern "C" void kernel_launch(void* const* d_in, const int* in_sizes, int n_in, void* d_out, int out_size, void* d_ws, size_t ws_size, hipStream_t stream) {
    static int grid = 0;
    if (grid == 0) {
        if (n_in != 22 || ws_size < WS_NEED) { fprintf(stderr, "kernel_launch: unexpected n_in %d or ws_size %zu (< %zu)\n", n_in, ws_size, (size_t)WS_NEED); grid = -1; return; }
        int dev = 0, cus = 0, per_cu = 0;
        hipGetDevice(&dev);
        hipDeviceGetAttribute(&cus, hipDeviceAttributeMultiprocessorCount, dev);
        hipFuncSetAttribute((const void*)fwd_mega, hipFuncAttributeMaxDynamicSharedMemorySize, LDS_BYTES);
        hipOccupancyMaxActiveBlocksPerMultiprocessor(&per_cu, (const void*)fwd_mega, 512, LDS_BYTES);
        if (per_cu < 1) per_cu = 1;
        if (per_cu > 1) per_cu = 1;
        grid = cus * per_cu;
        (void)hipGetLastError();
    }
    if (grid < 0) return;
    Params p{};
    for (int i = 0; i < 22; ++i) p.in[i] = (const float*)d_in[i];
    p.out = (float*)d_out; p.ws = (unsigned char*)d_ws;
    (void)hipMemsetAsync((unsigned char*)d_ws + R4_BAR, 0, 32768, stream);
    void* args[] = {&p};
    hipError_t e = hipLaunchCooperativeKernel((const void*)fwd_mega, dim3(grid), dim3(512), args, LDS_BYTES, stream);
    if (e != hipSuccess) fprintf(stderr, "cooperative launch failed: %s (grid %d)\n", hipGetErrorString(e), grid);
}
```
